# Optimizing an MI355X kernel written in HIP

```python
import math
import functools
import jax
import jax.numpy as jnp
from jax import lax
import numpy as np

D_MODEL = 2048
BATCH = 1
SEQ = 16384
DEPTH = 2

CTX_LEN = 256
GRID_W = 64
N_MIXERS = 4
GROUP_WIDTH = D_MODEL // N_MIXERS
D_MIX = N_MIXERS * GROUP_WIDTH
GDN_DK = 64
GDN_DV = 64
GDN_HEADS = GROUP_WIDTH // GDN_DV
SHORT_CONV = 3
SCAN_CHUNK = 64
SC_WIDTH = GROUP_WIDTH
GLA_DK = 64
GLA_DV = 128
GLA_HEADS = GROUP_WIDTH // GLA_DV
GLA_GATE_RANK = 16
GLA_TAU = 16.0
DIFF_DK = 64
DIFF_DV = 128
DIFF_HEADS = GROUP_WIDTH // DIFF_DV
Q_BLOCK = 128
ROPE_BASE = 10000.0
ROPE_PAIRS = DIFF_DK // 4
N_GROUPS = 4
EXPERTS_PER_GROUP = 8
N_EXPERTS = N_GROUPS * EXPERTS_PER_GROUP
TOP_K = 2
D_EXPERT = D_MODEL // 4
EXPERT_BLOCK = 256
NORM_EPS = 1e-6
F32 = jnp.float32

PROJ_LAYOUT = (
    ('gdn_qkv', GDN_HEADS * (2 * GDN_DK + GDN_DV)),
    ('gdn_gate', GDN_HEADS * GDN_DV),
    ('gdn_beta', 2 * GDN_HEADS),
    ('gdn_alpha', 2 * GDN_HEADS),
    ('sc_b', SC_WIDTH),
    ('sc_c', SC_WIDTH),
    ('sc_x', SC_WIDTH),
    ('gla_q', GLA_HEADS * GLA_DK),
    ('gla_k', GLA_HEADS * GLA_DK),
    ('gla_v', GLA_HEADS * GLA_DV),
    ('gla_r', GLA_HEADS * GLA_DV),
    ('gla_lowrank', 2 * GLA_GATE_RANK),
    ('diff_q', DIFF_HEADS * 2 * DIFF_DK),
    ('diff_k', DIFF_HEADS * 2 * DIFF_DK),
    ('diff_v', DIFF_HEADS * DIFF_DV),
)
PROJ_WIDTH = sum(size for _, size in PROJ_LAYOUT)

kernel_name = 'hybrid_dit_delta_conv_gla_diffattn_hmoe'


def rms_norm(x, gain):
    xf = x.astype(F32)
    y = xf * lax.rsqrt(jnp.mean(xf * xf, axis=-1, keepdims=True) + NORM_EPS)
    return (y * gain.astype(F32)).astype(x.dtype)


def l2_normalize(x):
    xf = x.astype(F32)
    return (xf * lax.rsqrt(jnp.sum(xf * xf, axis=-1, keepdims=True) + NORM_EPS)).astype(x.dtype)


def adaln(h, shift, scale):
    return h * (1.0 + scale) + shift


def dwconv_centred(x, w):
    pad = w.shape[0] // 2
    return lax.conv_general_dilated(
        x, w[:, None, :].astype(x.dtype), window_strides=(1,), padding=((pad, pad),),
        dimension_numbers=('NWC', 'WIO', 'NWC'), feature_group_count=x.shape[-1])


def split_proj(p):
    parts, off = {}, 0
    for name, size in PROJ_LAYOUT:
        parts[name] = p[..., off:off + size]
        off += size
    return parts


def to_chunks(t, chunk):
    bsz, T, H = t.shape[:3]
    t = t.astype(F32).reshape((bsz, T // chunk, chunk, H) + t.shape[3:])
    return jnp.moveaxis(t, (1, 3), (0, 2))


def from_chunks(t):
    t = jnp.moveaxis(t, (0, 2), (1, 3))
    return t.reshape((t.shape[0], t.shape[1] * t.shape[2]) + t.shape[3:])


def gated_delta_chunked(q, k, v, log_decay, beta, state0):
    C = SCAN_CHUNK
    q = to_chunks(q, C) * (q.shape[-1] ** -0.5)
    k = to_chunks(k, C)
    v = to_chunks(v, C)
    beta = to_chunks(beta, C)
    g = jnp.cumsum(to_chunks(log_decay, C), axis=-1)
    incl = jnp.tril(jnp.ones((C, C), bool))
    strict = jnp.tril(jnp.ones((C, C), bool), -1)
    decay = jnp.exp(jnp.where(incl, g[..., :, None] - g[..., None, :], -jnp.inf))
    kb = k * beta[..., None]
    lower = jnp.where(strict, jnp.einsum('nbhid,nbhjd->nbhij', kb, k) * decay, 0.0)
    tmat = lower + jnp.eye(C, dtype=F32)
    solve = functools.partial(lax.linalg.triangular_solve, left_side=True, lower=True, unit_diagonal=True)
    u = solve(tmat, v * beta[..., None])
    w = solve(tmat, kb * jnp.exp(g)[..., None])
    attn = jnp.einsum('nbhid,nbhjd->nbhij', q, k) * decay
    g_last = g[..., -1]
    q_dec = q * jnp.exp(g)[..., None]
    k_dec = k * jnp.exp(g_last[..., None] - g)[..., None]

    def step(S, xs):
        u_n, w_n, q_n, k_n, a_n, gl_n = xs
        v_new = u_n - jnp.einsum('bhcd,bhde->bhce', w_n, S)
        o_n = jnp.einsum('bhcd,bhde->bhce', q_n, S) + jnp.einsum('bhij,bhje->bhie', a_n, v_new)
        S = S * jnp.exp(gl_n)[..., None, None] + jnp.einsum('bhcd,bhce->bhde', k_n, v_new)
        return S, o_n

    S, o = lax.scan(step, state0, (u, w, q_dec, k_dec, attn, g_last))
    return from_chunks(o), S


def gla_chunked(q, k, v, log_a, state0):
    C = SCAN_CHUNK
    q = to_chunks(q, C) * (q.shape[-1] ** -0.5)
    k = to_chunks(k, C)
    v = to_chunks(v, C)
    b = jnp.cumsum(to_chunks(log_a, C), axis=-2)
    b_last = b[..., -1:, :]
    k_out = k * jnp.exp(b_last - b)
    incl = jnp.tril(jnp.ones((C, C), bool))
    attn = jnp.where(incl, jnp.einsum('nbhid,nbhjd->nbhij', q * jnp.exp(b - b_last), k_out), 0.0)
    contrib = jnp.einsum('nbhcd,nbhce->nbhde', k_out, v)

    def step(S, xs):
        a, dS = xs
        return a[..., None] * S + dS, S

    S, S_start = lax.scan(step, state0, (jnp.exp(b_last[..., 0, :]), contrib))
    o = jnp.einsum('nbhij,nbhje->nbhie', attn, v) + jnp.einsum('nbhcd,nbhde->nbhce', q * jnp.exp(b), S_start)
    return from_chunks(o), S


def bidir_prefix_scan(scan_fn, ctx_dirs, lat_dirs, state0):
    o_ctx, o_lat = 0.0, 0.0
    for d in range(2):
        rev = (lambda t: jnp.flip(t, axis=1)) if d == 1 else (lambda t: t)
        oc, s_ctx = scan_fn(*[rev(t) for t in ctx_dirs[d]], state0)
        ol, _ = scan_fn(*[rev(t) for t in lat_dirs[d]], s_ctx)
        o_ctx = o_ctx + rev(oc)
        o_lat = o_lat + rev(ol)
    return o_ctx, o_lat


def gdn_mixer(pl, pc, conv_w, a_log, dt_bias, out_norm, with_ctx_out):
    hk = GDN_HEADS * GDN_DK

    def prep(pp):
        bsz, T = pp['gdn_qkv'].shape[:2]
        qkv = jax.nn.silu(dwconv_centred(pp['gdn_qkv'], conv_w))
        q, k, v = jnp.split(qkv, [hk, 2 * hk], axis=-1)
        q = l2_normalize(q.reshape(bsz, T, GDN_HEADS, GDN_DK))
        k = l2_normalize(k.reshape(bsz, T, GDN_HEADS, GDN_DK))
        v = v.reshape(bsz, T, GDN_HEADS, GDN_DV)
        beta = jax.nn.sigmoid(pp['gdn_beta'].astype(F32)).reshape(bsz, T, 2, GDN_HEADS)
        alpha = pp['gdn_alpha'].astype(F32).reshape(bsz, T, 2, GDN_HEADS)
        log_decay = -jnp.exp(a_log.astype(F32)) * jax.nn.softplus(alpha + dt_bias.astype(F32))
        return [(q, k, v, log_decay[:, :, d], beta[:, :, d]) for d in range(2)]

    bsz = pl['gdn_qkv'].shape[0]
    s0 = jnp.zeros((bsz, GDN_HEADS, GDN_DK, GDN_DV), F32)
    o_ctx, o_lat = bidir_prefix_scan(gated_delta_chunked, prep(pc), prep(pl), s0)

    def post(o, pp):
        bsz, T = o.shape[:2]
        gate = pp['gdn_gate'].reshape(bsz, T, GDN_HEADS, GDN_DV)
        y = rms_norm(o.astype(gate.dtype), out_norm) * jax.nn.silu(gate)
        return y.reshape(bsz, T, GDN_HEADS * GDN_DV)

    return post(o_lat, pl), (post(o_ctx, pc) if with_ctx_out else None)


def short_conv_mixer(pp, conv_w):
    return pp['sc_b'] * dwconv_centred(pp['sc_c'] * pp['sc_x'], conv_w)


def gla_mixer(pl, pc, gate_up, gate_bias, out_norm, with_ctx_out):
    def prep(pp):
        bsz, T = pp['gla_q'].shape[:2]
        q = pp['gla_q'].reshape(bsz, T, GLA_HEADS, GLA_DK)
        k = pp['gla_k'].reshape(bsz, T, GLA_HEADS, GLA_DK)
        v = pp['gla_v'].reshape(bsz, T, GLA_HEADS, GLA_DV)
        lowrank = pp['gla_lowrank'].reshape(bsz, T, 2, GLA_GATE_RANK)
        z = jnp.einsum('btnr,nrk->btnk', lowrank, gate_up) + gate_bias
        log_a = (jax.nn.log_sigmoid(z.astype(F32)) / GLA_TAU).reshape(bsz, T, 2, GLA_HEADS, GLA_DK)
        return [(q, k, v, log_a[:, :, d]) for d in range(2)]

    bsz = pl['gla_q'].shape[0]
    s0 = jnp.zeros((bsz, GLA_HEADS, GLA_DK, GLA_DV), F32)
    o_ctx, o_lat = bidir_prefix_scan(gla_chunked, prep(pc), prep(pl), s0)

    def post(o, pp):
        bsz, T = o.shape[:2]
        r = pp['gla_r'].reshape(bsz, T, GLA_HEADS, GLA_DV)
        y = rms_norm(o.astype(r.dtype), out_norm) * jax.nn.silu(r)
        return y.reshape(bsz, T, GLA_HEADS * GLA_DV)

    return post(o_lat, pl), (post(o_ctx, pc) if with_ctx_out else None)


def axial_rope(x, cos_r, sin_r, cos_c, sin_c):
    r1, r2, c1, c2 = jnp.split(x, 4, axis=-1)
    ex = lambda t: t[None, :, None, None, :].astype(x.dtype)
    cr, sr, cc, sc = ex(cos_r), ex(sin_r), ex(cos_c), ex(sin_c)
    return jnp.concatenate([r1 * cr - r2 * sr, r2 * cr + r1 * sr, c1 * cc - c2 * sc, c2 * cc + c1 * sc], axis=-1)


def diff_softmax_attend(q, k, v, lam):
    s = jnp.einsum('bqhcd,bkhcd->bhcqk', q, k).astype(F32) * (q.shape[-1] ** -0.5)
    p = jax.nn.softmax(s, axis=-1)
    w = p[:, :, 0] - lam * p[:, :, 1]
    return jnp.einsum('bhqk,bkhd->bqhd', w.astype(v.dtype), v)


def diff_mixer(pl, pc, rope, q_norm, k_norm, lam_params, out_norm, lam_init, with_ctx_out):
    bsz, S = pl['diff_q'].shape[:2]
    n_ctx = pc['diff_k'].shape[1]
    qk_shape = lambda T: (bsz, T, DIFF_HEADS, 2, DIFF_DK)
    q_lat = axial_rope(rms_norm(pl['diff_q'].reshape(qk_shape(S)), q_norm), *rope)
    k_lat = axial_rope(rms_norm(pl['diff_k'].reshape(qk_shape(S)), k_norm), *rope)
    k_ctx = rms_norm(pc['diff_k'].reshape(qk_shape(n_ctx)), k_norm)
    v_lat = pl['diff_v'].reshape(bsz, S, DIFF_HEADS, DIFF_DV)
    v_ctx = pc['diff_v'].reshape(bsz, n_ctx, DIFF_HEADS, DIFF_DV)
    lq1, lk1, lq2, lk2 = lam_params.astype(F32)
    lam = jnp.exp(jnp.sum(lq1 * lk1)) - jnp.exp(jnp.sum(lq2 * lk2)) + lam_init
    k_all = jnp.concatenate([k_ctx, k_lat], axis=1)
    v_all = jnp.concatenate([v_ctx, v_lat], axis=1)
    q_blocks = jnp.moveaxis(q_lat.reshape(bsz, S // Q_BLOCK, Q_BLOCK, DIFF_HEADS, 2, DIFF_DK), 1, 0)
    o_lat = lax.map(lambda qb: diff_softmax_attend(qb, k_all, v_all, lam), q_blocks)
    o_lat = jnp.moveaxis(o_lat, 0, 1).reshape(bsz, S, DIFF_HEADS, DIFF_DV)

    def post(o):
        y = rms_norm(o, out_norm) * (1.0 - lam_init)
        return y.reshape(o.shape[0], o.shape[1], DIFF_HEADS * DIFF_DV)

    if not with_ctx_out:
        return post(o_lat), None
    q_ctx = rms_norm(pc['diff_q'].reshape(qk_shape(n_ctx)), q_norm)
    return post(o_lat), post(diff_softmax_attend(q_ctx, k_ctx, v_ctx, lam))


def grouped_expert_ffn(h, expert_idx, weights, w1, w3, w2):
    N, D = h.shape
    K = expert_idx.shape[1]
    E = w1.shape[0]
    M = EXPERT_BLOCK
    A = N * K
    flat_e = expert_idx.reshape(-1)
    flat_t = jnp.arange(A, dtype=jnp.int32) // K
    flat_w = weights.reshape(-1)
    order = jnp.argsort(flat_e)
    e_s, t_s, w_s = flat_e[order], flat_t[order], flat_w[order]
    counts = jnp.bincount(flat_e, length=E)
    padded = (counts + M - 1) // M * M
    pad_end = jnp.cumsum(padded)
    pad_start = pad_end - padded
    start = jnp.cumsum(counts) - counts
    dest = pad_start[e_s] + (jnp.arange(A, dtype=jnp.int32) - start[e_s])
    n_blocks = -(-A // M) + E
    L = n_blocks * M
    slot_tok = jnp.full((L,), N, jnp.int32).at[dest].set(t_s)
    slot_w = jnp.zeros((L,), h.dtype).at[dest].set(w_s.astype(h.dtype))
    block_expert = jnp.minimum(jnp.searchsorted(pad_end, jnp.arange(n_blocks, dtype=jnp.int32) * M, side='right'), E - 1)
    h_pad = jnp.concatenate([h, jnp.zeros((1, D), h.dtype)], axis=0)

    def run_block(args):
        tok, e = args
        xb = h_pad[tok]
        return (jax.nn.silu(xb @ w1[e]) * (xb @ w3[e])) @ w2[e]

    y = lax.map(run_block, (slot_tok.reshape(n_blocks, M), block_expert))
    y = y.reshape(L, D) * slot_w[:, None]
    return jnp.zeros((N + 1, D), h.dtype).at[slot_tok].add(y)[:N]


def hier_moe(h, wg, bg, we, be, w1, w3, w2):
    bsz, T, D = h.shape
    hf = h.reshape(-1, D)
    N = hf.shape[0]
    g_prob = jax.nn.softmax((hf @ wg + bg).astype(F32), axis=-1)
    g_top_p, g_idx = lax.top_k(g_prob, 1)
    e_logits = (hf @ we + be).astype(F32).reshape(N, N_GROUPS, EXPERTS_PER_GROUP)
    e_in_group = e_logits[jnp.arange(N), g_idx[:, 0]]
    e_top_p, e_top_i = lax.top_k(jax.nn.softmax(e_in_group, axis=-1), TOP_K)
    e_top_p = e_top_p / jnp.sum(e_top_p, axis=-1, keepdims=True)
    weights = g_top_p * e_top_p
    expert_idx = g_idx * EXPERTS_PER_GROUP + e_top_i
    return grouped_expert_ffn(hf, expert_idx, weights, w1, w3, w2).reshape(bsz, T, D)


def setup_inputs(seed: int = 0) -> dict:
    key = jax.random.key(seed)
    ks = iter(jax.random.split(key, 40))

    def nrm(shape, scale):
        return jax.random.normal(next(ks), shape, F32) * scale

    def gain(shape):
        return 1.0 + nrm(shape, 0.01)

    L = DEPTH
    gdn_qkv_w = GDN_HEADS * (2 * GDN_DK + GDN_DV)
    dt = jnp.exp(jax.random.uniform(next(ks), (L, 2, GDN_HEADS), F32, math.log(1e-3), math.log(1e-1)))
    return {
        'x': nrm((BATCH, SEQ, D_MODEL), 1.0),
        'c': nrm((BATCH, D_MODEL), 1.0),
        'ctx': nrm((BATCH, CTX_LEN, D_MODEL), 1.0),
        'c_ctx': nrm((D_MODEL,), 1.0),
        'w_mod': nrm((L, D_MODEL, 6 * D_MODEL), 0.5 * D_MODEL ** -0.5),
        'b_mod': nrm((L, 6 * D_MODEL), 0.01),
        'norm1': gain((L, D_MODEL)),
        'norm2': gain((L, D_MODEL)),
        'w_in': nrm((L, D_MODEL, PROJ_WIDTH), D_MODEL ** -0.5),
        'w_out': nrm((L, D_MIX, D_MODEL), D_MIX ** -0.5),
        'gdn_conv': nrm((L, SHORT_CONV, gdn_qkv_w), SHORT_CONV ** -0.5),
        'gdn_a_log': jnp.log(jax.random.uniform(next(ks), (L, 2, GDN_HEADS), F32, 1.0, 16.0)),
        'gdn_dt_bias': dt + jnp.log(-jnp.expm1(-dt)),
        'gdn_out_norm': gain((L, GDN_DV)),
        'sc_conv': nrm((L, SHORT_CONV, SC_WIDTH), SHORT_CONV ** -0.5),
        'gla_gate_up': nrm((L, 2, GLA_GATE_RANK, GLA_HEADS * GLA_DK), GLA_GATE_RANK ** -0.5),
        'gla_gate_bias': nrm((L, 2, GLA_HEADS * GLA_DK), 0.01),
        'gla_out_norm': gain((L, GLA_DV)),
        'diff_q_norm': gain((L, DIFF_DK)),
        'diff_k_norm': gain((L, DIFF_DK)),
        'diff_lambda': nrm((L, 4, DIFF_DK), 0.1),
        'diff_out_norm': gain((L, DIFF_DV)),
        'router_group': nrm((L, D_MODEL, N_GROUPS), D_MODEL ** -0.5),
        'router_group_bias': nrm((L, N_GROUPS), 0.01),
        'router_expert': nrm((L, D_MODEL, N_EXPERTS), D_MODEL ** -0.5),
        'router_expert_bias': nrm((L, N_EXPERTS), 0.01),
        'expert_w1': nrm((L, N_EXPERTS, D_MODEL, D_EXPERT), D_MODEL ** -0.5),
        'expert_w3': nrm((L, N_EXPERTS, D_MODEL, D_EXPERT), D_MODEL ** -0.5),
        'expert_w2': nrm((L, N_EXPERTS, D_EXPERT, D_MODEL), D_EXPERT ** -0.5),
    }


def reference(x, c, ctx, c_ctx, w_mod, b_mod, norm1, norm2, w_in, w_out, gdn_conv, gdn_a_log,
              gdn_dt_bias, gdn_out_norm, sc_conv, gla_gate_up, gla_gate_bias, gla_out_norm,
              diff_q_norm, diff_k_norm, diff_lambda, diff_out_norm, router_group, router_group_bias,
              router_expert, router_expert_bias, expert_w1, expert_w3, expert_w2):
    bsz, S, _ = x.shape
    n_ctx = ctx.shape[1]
    rows = S // GRID_W
    pos = jnp.arange(rows * GRID_W, dtype=jnp.int32)
    row = (pos // GRID_W).astype(F32)
    col = (pos % GRID_W).astype(F32)
    inv_freq = ROPE_BASE ** (-jnp.arange(ROPE_PAIRS, dtype=F32) / ROPE_PAIRS)
    ang_r, ang_c = row[:, None] * inv_freq, col[:, None] * inv_freq
    rope = (jnp.cos(ang_r), jnp.sin(ang_r), jnp.cos(ang_c), jnp.sin(ang_c))

    x_ctx = ctx
    cond, cond_ctx = jax.nn.silu(c), jax.nn.silu(c_ctx)
    for l in range(DEPTH):
        with_ctx_out = l < DEPTH - 1
        lam_init = 0.8 - 0.6 * math.exp(-0.3 * l)
        m = jnp.split((cond @ w_mod[l] + b_mod[l])[:, None, :], 6, axis=-1)
        mc = jnp.split(cond_ctx @ w_mod[l] + b_mod[l], 6, axis=-1)

        h_lat = adaln(rms_norm(x, norm1[l]), m[0], m[1])
        h_ctx = adaln(rms_norm(x_ctx, norm1[l]), mc[0], mc[1])
        p_lat = split_proj(h_lat @ w_in[l])
        p_ctx = split_proj(h_ctx @ w_in[l])
        a_lat, a_ctx = gdn_mixer(p_lat, p_ctx, gdn_conv[l], gdn_a_log[l], gdn_dt_bias[l], gdn_out_norm[l], with_ctx_out)
        b_lat = short_conv_mixer(p_lat, sc_conv[l])
        g_lat, g_ctx = gla_mixer(p_lat, p_ctx, gla_gate_up[l], gla_gate_bias[l], gla_out_norm[l], with_ctx_out)
        d_lat, d_ctx = diff_mixer(p_lat, p_ctx, rope, diff_q_norm[l], diff_k_norm[l], diff_lambda[l],
                                  diff_out_norm[l], lam_init, with_ctx_out)
        x = x + m[2] * (jnp.concatenate([a_lat, b_lat, g_lat, d_lat], axis=-1) @ w_out[l])

        moe_w = (router_group[l], router_group_bias[l], router_expert[l], router_expert_bias[l],
                 expert_w1[l], expert_w3[l], expert_w2[l])
        h2_lat = adaln(rms_norm(x, norm2[l]), m[3], m[4])
        if with_ctx_out:
            b_ctx = short_conv_mixer(p_ctx, sc_conv[l])
            x_ctx = x_ctx + mc[2] * (jnp.concatenate([a_ctx, b_ctx, g_ctx, d_ctx], axis=-1) @ w_out[l])
            h2_ctx = adaln(rms_norm(x_ctx, norm2[l]), mc[3], mc[4])
            y = hier_moe(jnp.concatenate([h2_ctx, h2_lat], axis=1), *moe_w)
            x_ctx = x_ctx + mc[5] * y[:, :n_ctx]
            x = x + m[5] * y[:, n_ctx:]
        else:
            x = x + m[5] * hier_moe(h2_lat, *moe_w)
    return x
```

```cpp
#define MK_SINGLE 1
#include <hip/hip_runtime.h>
#include <cstdio>
#include <cstdint>

#ifndef GSCALE
#define GSCALE 1.0f
#endif
namespace pg8 {
#define PG8_LAS __attribute__((address_space(3)))
typedef unsigned short bf16_t;
typedef short bf16x8 __attribute__((ext_vector_type(8)));
typedef float f32x4 __attribute__((ext_vector_type(4)));
typedef unsigned u32x4 __attribute__((ext_vector_type(4)));
constexpr int BM = 256, BK = 64, HALF = 128, HTB = HALF * BK * 2  , STAGE_BYTES = 8 * HTB, NXCD = 8, WGM = 8;

__host__ __device__ __forceinline__ int lds_byte(int r, int c) { const int st = (r >> 4) * 2 + (c >> 5), rr = r & 15, cc = c & 31, ob = rr * 64 + cc * 2; return st * 1024 + (ob ^ (((ob >> 9) & 1) << 5)); }
__host__ __device__ __forceinline__ void stage_rc(int b, int& R, int& C) { const int st = b / 1024, sb = b % 1024, swz = sb ^ (((sb >> 9) & 1) << 5); R = (st >> 1) * 16 + swz / 64; C = (st & 1) * 32 + (swz % 64) / 2; }
__host__ __device__ __forceinline__ int perm32(int rho) { const int n = rho >> 4, i = rho & 15; return 8 * (i >> 2) + 4 * n + (i & 3); }

struct Unit { int pm, pn; size_t aoff, boff; };
struct Gemm { const bf16_t* A; const bf16_t* Bt; int M, N, K; };

struct StaticOrder {
    int nM, nN, nwg, G, c; size_t tstep;
    __host__ __device__ void init(int M, int N, int K, int G_, int c_) { nM = M / BM; nN = N / BM; nwg = nM * nN; G = G_; c = c_; tstep = (size_t)BM * K * 2; }
    __host__ __device__ bool next(int i, Unit& u) const {
        const long L = (long)i * G + c; if (L >= nwg) return false;
        int wgid = (int)L; { const int q = nwg / NXCD, r = nwg % NXCD, xcd = wgid % NXCD, off = wgid / NXCD; wgid = (xcd < r ? xcd * (q + 1) : r * (q + 1) + (xcd - r) * q) + off; }
        const int nig = WGM * nN, gid = wgid / nig, fm = gid * WGM, gsz = (nM - fm) < WGM ? (nM - fm) : WGM;
        u.pm = fm + ((wgid % nig) % gsz); u.pn = (wgid % nig) / gsz; u.aoff = (size_t)u.pm * tstep; u.boff = (size_t)u.pn * tstep; return true;
    }
    __device__ __forceinline__ void a_ready(const Unit&) const {}
    __device__ __forceinline__ void done(const Unit&) const {}
};

__device__ __forceinline__ unsigned cvt_pk_bf16(float lo, float hi) { unsigned r; asm volatile("v_cvt_pk_bf16_f32 %0, %1, %2" : "=v"(r) : "v"(lo), "v"(hi)); return r; }

struct EpiBf16 {
    static constexpr bool PERM = true, AFTER_DRAIN = false;
    bf16_t* O; int ldc;
    __device__ __forceinline__ void operator()(const f32x4 (&acc)[2][2][4][2], const Unit& u, int wr, int wc, int fr, int fq) const {
        const int row0 = u.pm * BM + wr * 64 + fr; const int col0 = u.pn * BM + wc * 32 + 8 * fq;
#pragma unroll
        for (int ai = 0; ai < 2; ++ai)
#pragma unroll
            for (int m = 0; m < 4; ++m) { bf16_t* rowp = O + (size_t)(row0 + ai * HALF + m * 16) * ldc + col0;
#pragma unroll
                for (int bj = 0; bj < 2; ++bj) { const f32x4 v0 = acc[ai][bj][m][0], v1 = acc[ai][bj][m][1];
                    u32x4 w; w.x = cvt_pk_bf16(v0[0], v0[1]); w.y = cvt_pk_bf16(v0[2], v0[3]); w.z = cvt_pk_bf16(v1[0], v1[1]); w.w = cvt_pk_bf16(v1[2], v1[3]);
                    *(u32x4*)(rowp + bj * HALF) = w; } }
    }
};
struct EpiSwiGLU {
    static constexpr bool PERM = true, AFTER_DRAIN = false;
    bf16_t* O; int ldc;
    __device__ __forceinline__ void operator()(const f32x4 (&acc)[2][2][4][2], const Unit& u, int wr, int wc, int fr, int fq) const {
        const int row0 = u.pm * BM + wr * 64 + fr; const int col0 = u.pn * HALF + wc * 32 + 8 * fq;
#pragma unroll
        for (int ai = 0; ai < 2; ++ai)
#pragma unroll
            for (int m = 0; m < 4; ++m) { bf16_t* rowp = O + (size_t)(row0 + ai * HALF + m * 16) * ldc + col0;
                float r[8];
#pragma unroll
                for (int n = 0; n < 2; ++n)
#pragma unroll
                    for (int j = 0; j < 4; ++j) { const float g = acc[ai][0][m][n][j], up = acc[ai][1][m][n][j]; r[n * 4 + j] = g * __builtin_amdgcn_rcpf(1.0f + __expf(-g)) * up; }
                u32x4 w; w.x = cvt_pk_bf16(r[0], r[1]); w.y = cvt_pk_bf16(r[2], r[3]); w.z = cvt_pk_bf16(r[4], r[5]); w.w = cvt_pk_bf16(r[6], r[7]);
                *(u32x4*)rowp = w; }
    }
};
struct EpiRouter {
    static constexpr bool PERM = false, AFTER_DRAIN = true;
    const float* bias_g; const float* bias_e; int* toke; float* tokw; unsigned* cnt; int row_base;
    __device__ __forceinline__ void fused(const f32x4 (&acc)[2][2][4][2], const Unit& u, int wr, int wc, int fr, int fq, PG8_LAS unsigned char* lds, int wid, int lane) const {
        PG8_LAS float* T = (PG8_LAS float*)lds;
        if (wc == 0 || (wc == 1 && fq == 0)) {
#pragma unroll
            for (int ai = 0; ai < 2; ++ai)
#pragma unroll
                for (int m = 0; m < 4; ++m) { const int row = ai * HALF + wr * 64 + m * 16 + fr;
#pragma unroll
                    for (int n = 0; n < 2; ++n) { if (wc == 1 && n == 1) continue; const int c0 = 32 * wc + 16 * n + 4 * fq;
#pragma unroll
                        for (int j = 0; j < 4; ++j) T[row * 37 + c0 + j] = acc[ai][0][m][n][j]; } }
        }
        asm volatile("s_waitcnt lgkmcnt(0)" ::: "memory"); __builtin_amdgcn_s_barrier(); asm volatile("" ::: "memory");
        const int row = wid * 64 + lane;
        if (row < 256) {
            float lg[4], e8[8];
#pragma unroll
            for (int q = 0; q < 4; ++q) lg[q] = T[row * 37 + q] + bias_g[q];
            int gi = 0; float gm = lg[0];
#pragma unroll
            for (int q = 1; q < 4; ++q) if (lg[q] > gm) { gm = lg[q]; gi = q; }
            float gs = 0.f;
#pragma unroll
            for (int q = 0; q < 4; ++q) gs += __expf(lg[q] - gm);
            const float gp = 1.0f / gs;
#pragma unroll
            for (int q = 0; q < 8; ++q) e8[q] = T[row * 37 + 4 + gi * 8 + q] + bias_e[gi * 8 + q];
            int i1 = 0; float m1 = e8[0];
#pragma unroll
            for (int q = 1; q < 8; ++q) if (e8[q] > m1) { m1 = e8[q]; i1 = q; }
            int i2 = -1; float m2 = -3.0e38f;
#pragma unroll
            for (int q = 0; q < 8; ++q) if (q != i1 && e8[q] > m2) { m2 = e8[q]; i2 = q; }
            const float a2 = __expf(m2 - m1), w1 = gp / (1.0f + a2), w2 = gp * a2 / (1.0f + a2);
            const int t = row_base + u.pm * BM + row, e1 = gi * 8 + i1, e2 = gi * 8 + i2;
            toke[t * 2] = e1; toke[t * 2 + 1] = e2; tokw[t * 2] = w1; tokw[t * 2 + 1] = w2;
            atomicAdd(cnt + e1, 1u); atomicAdd(cnt + e2, 1u);
        }
    }
};
struct EpiResid {
    static constexpr bool PERM = false, AFTER_DRAIN = false;
    const float* src_lat; float* dst_lat; const float* src_ctx; float* dst_ctx; const float* gate_lat; const float* gate_ctx; int nctx; int row_base;
    __device__ __forceinline__ void operator()(const f32x4 (&acc)[2][2][4][2], const Unit& u, int wr, int wc, int fr, int fq) const {
        const int row0 = row_base + u.pm * BM + wr * 64 + fr, col0 = u.pn * BM + wc * 32 + 4 * fq;
        const bool isctx = (row_base + u.pm * BM) < nctx;
        const float* gate = isctx ? gate_ctx : gate_lat;
        f32x4 gv[2][2];
#pragma unroll
        for (int bj = 0; bj < 2; ++bj)
#pragma unroll
            for (int n = 0; n < 2; ++n) gv[bj][n] = *(const f32x4*)(gate + col0 + bj * HALF + n * 16);
#pragma unroll
        for (int ai = 0; ai < 2; ++ai)
#pragma unroll
            for (int m = 0; m < 4; ++m) { const int r = row0 + ai * HALF + m * 16;
                const float* sp = isctx ? src_ctx + (size_t)r * 2048 : src_lat + (size_t)(r - nctx) * 2048;
                float* dp = isctx ? dst_ctx + (size_t)r * 2048 : dst_lat + (size_t)(r - nctx) * 2048;
#pragma unroll
                for (int bj = 0; bj < 2; ++bj)
#pragma unroll
                    for (int n = 0; n < 2; ++n) { const int c = col0 + bj * HALF + n * 16; const f32x4 s = *(const f32x4*)(sp + c); *(f32x4*)(dp + c) = s + gv[bj][n] * acc[ai][bj][m][n] * GSCALE; } }
    }
};
template <class Epi, class Sched, bool ALIGN_EPI = false, bool SP2 = false>
__device__ __forceinline__ void gemm_phase(PG8_LAS unsigned char* lds, const Gemm g, const Sched& S, const Epi& E, const int tid) {
    const int wid = __builtin_amdgcn_readfirstlane(tid >> 6), lane = tid & 63, wr = wid >> 2, wc = wid & 3, fr = lane & 15, fq = lane >> 4;
    const int K = g.K, nt = K / BK;
    unsigned voffA[2], voffB[2];
#pragma unroll
    for (int i = 0; i < 2; ++i) { int R, C; stage_rc(tid * 16 + i * 8192, R, C); const int Rb = Epi::PERM ? ((R & ~31) + perm32(R & 31)) : R;
        voffA[i] = (unsigned)(R * K + C) * 2u; voffB[i] = (unsigned)(Rb * K + C) * 2u; }
    const size_t kstep = (size_t)(BK * 2);
    const size_t hstep = (size_t)HALF * K * 2;
    const size_t tstep = 2 * hstep;
    const unsigned ldsw = (unsigned)wid * 1024u;
    const int aoff = lds_byte(wr * 64 + fr, fq * 8), boff = lds_byte(wc * 32 + fr, fq * 8);
#define PG8_SA(b, h) (((b) * 2 + (h)) * HTB)
#define PG8_SB(b, h) ((4 + (b) * 2 + (h)) * HTB)
#define PG8_STAGE(bufoff, gbase, voff) do { _Pragma("unroll") for (int _i = 0; _i < 2; ++_i) \
        __builtin_amdgcn_global_load_lds((const unsigned*)((const char*)(gbase) + (voff)[_i]), (PG8_LAS unsigned*)(lds + (bufoff) + ldsw + _i * 8192), 16, 0, 0); } while (0)
#define PG8_LDA(dst, b, h) do { _Pragma("unroll") for (int m = 0; m < 4; ++m) _Pragma("unroll") for (int k = 0; k < 2; ++k) dst[m][k] = *(const PG8_LAS bf16x8*)(lds + PG8_SA(b, h) + aoff + m * 2048 + k * 1024); } while (0)
#define PG8_LDB(dst, b, h) do { _Pragma("unroll") for (int n = 0; n < 2; ++n) _Pragma("unroll") for (int k = 0; k < 2; ++k) dst[n][k] = *(const PG8_LAS bf16x8*)(lds + PG8_SB(b, h) + boff + n * 2048 + k * 1024); } while (0)
#define PG8_MMA(ai, bj, At, Bt) do { __builtin_amdgcn_s_setprio(1); _Pragma("unroll") for (int m = 0; m < 4; ++m) _Pragma("unroll") for (int n = 0; n < 2; ++n) _Pragma("unroll") for (int k = 0; k < 2; ++k) \
        acc[ai][bj][m][n] = __builtin_amdgcn_mfma_f32_16x16x32_bf16(Bt[n][k], At[m][k], acc[ai][bj][m][n], 0, 0, 0); __builtin_amdgcn_s_setprio(0); } while (0)
#define PG8_WAIT_V(n) asm volatile("s_waitcnt vmcnt(" #n ")" ::: "memory")
#define PG8_WAIT_L(n) asm volatile("s_waitcnt lgkmcnt(" #n ")" ::: "memory")
#define PG8_BAR __builtin_amdgcn_s_barrier()
#define PG8_SCHED __builtin_amdgcn_sched_barrier(0)
    Unit cur, nxt; int ui = 0;
    if (!S.next(0, cur)) return;
    f32x4 acc[2][2][4][2];
    float zz_ = 0.f; asm volatile("" : "+v"(zz_));
#pragma unroll
    for (int a = 0; a < 2; ++a)
#pragma unroll
        for (int b = 0; b < 2; ++b)
#pragma unroll
            for (int m = 0; m < 4; ++m)
#pragma unroll
                for (int n = 0; n < 2; ++n) acc[a][b][m][n] = (f32x4){zz_, zz_, zz_, zz_};
    bf16x8 At[4][2], B0[2][2], B1[2][2];
    const char* cA = (const char*)g.A + cur.aoff; const char* cB = (const char*)g.Bt + cur.boff;
    S.a_ready(cur);
    if constexpr (SP2) {
        PG8_STAGE(PG8_SB(0, 0), cB, voffB); PG8_STAGE(PG8_SB(0, 1), cB + hstep, voffB); PG8_STAGE(PG8_SA(0, 0), cA, voffA); PG8_STAGE(PG8_SA(0, 1), cA + hstep, voffA);
        if (wr == 1) PG8_BAR;
        PG8_WAIT_V(2); PG8_BAR;
        PG8_STAGE(PG8_SB(1, 0), cB + kstep, voffB); PG8_STAGE(PG8_SA(1, 0), cA + kstep, voffA); PG8_STAGE(PG8_SB(1, 1), cB + hstep + kstep, voffB);
        PG8_WAIT_V(6); PG8_BAR;
    } else {
        PG8_STAGE(PG8_SB(0, 0), cB, voffB); PG8_STAGE(PG8_SA(0, 0), cA, voffA); PG8_STAGE(PG8_SB(0, 1), cB + hstep, voffB); PG8_STAGE(PG8_SA(0, 1), cA + hstep, voffA);
        if (wr == 1) PG8_BAR;
        PG8_WAIT_V(4); PG8_BAR;
        PG8_STAGE(PG8_SB(1, 0), cB + kstep, voffB); PG8_STAGE(PG8_SA(1, 0), cA + kstep, voffA); PG8_STAGE(PG8_SB(1, 1), cB + hstep + kstep, voffB);
        PG8_WAIT_V(6); PG8_BAR;
    }
    for (;;) {
        const bool has_next = S.next(ui + 1, nxt);
        const char* nA = has_next ? (const char*)g.A + nxt.aoff : cA; const char* nB = has_next ? (const char*)g.Bt + nxt.boff : cB;
        for (int t = 0; t < nt; t += 2) {
            const bool last = (t == nt - 2);
            const char* a1 = cA + (size_t)(t + 1) * kstep;
            const char* a2 = last ? nA : cA + (size_t)(t + 2) * kstep; const char* b2 = last ? nB : cB + (size_t)(t + 2) * kstep;
            const char* a3 = a2 + kstep; const char* b3 = b2 + kstep;
            if (last && has_next) S.a_ready(nxt);
            if constexpr (SP2) {
            PG8_LDB(B0, 0, 0); PG8_LDB(B1, 0, 1); PG8_SCHED; PG8_LDA(At, 0, 0); PG8_STAGE(PG8_SA(1, 1), a1 + hstep, voffA);
            PG8_WAIT_V(8); PG8_WAIT_L(0); PG8_BAR; PG8_MMA(0, 0, At, B0); PG8_MMA(0, 1, At, B1); PG8_BAR; PG8_SCHED;
            PG8_LDA(At, 0, 1); PG8_STAGE(PG8_SB(0, 0), b2, voffB); PG8_STAGE(PG8_SB(0, 1), b2 + hstep, voffB); PG8_STAGE(PG8_SA(0, 0), a2, voffA);
            PG8_WAIT_V(8); PG8_WAIT_L(0); PG8_BAR; PG8_MMA(1, 0, At, B0); PG8_MMA(1, 1, At, B1); PG8_BAR; PG8_SCHED;
            PG8_LDB(B0, 1, 0); PG8_LDB(B1, 1, 1); PG8_SCHED; PG8_LDA(At, 1, 0); PG8_STAGE(PG8_SA(0, 1), a2 + hstep, voffA);
            PG8_WAIT_V(8); PG8_WAIT_L(0); PG8_BAR; PG8_MMA(0, 0, At, B0); PG8_MMA(0, 1, At, B1); PG8_BAR; PG8_SCHED;
            PG8_LDA(At, 1, 1); PG8_STAGE(PG8_SB(1, 0), b3, voffB); PG8_STAGE(PG8_SB(1, 1), b3 + hstep, voffB); PG8_STAGE(PG8_SA(1, 0), a3, voffA);
            PG8_WAIT_V(8); PG8_WAIT_L(0); PG8_BAR; PG8_MMA(1, 0, At, B0); PG8_MMA(1, 1, At, B1); PG8_BAR; PG8_SCHED;
            } else {
            PG8_LDB(B0, 0, 0); PG8_SCHED; PG8_LDA(At, 0, 0); PG8_STAGE(PG8_SA(1, 1), a1 + hstep, voffA);
            PG8_WAIT_L(8); PG8_BAR; PG8_WAIT_L(0); PG8_MMA(0, 0, At, B0); PG8_BAR; PG8_SCHED;
            PG8_LDB(B1, 0, 1); PG8_STAGE(PG8_SB(0, 0), b2, voffB);
            PG8_BAR; PG8_WAIT_L(0); PG8_MMA(0, 1, At, B1); PG8_BAR;
            PG8_LDA(At, 0, 1); PG8_STAGE(PG8_SA(0, 0), a2, voffA);
            PG8_BAR; PG8_WAIT_L(0); PG8_MMA(1, 0, At, B0); PG8_BAR; PG8_SCHED;
            PG8_STAGE(PG8_SB(0, 1), b2 + hstep, voffB);
            PG8_WAIT_V(6); PG8_BAR; PG8_MMA(1, 1, At, B1); PG8_BAR;
            PG8_LDB(B0, 1, 0); PG8_SCHED; PG8_LDA(At, 1, 0); PG8_STAGE(PG8_SA(0, 1), a2 + hstep, voffA);
            PG8_WAIT_L(8); PG8_BAR; PG8_WAIT_L(0); PG8_MMA(0, 0, At, B0); PG8_BAR; PG8_SCHED;
            PG8_LDB(B1, 1, 1); PG8_STAGE(PG8_SB(1, 0), b3, voffB);
            PG8_BAR; PG8_WAIT_L(0); PG8_MMA(0, 1, At, B1); PG8_BAR;
            PG8_LDA(At, 1, 1); PG8_STAGE(PG8_SA(1, 0), a3, voffA);
            PG8_BAR; PG8_WAIT_L(0); PG8_MMA(1, 0, At, B0); PG8_BAR; PG8_SCHED;
            PG8_STAGE(PG8_SB(1, 1), b3 + hstep, voffB);
            PG8_WAIT_V(6); PG8_BAR; PG8_MMA(1, 1, At, B1); PG8_BAR;
            }
        }
        if constexpr (ALIGN_EPI) { if (wr == 0) PG8_BAR; }
        if constexpr (!Epi::AFTER_DRAIN) { E(acc, cur, wr, wc, fr, fq); S.done(cur); }
        if (!has_next) break;
#pragma unroll
        for (int a = 0; a < 2; ++a)
#pragma unroll
            for (int b = 0; b < 2; ++b)
#pragma unroll
                for (int m = 0; m < 4; ++m)
#pragma unroll
                    for (int n = 0; n < 2; ++n) acc[a][b][m][n] = (f32x4){zz_, zz_, zz_, zz_};
        cur = nxt; cA = nA; cB = nB; ++ui;
        if constexpr (ALIGN_EPI) { if (wr == 1) PG8_BAR; }
    }
    PG8_WAIT_V(0);
    if constexpr (!ALIGN_EPI) { if (wr == 0) PG8_BAR; }
    PG8_BAR;
    if constexpr (Epi::AFTER_DRAIN) { E.fused(acc, cur, wr, wc, fr, fq, lds, wid, lane); S.done(cur); }
#undef PG8_SA
#undef PG8_SB
#undef PG8_STAGE
#undef PG8_LDA
#undef PG8_LDB
#undef PG8_MMA
#undef PG8_WAIT_V
#undef PG8_WAIT_L
#undef PG8_BAR
#undef PG8_SCHED
}
}


constexpr int NWAVES = 8, NTHR = 512;
constexpr int DM = 2048, SEQ = 16384, NCTX = 256, NTOK = SEQ + NCTX, PW = 6720, PWP = 6912, NEXP = 32;
constexpr int C_GQKV = 0, C_GGATE = 1536, C_GBETA = 2048, C_GALPHA = 2064, C_SCB = 2080, C_SCC = 2592, C_SCX = 3104, C_LQ = 3616, C_LK = 3872, C_LV = 4128, C_LR = 4640,
              C_LLR = 5152, C_DQ = 5184, C_DK = 5696, C_DV = 6208;
constexpr int MAXSLOT = 41472;
constexpr float NEPS = 1e-6f;
enum { I_X = 0, I_C, I_CTX, I_CCTX, I_WMOD, I_BMOD, I_NORM1, I_NORM2, I_WIN, I_WOUT, I_GCONV, I_GALOG, I_GDT, I_GONORM, I_SCCONV, I_LGUP, I_LGBIAS, I_LONORM,
       I_DQN, I_DKN, I_DLAM, I_DON, I_RG, I_RGB, I_RE, I_REB, I_W1, I_W3, I_W2, N_IN };

constexpr size_t MiB = 1u << 20;
constexpr size_t WS_CTL = 0, CTL_ZERO_BYTES = 1 * MiB;
constexpr int CW_BAR = 4096;
constexpr int CW_CNT = 8192, CW_CUR = 8192 + 128;
constexpr size_t CTL_MODV = 256 * 1024;
constexpr size_t WS_SMALL = 1 * MiB;
constexpr size_t SM_ROPER = 0, SM_ROPEC = 32768, SM_LAM = 32768 + 8192;
constexpr size_t WS_MODP = 930 * MiB;
constexpr size_t WS_XCTX = 2 * MiB;
constexpr size_t WS_TOKE = 4 * MiB, WS_TOKW = WS_TOKE + 160 * 1024, WS_TOKS = WS_TOKW + 160 * 1024;
constexpr size_t WS_GBETA = 5 * MiB, WS_GDEC = WS_GBETA + 1280 * 1024;
constexpr size_t WS_WIN = 8 * MiB, WS_WOUT = 35 * MiB, WS_WUP = 43 * MiB, WS_WDN = 171 * MiB;
constexpr size_t WS_HBUF = 235 * MiB, WS_P = 300 * MiB, WS_MIX = 520 * MiB;
constexpr size_t WS_QR = 585 * MiB, WS_KR = 602 * MiB, WS_VT = 619 * MiB;
constexpr size_t WS_GQ = 636 * MiB, WS_GK = 669 * MiB, WS_GV = 702 * MiB, WS_LOGA = 735 * MiB;
constexpr size_t WS_OGDN = 768 * MiB, WS_OGLA = 833 * MiB, WS_PARK = 898 * MiB;
constexpr size_t WS_GQP = WS_OGDN, WS_GOP = WS_OGLA; constexpr size_t WS_GST = WS_GQP + 65 * MiB / 2; constexpr size_t WS_GLS = WS_GOP + 65 * MiB / 2;
constexpr size_t WS_GA = 936 * MiB, WS_GB = 1001 * MiB, WS_OL = 1066 * MiB;
constexpr size_t WS_DS = WS_HBUF;
constexpr size_t WS_GQB = 1131 * MiB, WS_ACH = 1164 * MiB, WS_EGL = 1164 * MiB + 640 * 1024, WS_WR = 1165 * MiB  , WS_END = 1166 * MiB;
constexpr size_t WS_AMOE = WS_P, WS_HMOE = WS_P + 162 * MiB;
static_assert(WS_HMOE + (size_t)MAXSLOT * 512 * 2 <= WS_MIX, "moe overlay");
#ifdef Y_SEPARATE
constexpr size_t WS_YMOE = WS_MIX;
#else
constexpr size_t WS_YMOE = WS_AMOE;
#endif

constexpr int RING_BYTES = 131072, LDSCTL_OFF = RING_BYTES, MISC_OFF = LDSCTL_OFF + 320, TILE_TAB_OFF = LDSCTL_OFF + 1024, LDS_BYTES = 147456;

#define GAS __attribute__((address_space(1)))
#define LAS __attribute__((address_space(3)))
typedef unsigned short bf16;
typedef unsigned v4u __attribute__((ext_vector_type(4)));
typedef float f32x4 __attribute__((ext_vector_type(4)));
typedef float f32x16 __attribute__((ext_vector_type(16)));
typedef short bf16x8 __attribute__((ext_vector_type(8)));
#define LDS_WAIT() asm volatile("s_waitcnt lgkmcnt(0)" ::: "memory")
#define VM_WAIT() asm volatile("s_waitcnt vmcnt(0)" ::: "memory")
__device__ __forceinline__ unsigned f2bf(float f) { unsigned u = __builtin_bit_cast(unsigned, f); return (u + 0x7fffu + ((u >> 16) & 1u)) >> 16; }
__device__ __forceinline__ unsigned pk2(float lo, float hi) { return f2bf(lo) | (f2bf(hi) << 16); }
__device__ __forceinline__ float bf2f(unsigned short b) { return __builtin_bit_cast(float, (unsigned)b << 16); }
__device__ __forceinline__ void unpack8(const v4u v, float (&f)[8]) {
#pragma unroll
    for (int i = 0; i < 4; ++i) { f[2 * i] = __builtin_bit_cast(float, v[i] << 16); f[2 * i + 1] = __builtin_bit_cast(float, v[i] & 0xffff0000u); }
}
__device__ __forceinline__ void load8(const bf16* p, float (&f)[8]) { unpack8(*(const v4u*)p, f); }
__device__ __forceinline__ v4u pack8(const float (&f)[8]) { v4u w; w.x = pk2(f[0], f[1]); w.y = pk2(f[2], f[3]); w.z = pk2(f[4], f[5]); w.w = pk2(f[6], f[7]); return w; }
__device__ __forceinline__ float siluf(float x) { return x / (1.0f + __expf(-x)); }
__device__ __forceinline__ float sigmoidf_(float x) { return 1.0f / (1.0f + __expf(-x)); }
__device__ __forceinline__ float softplusf_(float x) { return fmaxf(x, 0.f) + __logf(1.0f + __expf(-fabsf(x))); }
__device__ __forceinline__ float wave_sum(float v) {
#pragma unroll
    for (int o = 1; o < 64; o <<= 1) v += __shfl_xor(v, o);
    return v;
}

#define XB_TMO      128
#define XB_XCNT(j)  (256  + 64 * (j))
#define XB_XSUB(j)  (1280 + 64 * (j))
#define XB_XGEN(j)  (2304 + 64 * (j))
#define XB_TOP      3328
#define XB_TOPGEN   3392
#define XCD_BAR_WORDS 3456
#define XB_SPIN_CAP (1u << 18)
__device__ __forceinline__ unsigned xb_ld(unsigned* p)              { return __hip_atomic_load(p, __ATOMIC_RELAXED, __HIP_MEMORY_SCOPE_AGENT); }
__device__ __forceinline__ unsigned xb_add(unsigned* p, unsigned v) { return __hip_atomic_fetch_add(p, v, __ATOMIC_RELAXED, __HIP_MEMORY_SCOPE_AGENT); }
__device__ __forceinline__ unsigned xb_xcc_id() { return (unsigned)__builtin_amdgcn_s_getreg((3 << 11) | 20) & 0xFu; }
#define XB_SPIN(cond, bar) do { unsigned _sp = 0; while (cond) { __builtin_amdgcn_s_sleep(1); \
    if ((++_sp & 255u) == 0u) { if (xb_ld(&(bar)[XB_TMO])) break; if (_sp > XB_SPIN_CAP) { atomicAdd(&(bar)[XB_TMO], 1u); break; } } } } while (0)
struct XcdBarrier { unsigned* bar; unsigned x; volatile LAS unsigned* st; };
__device__ __forceinline__ XcdBarrier xcd_barrier_post(unsigned* bar, volatile LAS unsigned* st) {
    XcdBarrier b; b.bar = bar; b.x = xb_xcc_id(); b.st = st;
    if (threadIdx.x == 0) (void)xb_add(&bar[XB_XCNT(b.x)], 1u);
    return b;
}
__device__ __forceinline__ unsigned long long xcd_barrier_complete(unsigned* bar, unsigned x) {
    const unsigned G = gridDim.x * gridDim.y * gridDim.z;
    unsigned sum, cnt, mine, sp = 0u;
    for (;;) {
        sum = 0u; cnt = 0u; mine = 0u;
#pragma unroll
        for (unsigned j = 0; j < 16; ++j) { const unsigned c = xb_ld(&bar[XB_XCNT(j)]); sum += c; cnt += (c > 0u) ? 1u : 0u; mine = (j == x) ? c : mine; }
        if (sum == G) break;
        __builtin_amdgcn_s_sleep(1);
        if ((++sp & 255u) == 0u) { if (xb_ld(&bar[XB_TMO])) break; if (sp > XB_SPIN_CAP) { atomicAdd(&bar[XB_TMO], 1u); break; } }
    }
    const unsigned nloc = mine > 0u ? mine : 1u, nx = cnt > 0u ? cnt : 1u;
    return ((unsigned long long)nx << 32) | nloc;
}
__device__ __forceinline__ void xcd_barrier(const XcdBarrier& b) {
    asm volatile("s_waitcnt vmcnt(0)" ::: "memory");
    __syncthreads();
    if (threadIdx.x == 0) {
        unsigned* bar = b.bar;
        __builtin_amdgcn_s_waitcnt(0);
        unsigned nloc = b.st[0], nx = b.st[1];
        if (nloc == 0u) { const unsigned long long r_ = xcd_barrier_complete(bar, b.x); nloc = (unsigned)r_; nx = (unsigned)(r_ >> 32); b.st[0] = nloc; b.st[1] = nx; }
        const unsigned old = xb_add(&bar[XB_XSUB(b.x)], 1u);
        const unsigned gen = old / nloc;
        if (old + 1u == (gen + 1u) * nloc) {
            __builtin_amdgcn_fence(__ATOMIC_RELEASE, "agent");
            asm volatile("s_waitcnt vmcnt(0)" ::: "memory");
            const unsigned og = xb_add(&bar[XB_TOP], 1u);
            const unsigned tg = og / nx;
            if (og + 1u == (tg + 1u) * nx) xb_add(&bar[XB_TOPGEN], 1u);
            else XB_SPIN(xb_ld(&bar[XB_TOPGEN]) == tg, bar);
            __builtin_amdgcn_fence(__ATOMIC_ACQUIRE, "agent");
            xb_add(&bar[XB_XGEN(b.x)], 1u);
            asm volatile("s_waitcnt vmcnt(0)" ::: "memory");
        } else {
            XB_SPIN(xb_ld(&bar[XB_XGEN(b.x)]) == gen, bar);
            __builtin_amdgcn_fence(__ATOMIC_ACQUIRE, "agent");
            asm volatile("s_waitcnt vmcnt(0)" ::: "memory");
        }
    }
    __syncthreads();
}

struct Args { const float* in[N_IN]; float* out; unsigned char* ws; int ph_lo, ph_hi, rep, pad; };
typedef const __attribute__((address_space(4))) Args* CArgsP;
struct InProxy { CArgsP p; __device__ __forceinline__ const float* operator[](int i) const { return p->in[i]; } };
struct ArgView { InProxy in; };
struct Frame {
    LAS unsigned char* lds;
    unsigned char* ws; unsigned* ctl;
    float* out;
    int tid, lane, wave, G, bid;
};
__device__ __forceinline__ float* modv_ptr(const Frame& F, int l, int which  ) { return (float*)(F.ws + WS_CTL + CTL_MODV) + (size_t)(l * 2 + which) * 12288; }

__device__ __forceinline__ void ph_prologue(const Frame& F, const ArgView& A) {
    const float* cvec = A.in[I_C]; const float* cctx = A.in[I_CCTX];
    for (int item = F.bid; item < 768; item += F.G) {
        const int l = item / 384, rem = item % 384, cc = rem / 32, ks = rem % 32, col = cc * 1024 + F.tid * 2;
        const float* W = A.in[I_WMOD] + (size_t)l * 2048 * 12288;
        float a0 = 0.f, a1 = 0.f, b0 = 0.f, b1 = 0.f;
#pragma unroll 16
        for (int i = ks * 64; i < ks * 64 + 64; ++i) {
            const float sl = siluf(cvec[i]), sx = siluf(cctx[i]);
            const float2 w = *(const float2*)(W + (size_t)i * 12288 + col);
            a0 += sl * w.x; a1 += sl * w.y; b0 += sx * w.x; b1 += sx * w.y;
        }
        float* pl = (float*)(F.ws + WS_MODP) + ((size_t)((l * 32 + ks) * 2 + 0)) * 12288 + col; float* pc = pl + 12288;
        *(float2*)pl = make_float2(a0, a1); *(float2*)pc = make_float2(b0, b1);
    }
    float* small = (float*)(F.ws + WS_SMALL);
    for (int i = F.bid * NTHR + F.tid; i < 320 * 16; i += F.G * NTHR) {
        const int pos = i / 16, fi = i % 16; const float inv = powf(10000.f, -(float)fi / 16.f);
        const float ang = (float)(pos < 256 ? pos : pos - 256) * inv;
        float* dst = pos < 256 ? small + SM_ROPER / 4 + (pos * 16 + fi) * 2 : small + SM_ROPEC / 4 + ((pos - 256) * 16 + fi) * 2;
        dst[0] = cosf(ang); dst[1] = sinf(ang);
    }
    if (F.bid == 0 && F.wave == 0) {
#pragma unroll
        for (int l = 0; l < 2; ++l) {
            const float* lp = A.in[I_DLAM] + l * 256;
            const float s1 = wave_sum(lp[F.lane] * lp[64 + F.lane]), s2 = wave_sum(lp[128 + F.lane] * lp[192 + F.lane]);
            const float lam_init = 0.8f - 0.6f * expf(-0.3f * (float)l);
            if (F.lane == 0) small[SM_LAM / 4 + l] = expf(s1) - expf(s2) + lam_init;
        }
    }
}

__device__ __forceinline__ void transpose_item(const float* W, int K, int N, bf16* WT, int k0, int n0, int drow0, LAS float* scr, int lane) {
#pragma unroll 8
    for (int i = 0; i < 32; ++i) { const int kk = 2 * i + (lane >> 5); scr[kk * 33 + (lane & 31)] = W[(size_t)(k0 + kk) * N + n0 + (lane & 31)]; }
    LDS_WAIT(); asm volatile("" ::: "memory");
    const int c = lane & 7;
#pragma unroll
    for (int j = 0; j < 4; ++j) { const int n = (lane >> 3) + 8 * j; const LAS float* s = scr + (8 * c) * 33 + n;
        v4u o; o.x = pk2(s[0 * 33], s[1 * 33]); o.y = pk2(s[2 * 33], s[3 * 33]); o.z = pk2(s[4 * 33], s[5 * 33]); o.w = pk2(s[6 * 33], s[7 * 33]);
        *(v4u*)(WT + (size_t)(drow0 + n) * K + k0 + 8 * c) = o; }
    LDS_WAIT(); asm volatile("" ::: "memory");
}
__device__ __forceinline__ void ph_convert(const Frame& F, const ArgView& A, int l) {
    LAS float* scr = (LAS float*)(F.lds + F.wave * 16384);
    const int gw = F.bid * NWAVES + F.wave, NGW = F.G * NWAVES;
    constexpr int I_IN = 32 * 210, I_OUT = 32 * 64, I_E13 = 32 * 16, I_E2 = 8 * 64;
    constexpr int NITEMS = I_IN + I_OUT + NEXP * (2 * I_E13 + I_E2);
    bf16* win = (bf16*)(F.ws + WS_WIN); bf16* wout = (bf16*)(F.ws + WS_WOUT); bf16* wup = (bf16*)(F.ws + WS_WUP); bf16* wdn = (bf16*)(F.ws + WS_WDN);
    for (int it = gw; it < NITEMS; it += NGW) {
        int r = it;
        if (r < I_IN) { const int kb = r / 210, nb = r % 210; transpose_item(A.in[I_WIN] + (size_t)l * 2048 * PW, 2048, PW, win, 64 * kb, 32 * nb, 32 * nb, scr, F.lane); continue; } r -= I_IN;
        if (r < I_OUT) { const int kb = r / 64, nb = r % 64; transpose_item(A.in[I_WOUT] + (size_t)l * 2048 * 2048, 2048, 2048, wout, 64 * kb, 32 * nb, 32 * nb, scr, F.lane); continue; } r -= I_OUT;
        const int e = r / (2 * I_E13 + I_E2); r %= (2 * I_E13 + I_E2);
        if (r < 2 * I_E13) { const int w3 = r / I_E13, q = r % I_E13, kb = q / 16, nb = q % 16, n0 = 32 * nb;
            const float* W = (w3 ? A.in[I_W3] : A.in[I_W1]) + ((size_t)l * NEXP + e) * 2048 * 512;
            transpose_item(W, 2048, 512, wup + (size_t)e * 1024 * 2048, 64 * kb, n0, (n0 / 128) * 256 + (n0 % 128) + (w3 ? 128 : 0), scr, F.lane); continue; }
        r -= 2 * I_E13;
        { const int kb = r / 64, nb = r % 64; const float* W = A.in[I_W2] + ((size_t)l * NEXP + e) * 512 * 2048;
          transpose_item(W, 512, 2048, wdn + (size_t)e * 2048 * 512, 64 * kb, 32 * nb, 32 * nb, scr, F.lane); }
    }
    if (l == 0) {
        for (int i = F.bid * NTHR + F.tid; i < 2 * 2 * 12288; i += F.G * NTHR) { const int ll = i / (2 * 12288), which = (i / 12288) & 1, col = i % 12288;
            float sacc = A.in[I_BMOD][ll * 12288 + col];
            for (int ks = 0; ks < 32; ++ks) sacc += ((const float*)(F.ws + WS_MODP))[((size_t)((ll * 32 + ks) * 2 + which)) * 12288 + col];
            modv_ptr(F, ll, which)[col] = sacc; }
    }
    {
        bf16* wr = (bf16*)(F.ws + WS_WR); const float* rg = A.in[I_RG] + (size_t)l * 2048 * 4; const float* re = A.in[I_RE] + (size_t)l * 2048 * 32;
        for (int i = F.bid * NTHR + F.tid; i < 256 * 2048; i += F.G * NTHR) { const int n = i >> 11, k = i & 2047;
            const float v = n < 4 ? rg[k * 4 + n] : (n < 36 ? re[k * 32 + (n - 4)] : 0.f); wr[i] = (bf16)f2bf(v); }
    }
    unsigned zu_ = 0u; asm volatile("" : "+v"(zu_));
    v4u* z = (v4u*)(win + (size_t)PW * 2048);
    for (int i = F.bid * NTHR + F.tid; i < (PWP - PW) * 2048 / 8; i += F.G * NTHR) z[i] = (v4u){zu_, zu_, zu_, zu_};
}

template <int WHICH>
__device__ __forceinline__ void ph_norm(const Frame& F, const ArgView& A, int l, const float* xlat, const float* xctx, int row_lo) {
    const int gw = F.bid * NWAVES + F.wave, NGW = F.G * NWAVES;
    const float* gain = A.in[WHICH == 0 ? I_NORM1 : I_NORM2] + l * 2048;
    bf16* hb = (bf16*)(F.ws + WS_HBUF);
    unsigned* cnt = F.ctl + CW_CNT + 64 * l;
    int* toke = (int*)(F.ws + WS_TOKE); float* tokw = (float*)(F.ws + WS_TOKW);
    const float* rg = A.in[I_RG] + (size_t)l * 2048 * 4; const float* re = A.in[I_RE] + (size_t)l * 2048 * 32;
    for (int r = row_lo + gw; r < NTOK; r += NGW) {
        const bool isctx = r < NCTX;
        const float* xr = isctx ? xctx + (size_t)r * 2048 : xlat + (size_t)(r - NCTX) * 2048;
        const float* mod = modv_ptr(F, l, isctx ? 1 : 0);
        const float* shift = mod + (WHICH == 0 ? 0 : 3) * 2048; const float* scale = mod + (WHICH == 0 ? 1 : 4) * 2048;
        f32x4 v[8]; float ss = 0.f;
#pragma unroll
        for (int j = 0; j < 8; ++j) { v[j] = *(const f32x4*)(xr + 4 * F.lane + 256 * j); ss += (v[j].x * v[j].x + v[j].y * v[j].y) + (v[j].z * v[j].z + v[j].w * v[j].w); }
        const float rs = 1.0f / sqrtf(wave_sum(ss) * (1.f / 2048.f) + NEPS);
#pragma unroll
        for (int j = 0; j < 8; ++j) { const int c = 4 * F.lane + 256 * j;
            const f32x4 g = *(const f32x4*)(gain + c), sh = *(const f32x4*)(shift + c), sc = *(const f32x4*)(scale + c);
            v[j] = (v[j] * rs * g) * (sc + 1.0f) + sh;
            uint2 o; o.x = pk2(v[j].x, v[j].y); o.y = pk2(v[j].z, v[j].w);
            *(uint2*)(hb + (size_t)r * 2048 + c) = o; }
    }
}

__device__ __forceinline__ void ph_prep(const Frame& F, const ArgView& A, int l) {
    const int gw = F.bid * NWAVES + F.wave, NGW = F.G * NWAVES, lane = F.lane;
    const bf16* P = (const bf16*)(F.ws + WS_P);
    bf16* mix = (bf16*)(F.ws + WS_MIX);
    float* GQ = (float*)(F.ws + WS_GQ); float* GK = (float*)(F.ws + WS_GK); float* GV = (float*)(F.ws + WS_GV);
    float* GBETA = (float*)(F.ws + WS_GBETA); float* GDEC = (float*)(F.ws + WS_GDEC); float* LOGA = (float*)(F.ws + WS_LOGA);
    bf16* QR = (bf16*)(F.ws + WS_QR); bf16* KR = (bf16*)(F.ws + WS_KR);
    const float* small = (const float*)(F.ws + WS_SMALL);
    const float* scw = A.in[I_SCCONV] + l * 3 * 512; const float* gcw = A.in[I_GCONV] + l * 3 * 1536;
    const float* gup = A.in[I_LGUP] + l * 2 * 16 * 256; const float* gbias = A.in[I_LGBIAS] + l * 512;
    for (int r = gw; r < NTOK; r += NGW) {
        const bf16* pr = P + (size_t)r * PWP;
        const int seg_lo = r < NCTX ? 0 : NCTX, seg_hi = r < NCTX ? NCTX : NTOK;
        const bool hp = r > seg_lo, hn = r + 1 < seg_hi;
        const bf16* pm = hp ? pr - PWP : pr; const bf16* pn = hn ? pr + PWP : pr;
        { const int col = 8 * lane; float c0[8], x0[8], cm[8], xm[8], cn[8], xn[8], b[8], w0[8], w1[8], w2[8], y[8];
          load8(pr + C_SCC + col, c0); load8(pr + C_SCX + col, x0); load8(pr + C_SCB + col, b);
          load8(pm + C_SCC + col, cm); load8(pm + C_SCX + col, xm); load8(pn + C_SCC + col, cn); load8(pn + C_SCX + col, xn);
#pragma unroll
          for (int j = 0; j < 8; ++j) { w0[j] = scw[col + j]; w1[j] = scw[512 + col + j]; w2[j] = scw[1024 + col + j]; }
#pragma unroll
          for (int j = 0; j < 8; ++j) { const float um = hp ? cm[j] * xm[j] : 0.f, un = hn ? cn[j] * xn[j] : 0.f; y[j] = b[j] * (w0[j] * um + w1[j] * (c0[j] * x0[j]) + w2[j] * un); }
          *(v4u*)(mix + (size_t)r * 2048 + 512 + col) = pack8(y); }
    }
    asm volatile("" ::: "memory");
    for (int r = gw; r < NTOK; r += NGW) {
        const bf16* pr = P + (size_t)r * PWP;
        const int seg_lo = r < NCTX ? 0 : NCTX, seg_hi = r < NCTX ? NCTX : NTOK;
        const bool hp = r > seg_lo, hn = r + 1 < seg_hi;
        const bf16* pm = hp ? pr - PWP : pr; const bf16* pn = hn ? pr + PWP : pr;
#pragma unroll 1
        for (int part = 0; part < 3; ++part) { __builtin_amdgcn_sched_barrier(0); const int col = part * 512 + 8 * lane; float x0[8], xm[8], xn[8], y[8];
          load8(pr + C_GQKV + col, x0); load8(pm + C_GQKV + col, xm); load8(pn + C_GQKV + col, xn);
          float ss = 0.f;
#pragma unroll
          for (int j = 0; j < 8; ++j) { const float a = gcw[col + j] * (hp ? xm[j] : 0.f) + gcw[1536 + col + j] * x0[j] + gcw[3072 + col + j] * (hn ? xn[j] : 0.f); y[j] = siluf(a); ss += y[j] * y[j]; }
          if (part < 2) { ss += __shfl_xor(ss, 1); ss += __shfl_xor(ss, 2); ss += __shfl_xor(ss, 4); const float rs = 1.0f / sqrtf(ss + NEPS);
#pragma unroll
            for (int j = 0; j < 8; ++j) y[j] *= rs; }
          float* dst = (part == 0 ? GQ : part == 1 ? GK : GV) + (size_t)r * 512 + 8 * lane;
          *(f32x4*)dst = (f32x4){y[0], y[1], y[2], y[3]}; *(f32x4*)(dst + 4) = (f32x4){y[4], y[5], y[6], y[7]}; }
        if (lane < 16) { const float be = sigmoidf_(bf2f(pr[C_GBETA + lane])), al = bf2f(pr[C_GALPHA + lane]);
          const float g = -expf(A.in[I_GALOG][l * 16 + lane]) * softplusf_(al + A.in[I_GDT][l * 16 + lane]);
          GBETA[r * 16 + lane] = be; GDEC[r * 16 + lane] = g; }
    }
    asm volatile("" ::: "memory");
    for (int r = gw; r < NTOK; r += NGW) {
        const bf16* pr = P + (size_t)r * PWP;
        const int seg_lo = r < NCTX ? 0 : NCTX, seg_hi = r < NCTX ? NCTX : NTOK;
        const bool hp = r > seg_lo, hn = r + 1 < seg_hi;
        const bf16* pm = hp ? pr - PWP : pr; const bf16* pn = hn ? pr + PWP : pr;
        { const int dir = lane >> 5, c = (8 * lane) & 255; float lr[16];
          { float t0[8], t1[8]; load8(pr + C_LLR + dir * 16, t0); load8(pr + C_LLR + dir * 16 + 8, t1);
#pragma unroll
            for (int j = 0; j < 8; ++j) { lr[j] = t0[j]; lr[8 + j] = t1[j]; } }
          float z[8];
#pragma unroll
          for (int j = 0; j < 8; ++j) z[j] = gbias[dir * 256 + c + j];
#pragma unroll
          for (int q = 0; q < 16; ++q) { const float* gp = gup + (dir * 16 + q) * 256 + c; const f32x4 g0 = *(const f32x4*)gp, g1 = *(const f32x4*)(gp + 4);
            z[0] += lr[q] * g0.x; z[1] += lr[q] * g0.y; z[2] += lr[q] * g0.z; z[3] += lr[q] * g0.w; z[4] += lr[q] * g1.x; z[5] += lr[q] * g1.y; z[6] += lr[q] * g1.z; z[7] += lr[q] * g1.w; }
#pragma unroll
          for (int j = 0; j < 8; ++j) z[j] = -(softplusf_(-z[j])) * (1.0f / 16.0f);
          float* dst = LOGA + (size_t)r * 512 + 8 * lane;
          *(f32x4*)dst = (f32x4){z[0], z[1], z[2], z[3]}; *(f32x4*)(dst + 4) = (f32x4){z[4], z[5], z[6], z[7]}; }
    }
    asm volatile("" ::: "memory");
    for (int r = gw; r < NTOK; r += NGW) {
        const bf16* pr = P + (size_t)r * PWP;
        const int seg_lo = r < NCTX ? 0 : NCTX, seg_hi = r < NCTX ? NCTX : NTOK;
        const bool hp = r > seg_lo, hn = r + 1 < seg_hi;
        const bf16* pm = hp ? pr - PWP : pr; const bf16* pn = hn ? pr + PWP : pr;
#pragma unroll 1
        for (int which = 0; which < 2; ++which) { __builtin_amdgcn_sched_barrier(0); float x[8]; load8(pr + (which == 0 ? C_DQ : C_DK) + 8 * lane, x);
          float ss = 0.f;
#pragma unroll
          for (int j = 0; j < 8; ++j) ss += x[j] * x[j];
          ss += __shfl_xor(ss, 1); ss += __shfl_xor(ss, 2); ss += __shfl_xor(ss, 4);
          const float rs = 1.0f / sqrtf(ss * (1.f / 64.f) + NEPS); const int sub = lane & 7;
          const float* gn = A.in[which == 0 ? I_DQN : I_DKN] + l * 64 + 8 * sub;
#pragma unroll
          for (int j = 0; j < 8; ++j) x[j] = x[j] * rs * gn[j];
          if (r >= NCTX) { const int pos = r - NCTX, prow = pos >> 6, pcol = pos & 63, quarter = sub >> 1;
            const float* tab = quarter < 2 ? small + SM_ROPER / 4 + (prow * 16 + 8 * (sub & 1)) * 2 : small + SM_ROPEC / 4 + (pcol * 16 + 8 * (sub & 1)) * 2;
#pragma unroll
            for (int j = 0; j < 8; ++j) { const float partner = __shfl_xor(x[j], 2); const float cs = tab[2 * j], sn = tab[2 * j + 1];
              x[j] = (quarter & 1) ? x[j] * cs + partner * sn : x[j] * cs - partner * sn; } }
          if (which == 0) {
#pragma unroll
            for (int j = 0; j < 8; ++j) x[j] *= 0.18033688011112042f; }
          const int h = lane >> 4;
          *(v4u*)((which == 0 ? QR : KR) + ((size_t)h * NTOK + r) * 128 + 8 * (lane & 15)) = pack8(x); }
    }
    bf16* VT = (bf16*)(F.ws + WS_VT);
    LAS bf16* tl = (LAS bf16*)F.lds;
    for (int it = F.bid; it < 4 * (NTOK / 64); it += F.G) {
        const int h = it / (NTOK / 64), key0 = (it % (NTOK / 64)) * 64;
#pragma unroll
        for (int i = 0; i < 2; ++i) { const int id = F.tid + 512 * i, key = id >> 4, dvc = id & 15;
            const v4u v = *(const v4u*)(P + (size_t)(key0 + key) * PWP + C_DV + h * 128 + 8 * dvc);
            const int k16 = key & 15, pos = (key & ~15) | ((k16 >= 4 && k16 < 8) ? k16 + 4 : (k16 >= 8 && k16 < 12) ? k16 - 4 : k16);
#pragma unroll
            for (int j = 0; j < 4; ++j) { tl[(8 * dvc + 2 * j) * 72 + pos] = (bf16)(v[j] & 0xffffu); tl[(8 * dvc + 2 * j + 1) * 72 + pos] = (bf16)(v[j] >> 16); } }
        __syncthreads();
#pragma unroll
        for (int i = 0; i < 2; ++i) { const int id = F.tid + 512 * i, dv = id >> 3, ch = id & 7;
            const v4u v = *(const LAS v4u*)(tl + dv * 72 + 8 * ch);
            *(v4u*)(VT + ((size_t)h * 128 + dv) * NTOK + key0 + 8 * ch) = v; }
        __syncthreads();
    }
}

__device__ __forceinline__ float rdl(float v, int i) { return __builtin_bit_cast(float, __builtin_amdgcn_readlane(__builtin_bit_cast(int, v), i)); }
__device__ __forceinline__ void gdn_seq_chain(const Frame& F, int h, int d) {
    const float* GQ = (const float*)(F.ws + WS_GQ); const float* GK = (const float*)(F.ws + WS_GK); const float* GV = (const float*)(F.ws + WS_GV);
    const float* GBETA = (const float*)(F.ws + WS_GBETA); const float* GDEC = (const float*)(F.ws + WS_GDEC);
    float* OG = (float*)(F.ws + WS_OGDN) + (size_t)d * NTOK * 512;
    const int lane = F.lane;
    float S[64];
#pragma unroll
    for (int i = 0; i < 64; ++i) S[i] = 0.f;
    auto rowof = [&](int step) { return d == 0 ? step : (step < NCTX ? NCTX - 1 - step : NTOK - 1 - (step - NCTX)); };
    int r = rowof(0);
    float nk = GK[(size_t)r * 512 + h * 64 + lane], nq = GQ[(size_t)r * 512 + h * 64 + lane], nv = GV[(size_t)r * 512 + h * 64 + lane], ng = GDEC[r * 16 + d * 8 + h], nb = GBETA[r * 16 + d * 8 + h];
    for (int step = 0; step < NTOK; ++step) {
        const float kk = nk, qq = nq, vv = nv, g = ng, b = nb; const int rc = r;
        if (step + 1 < NTOK) { r = rowof(step + 1);
            nk = GK[(size_t)r * 512 + h * 64 + lane]; nq = GQ[(size_t)r * 512 + h * 64 + lane]; nv = GV[(size_t)r * 512 + h * 64 + lane]; ng = GDEC[r * 16 + d * 8 + h]; nb = GBETA[r * 16 + d * 8 + h]; }
        const float eg = __expf(g);
        float ks = 0.f;
#pragma unroll
        for (int i = 0; i < 64; ++i) ks += rdl(kk, i) * S[i];
        const float vn = b * (vv - eg * ks);
        float o = 0.f;
#pragma unroll
        for (int i = 0; i < 64; ++i) { S[i] = eg * S[i] + rdl(kk, i) * vn; o += rdl(qq, i) * S[i]; }
        OG[(size_t)rc * 512 + h * 64 + lane] = o * 0.125f;
    }
}
__device__ __forceinline__ void gla_seq_chain(const Frame& F, int h, int d, int half) {
    const bf16* P = (const bf16*)(F.ws + WS_P); const float* LOGA = (const float*)(F.ws + WS_LOGA);
    float* OL = (float*)(F.ws + WS_OGLA) + (size_t)d * NTOK * 512;
    const int lane = F.lane;
    float S[64];
#pragma unroll
    for (int i = 0; i < 64; ++i) S[i] = 0.f;
    auto rowof = [&](int step) { return d == 0 ? step : (step < NCTX ? NCTX - 1 - step : NTOK - 1 - (step - NCTX)); };
    int r = rowof(0);
    float na = LOGA[(size_t)r * 512 + d * 256 + h * 64 + lane]; unsigned short nk = P[(size_t)r * PWP + C_LK + h * 64 + lane], nq = P[(size_t)r * PWP + C_LQ + h * 64 + lane], nv = P[(size_t)r * PWP + C_LV + h * 128 + half * 64 + lane];
    for (int step = 0; step < NTOK; ++step) {
        const float a = __expf(na), kk = bf2f(nk), qq = bf2f(nq) * 0.125f, vv = bf2f(nv); const int rc = r;
        if (step + 1 < NTOK) { r = rowof(step + 1);
            na = LOGA[(size_t)r * 512 + d * 256 + h * 64 + lane]; nk = P[(size_t)r * PWP + C_LK + h * 64 + lane]; nq = P[(size_t)r * PWP + C_LQ + h * 64 + lane]; nv = P[(size_t)r * PWP + C_LV + h * 128 + half * 64 + lane]; }
        float o = 0.f;
#pragma unroll
        for (int i = 0; i < 64; ++i) { S[i] = rdl(a, i) * S[i] + rdl(kk, i) * vv; o += rdl(qq, i) * S[i]; }
        OL[(size_t)rc * 512 + h * 128 + half * 64 + lane] = o;
    }
}

constexpr int ATT_BUF = 24576;
__device__ __forceinline__ int att_swz(int row) { return ((row >> 1) & 1) | (((row >> 3) & 1) << 1) | (((row >> 4) & 1) << 2); }
__device__ __forceinline__ int fresh_lane() { int l_; asm volatile("v_mbcnt_lo_u32_b32 %0, -1, 0\n\tv_mbcnt_hi_u32_b32 %0, -1, %0" : "=v"(l_)); return l_; }
__device__ __forceinline__ void attn_unit(const Frame& F, const ArgView& A, int l, int h, int qrow0, int ntiles) {
    const bf16* QRh = (const bf16*)(F.ws + WS_QR) + (size_t)h * NTOK * 128; const bf16* KRh = (const bf16*)(F.ws + WS_KR) + (size_t)h * NTOK * 128;
    const bf16* VTh = (const bf16*)(F.ws + WS_VT) + (size_t)h * 128 * NTOK;
    const int w = F.wave;
    LAS unsigned char* lds = F.lds;
#pragma unroll 1
    for (int c = 0; c < 2; ++c) {
        bf16x8 qf[4]; int foff[4];
        { const int ln = fresh_lane(), l31 = ln & 31, hh = ln >> 5; const unsigned qoff = (unsigned)((qrow0 + 32 * w + l31) * 128 + 8 * hh) + 64u * c;
#pragma unroll
          for (int ks = 0; ks < 4; ++ks) { qf[ks] = *(const bf16x8*)(QRh + (qoff + 16u * ks)); foff[ks] = l31 * 128 + (((2 * ks + hh) ^ att_swz(l31)) << 4); } }
        f32x16 O[4];
        float zf_ = 0.f; asm volatile("" : "+v"(zf_));
#pragma unroll
        for (int mv = 0; mv < 4; ++mv)
#pragma unroll
            for (int i = 0; i < 16; ++i) O[mv][i] = zf_;
        float lsum = zf_;
        __syncthreads();
        { const int tl = w * 64 + fresh_lane(), kr = tl >> 3, kl = (tl & 7) ^ att_swz(kr);
          const unsigned kx = (unsigned)(kr * 128 + 8 * kl) + 64u * c, vx = (unsigned)(kr * NTOK + 8 * kl);
          const v4u k0 = *(const v4u*)(KRh + kx), v0 = *(const v4u*)(VTh + vx), v1 = *(const v4u*)(VTh + (vx + 64u * NTOK));
          *(LAS v4u*)(lds + tl * 16) = k0; *(LAS v4u*)(lds + 8192 + tl * 16) = v0; *(LAS v4u*)(lds + 16384 + tl * 16) = v1; }
        __syncthreads();
        bf16x8 pfp[2];
#pragma unroll
        for (int s = 0; s < 2; ++s) pfp[s] = __builtin_bit_cast(bf16x8, (v4u){0u, 0u, 0u, 0u});
        int vprev = 8192;
        int cur = 0;
#pragma unroll 1
        for (int t = 0; t < ntiles; ++t) {
            const int nxt = cur == 2 * ATT_BUF ? 0 : cur + ATT_BUF;
            v4u sk, sv0, sv1;
            {
                const int tn = t + 1 < ntiles ? t + 1 : t; const int tl = w * 64 + fresh_lane(), kr = tl >> 3, kl = (tl & 7) ^ att_swz(kr);
                const unsigned kx = (unsigned)(kr * 128 + 8 * kl) + 64u * c + (unsigned)tn * 8192u, vx = (unsigned)(kr * NTOK + 8 * kl) + (unsigned)tn * 64u;
                sk = *(const v4u*)(KRh + kx); sv0 = *(const v4u*)(VTh + vx); sv1 = *(const v4u*)(VTh + (vx + 64u * NTOK)); }
#pragma unroll
            for (int mt = 0; mt < 2; ++mt) {
                f32x16 S;
#pragma unroll
                for (int i = 0; i < 16; ++i) S[i] = 0.f;
#pragma unroll
                for (int ks = 0; ks < 4; ++ks) {
                    const bf16x8 kf = *(const LAS bf16x8*)(lds + cur + mt * 4096 + foff[ks]);
                    S = __builtin_amdgcn_mfma_f32_32x32x16_bf16(kf, qf[ks], S, 0, 0, 0);
                }
#pragma unroll
                for (int sp = 0; sp < 2; ++sp)
#pragma unroll
                    for (int mv = 0; mv < 4; ++mv) {
                        const bf16x8 vf = *(const LAS bf16x8*)(lds + vprev + mv * 4096 + foff[2 * (1 - mt) + sp]);
                        O[mv] = __builtin_amdgcn_mfma_f32_32x32x16_bf16(vf, pfp[sp], O[mv], 0, 0, 0);
                    }
                __builtin_amdgcn_sched_barrier(0);
#pragma unroll
                for (int s = 0; s < 2; ++s) {
                    unsigned w0[4];
#pragma unroll
                    for (int j = 0; j < 4; ++j) {
                        const float a0 = __builtin_amdgcn_exp2f(S[8 * s + 2 * j]), a1 = __builtin_amdgcn_exp2f(S[8 * s + 2 * j + 1]);
                        lsum += a0 + a1;
                        w0[j] = pg8::cvt_pk_bf16(a0, a1);
                    }
                    pfp[s] = __builtin_bit_cast(bf16x8, (v4u){w0[0], w0[1], w0[2], w0[3]});
                }
                vprev = cur + 8192;
                __builtin_amdgcn_sched_barrier(0);
            }
            { const int tl = w * 64 + fresh_lane();
                *(LAS v4u*)(lds + nxt + tl * 16) = sk; *(LAS v4u*)(lds + nxt + 8192 + tl * 16) = sv0; *(LAS v4u*)(lds + nxt + 16384 + tl * 16) = sv1; }
            __syncthreads();
            cur = nxt;
        }
#pragma unroll
        for (int sp = 0; sp < 2; ++sp)
#pragma unroll
            for (int mv = 0; mv < 4; ++mv) {
                const bf16x8 vf = *(const LAS bf16x8*)(lds + vprev + mv * 4096 + foff[2 + sp]);
                O[mv] = __builtin_amdgcn_mfma_f32_32x32x16_bf16(vf, pfp[sp], O[mv], 0, 0, 0);
            }
        lsum += __shfl_xor(lsum, 32);
        const float inv = 1.0f / lsum;
        const int ln = fresh_lane(), l31 = ln & 31, hh = ln >> 5;
        float* park = (float*)(F.ws + WS_PARK) + ((size_t)F.bid * NWAVES + w) * 4096 + ln * 4;
        if (c == 0) {
#pragma unroll
            for (int mv = 0; mv < 4; ++mv)
#pragma unroll
                for (int g = 0; g < 4; ++g) *(f32x4*)(park + (mv * 4 + g) * 256) = (f32x4){O[mv][4 * g] * inv, O[mv][4 * g + 1] * inv, O[mv][4 * g + 2] * inv, O[mv][4 * g + 3] * inv};
        } else {
            const float lam = ((const float*)(F.ws + WS_SMALL))[SM_LAM / 4 + l];
            const float post = 1.0f - (0.8f - 0.6f * expf(-0.3f * (float)l));
            const float* onorm = A.in[I_DON] + l * 128;
            float ssq = 0.f;
#pragma unroll
            for (int mv = 0; mv < 4; ++mv)
#pragma unroll
                for (int g = 0; g < 4; ++g) { const f32x4 o0 = *(const f32x4*)(park + (mv * 4 + g) * 256);
#pragma unroll
                    for (int j = 0; j < 4; ++j) { const float o = o0[j] - lam * O[mv][4 * g + j] * inv; O[mv][4 * g + j] = o; ssq += o * o; } }
            ssq += __shfl_xor(ssq, 32);
            const float rs = post / sqrtf(ssq * (1.f / 128.f) + NEPS);
            bf16* orow = (bf16*)(F.ws + WS_MIX) + 1536 + h * 128 + (size_t)(qrow0 + 32 * w + l31) * 2048;
#pragma unroll
            for (int mv = 0; mv < 4; ++mv)
#pragma unroll
                for (int g = 0; g < 4; ++g) { const int dv = 32 * mv + 8 * g + 4 * hh; const f32x4 gn = *(const f32x4*)(onorm + dv);
                    uint2 o; o.x = pk2(O[mv][4 * g] * rs * gn.x, O[mv][4 * g + 1] * rs * gn.y); o.y = pk2(O[mv][4 * g + 2] * rs * gn.z, O[mv][4 * g + 3] * rs * gn.w);
                    *(uint2*)(orow + dv) = o; }
        }
    }
}

#ifndef MIX_ONLY
#define MIX_ONLY 0
#endif
__device__ __forceinline__ void ph_mix(const Frame& F0, const ArgView& A, int l) {
    Frame F = F0;
#ifdef SEQ_SCANS
    if (MIX_ONLY == 0 || MIX_ONLY == 1) if (F.bid < 16) { if (F.wave == 0) gdn_seq_chain(F, F.bid & 7, F.bid >> 3); }
    if (MIX_ONLY == 0 || MIX_ONLY == 2) if (F.bid >= 16 && F.bid < 32) { const int b = F.bid - 16; if (F.wave == 0) gla_seq_chain(F, b & 3, (b >> 2) & 1, b >> 3); }
#endif
    if (MIX_ONLY == 0 || MIX_ONLY == 3) {
    { int l_; asm volatile("v_mbcnt_lo_u32_b32 %0, -1, 0\n\tv_mbcnt_hi_u32_b32 %0, -1, %0" : "=v"(l_)); F.lane = l_; F.tid = F.wave * 64 + l_; }
    const int ctxu = (l == 0 && F.bid >= F.G - 4) ? 256 + (F.G - 1 - F.bid) : -1;
    int u = F.bid < 256 ? F.bid : ctxu;
#pragma unroll 1
    while (u >= 0) {
        const bool lat = u < 256; const int h = lat ? (u & 7) >> 1 : u - 256, qb = (u >> 3) * 2 + (u & 1);
        attn_unit(F, A, l, h, lat ? NCTX + 256 * qb : 0, lat ? NTOK / 64 : NCTX / 64);
        if (lat) { u += F.G; if (u >= 256) u = ctxu; } else u = -1; }
    }
}

__device__ __forceinline__ void ph_post(const Frame& F, const ArgView& A, int l, int row_lo) {
    const int gw = F.bid * NWAVES + F.wave, NGW = F.G * NWAVES, lane = F.lane;
    const bf16* P = (const bf16*)(F.ws + WS_P); bf16* mix = (bf16*)(F.ws + WS_MIX);
    const float* OG = (const float*)(F.ws + WS_OGDN); const float* OL = (const float*)(F.ws + WS_OGLA);
    const float* gon = A.in[I_GONORM] + l * 64 + 8 * (lane & 7); const float* lon = A.in[I_LONORM] + l * 128 + 8 * (lane & 15);
    for (int r = row_lo + gw; r < NTOK; r += NGW) {
        { const float* a = OG + (size_t)r * 512 + 8 * lane; const float* b = a + (size_t)NTOK * 512; float o[8], g[8];
          const f32x4 a0 = *(const f32x4*)a, a1 = *(const f32x4*)(a + 4), b0 = *(const f32x4*)b, b1 = *(const f32x4*)(b + 4);
          o[0] = a0.x + b0.x; o[1] = a0.y + b0.y; o[2] = a0.z + b0.z; o[3] = a0.w + b0.w; o[4] = a1.x + b1.x; o[5] = a1.y + b1.y; o[6] = a1.z + b1.z; o[7] = a1.w + b1.w;
          float ss = 0.f;
#pragma unroll
          for (int j = 0; j < 8; ++j) ss += o[j] * o[j];
          ss += __shfl_xor(ss, 1); ss += __shfl_xor(ss, 2); ss += __shfl_xor(ss, 4);
          const float rs = 1.0f / sqrtf(ss * (1.f / 64.f) + NEPS);
          load8(P + (size_t)r * PWP + C_GGATE + 8 * lane, g);
#pragma unroll
          for (int j = 0; j < 8; ++j) o[j] = o[j] * rs * gon[j] * siluf(g[j]);
          *(v4u*)(mix + (size_t)r * 2048 + 8 * lane) = pack8(o); }
        { const float* a = OL + (size_t)r * 512 + 8 * lane; const float* b = a + (size_t)NTOK * 512; float o[8], g[8];
          const f32x4 a0 = *(const f32x4*)a, a1 = *(const f32x4*)(a + 4), b0 = *(const f32x4*)b, b1 = *(const f32x4*)(b + 4);
          o[0] = a0.x + b0.x; o[1] = a0.y + b0.y; o[2] = a0.z + b0.z; o[3] = a0.w + b0.w; o[4] = a1.x + b1.x; o[5] = a1.y + b1.y; o[6] = a1.z + b1.z; o[7] = a1.w + b1.w;
          float ss = 0.f;
#pragma unroll
          for (int j = 0; j < 8; ++j) ss += o[j] * o[j];
          ss += __shfl_xor(ss, 1); ss += __shfl_xor(ss, 2); ss += __shfl_xor(ss, 4); ss += __shfl_xor(ss, 8);
          const float rs = 1.0f / sqrtf(ss * (1.f / 128.f) + NEPS);
          load8(P + (size_t)r * PWP + C_LR + 8 * lane, g);
#pragma unroll
          for (int j = 0; j < 8; ++j) o[j] = o[j] * rs * lon[j] * siluf(g[j]);
          *(v4u*)(mix + (size_t)r * 2048 + 1024 + 8 * lane) = pack8(o); }
#ifdef MIX_KEEP
        { unsigned zu_ = 0u; asm volatile("" : "+v"(zu_));
#pragma unroll
          for (int gq = 0; gq < 4; ++gq) if (gq != MIX_KEEP) *(v4u*)(mix + (size_t)r * 2048 + gq * 512 + 8 * lane) = (v4u){zu_, zu_, zu_, zu_}; }
#endif
    }
}

__device__ __forceinline__ void ph_assign(const Frame& F, int l, int row_lo) {
    const int lane = F.lane, w = F.wave, e = F.bid;
    if (e >= NEXP) return;
    const unsigned* cnt = F.ctl + CW_CNT + 64 * l;
    const int* toke = (const int*)(F.ws + WS_TOKE); int* toks = (int*)(F.ws + WS_TOKS);
    LAS unsigned* wc = (LAS unsigned*)F.lds;
    const int n64 = (NTOK - row_lo) * 2 / 64, per = (n64 + NWAVES - 1) / NWAVES, b0 = w * per, b1 = (b0 + per < n64) ? b0 + per : n64;
    unsigned c = 0;
    for (int b = b0; b < b1; ++b) c += (unsigned)__popcll(__ballot(toke[row_lo * 2 + b * 64 + lane] == e));
    if (lane == 0) wc[w] = c;
    __syncthreads();
    unsigned pos = 0;
    for (int q = 0; q < e; ++q) pos += (__hip_atomic_load(cnt + q, __ATOMIC_RELAXED, __HIP_MEMORY_SCOPE_AGENT) + 255u) & ~255u;
    for (int q = 0; q < w; ++q) pos += wc[q];
    for (int b = b0; b < b1; ++b) { const int idx = row_lo * 2 + b * 64 + lane; const bool m = toke[idx] == e;
        const unsigned long long mask = __ballot(m);
        if (m) toks[idx] = (int)(pos + (unsigned)__popcll(mask & ((1ull << lane) - 1ull)));
        pos += (unsigned)__popcll(mask); }
}
__device__ __forceinline__ void ph_route(const Frame& F, int l, int row_lo) {
    const int gw = F.bid * NWAVES + F.wave, NGW = F.G * NWAVES, lane = F.lane;
    const int* toks = (const int*)(F.ws + WS_TOKS);
    const bf16* hb = (const bf16*)(F.ws + WS_HBUF); bf16* am = (bf16*)(F.ws + WS_AMOE);
    for (int t = row_lo + gw; t < NTOK; t += NGW) {
        const int s0 = toks[t * 2], s1 = toks[t * 2 + 1];
        const v4u* src = (const v4u*)(hb + (size_t)t * 2048); v4u* d0 = (v4u*)(am + (size_t)s0 * 2048); v4u* d1 = (v4u*)(am + (size_t)s1 * 2048);
#pragma unroll
        for (int j = 0; j < 4; ++j) { const v4u v = src[lane + 64 * j]; d0[lane + 64 * j] = v; d1[lane + 64 * j] = v; }
    }
}
__device__ __forceinline__ void build_tile_table(const Frame& F, int l) {
    LAS int* tab = (LAS int*)(F.lds + TILE_TAB_OFF);
    if (F.tid == 0) { const unsigned* cnt = F.ctl + CW_CNT + 64 * l; int nt = 0;
        for (int e = 0; e < NEXP; ++e) { const int k = (int)((__hip_atomic_load(cnt + e, __ATOMIC_RELAXED, __HIP_MEMORY_SCOPE_AGENT) + 255u) >> 8); for (int j = 0; j < k && nt < MAXSLOT / 256; ++j) tab[1 + nt++] = e; }
        tab[0] = nt; }
    __syncthreads();
}
struct GroupedOrder {
    const LAS int* tab; int nN, G, c, nunits; size_t a_tstep, b_estride, b_tstep;
    __device__ void init(const LAS int* tab_, int nN_, int K, int nrows_per_expert, int G_, int c_) { tab = tab_; nN = nN_; G = G_; c = c_; nunits = tab_[0] * nN_;
        a_tstep = (size_t)256 * K * 2; b_tstep = a_tstep; b_estride = (size_t)nrows_per_expert * K * 2; }
    __device__ bool next(int i, pg8::Unit& u) const {
        const int L = i * G + c; if (L >= nunits) return false;
        const int tile = L / nN; u.pm = tile; u.pn = L % nN; const int e = tab[1 + tile];
        u.aoff = (size_t)tile * a_tstep; u.boff = (size_t)e * b_estride + (size_t)u.pn * b_tstep; return true; }
    __device__ __forceinline__ void a_ready(const pg8::Unit&) const {}
    __device__ __forceinline__ void done(const pg8::Unit&) const {}
};
template <class Base> struct OneUnit {
    const Base& B; int i0;
    __device__ bool next(int i, pg8::Unit& u) const { return i == 0 ? B.next(i0, u) : false; }
    __device__ __forceinline__ void a_ready(const pg8::Unit&) const {}
    __device__ __forceinline__ void done(const pg8::Unit&) const {}
};
__device__ __forceinline__ void ph_combine(const Frame& F, int l, int row_lo) {
    const int gw = F.bid * NWAVES + F.wave, NGW = F.G * NWAVES, lane = F.lane;
    const int* toks = (const int*)(F.ws + WS_TOKS); const float* tokw = (const float*)(F.ws + WS_TOKW);
    const bf16* Y = (const bf16*)(F.ws + WS_YMOE);
    for (int t = row_lo + gw; t < NTOK; t += NGW) {
        const bool isctx = t < NCTX;
        float* dst = isctx ? (float*)(F.ws + WS_XCTX) + (size_t)t * 2048 : F.out + (size_t)(t - NCTX) * 2048;
        const float* gate = modv_ptr(F, l, isctx ? 1 : 0) + 5 * 2048;
        const int s0 = toks[t * 2], s1 = toks[t * 2 + 1]; const float w0 = tokw[t * 2], w1 = tokw[t * 2 + 1];
#pragma unroll
        for (int j = 0; j < 4; ++j) { const int c = 8 * (lane + 64 * j); float a[8], b[8];
#ifdef TEST_H
            if (j > 0) continue;
            load8((const bf16*)(F.ws + WS_HMOE) + (size_t)s0 * 512 + c, a); load8((const bf16*)(F.ws + WS_HMOE) + (size_t)s1 * 512 + c, b);
#else
            load8(Y + (size_t)s0 * 2048 + c, a); load8(Y + (size_t)s1 * 2048 + c, b);
#endif
            f32x4 d0 = *(f32x4*)(dst + c), d1 = *(f32x4*)(dst + c + 4); const f32x4 g0 = *(const f32x4*)(gate + c), g1 = *(const f32x4*)(gate + c + 4);
            d0.x += g0.x * (w0 * a[0] + w1 * b[0]); d0.y += g0.y * (w0 * a[1] + w1 * b[1]); d0.z += g0.z * (w0 * a[2] + w1 * b[2]); d0.w += g0.w * (w0 * a[3] + w1 * b[3]);
            d1.x += g1.x * (w0 * a[4] + w1 * b[4]); d1.y += g1.y * (w0 * a[5] + w1 * b[5]); d1.z += g1.z * (w0 * a[6] + w1 * b[6]); d1.w += g1.w * (w0 * a[7] + w1 * b[7]);
            *(f32x4*)(dst + c) = d0; *(f32x4*)(dst + c + 4) = d1; }
    }
}

template <class Sched>
__device__ __forceinline__ void sgemm_bf16out(const Frame& F, const bf16* A, const bf16* Bt, int K, const Sched& S, bf16* O, int ldc) {
    const int lane = F.lane, w = F.wave, tid = F.tid, l31 = lane & 31, hh = lane >> 5, wm = w >> 2, wn = w & 3;
    LAS unsigned char* lds = F.lds;
    const int nt = K / 64;
    int foff[4];
#pragma unroll
    for (int ks = 0; ks < 4; ++ks) foff[ks] = l31 * 128 + (((2 * ks + hh) ^ att_swz(l31)) << 4);
    pg8::Unit u;
#pragma unroll 1
    for (int ui = 0; S.next(ui, u); ++ui) {
        const bf16* Au = (const bf16*)((const char*)A + u.aoff); const bf16* Bu = (const bf16*)((const char*)Bt + u.boff);
        f32x16 acc[4][2];
        float zf_ = 0.f; asm volatile("" : "+v"(zf_));
#pragma unroll
        for (int a = 0; a < 4; ++a)
#pragma unroll
            for (int b = 0; b < 2; ++b)
#pragma unroll
                for (int i = 0; i < 16; ++i) acc[a][b][i] = zf_;
        __syncthreads();
#pragma unroll
        for (int i = 0; i < 4; ++i) { const int id = tid + 512 * i, row = id >> 3, lg = (id & 7) ^ (row & 7); const unsigned so = (unsigned)(row * K + 8 * lg);
            __builtin_amdgcn_global_load_lds((const unsigned*)(Au + so), (LAS unsigned*)(lds + (w * 64 + 512 * i) * 16), 16, 0, 0);
            __builtin_amdgcn_global_load_lds((const unsigned*)(Bu + so), (LAS unsigned*)(lds + 32768 + (w * 64 + 512 * i) * 16), 16, 0, 0); }
        VM_WAIT(); __syncthreads();
#pragma unroll 1
        for (int t = 0; t < nt; ++t) {
            const int cur = (t & 1) * 65536, nxt = 65536 - cur;
            if (t + 1 < nt) { int tl = tid; asm volatile("" : "+v"(tl));
#pragma unroll
                for (int i = 0; i < 4; ++i) { const int id = tl + 512 * i, row = id >> 3, lg = (id & 7) ^ (row & 7); const unsigned so = (unsigned)(row * K + 8 * lg + 64 * (t + 1));
                    __builtin_amdgcn_global_load_lds((const unsigned*)(Au + so), (LAS unsigned*)(lds + nxt + (w * 64 + 512 * i) * 16), 16, 0, 0);
                    __builtin_amdgcn_global_load_lds((const unsigned*)(Bu + so), (LAS unsigned*)(lds + nxt + 32768 + (w * 64 + 512 * i) * 16), 16, 0, 0); } }
#pragma unroll
            for (int ks = 0; ks < 4; ++ks) {
                bf16x8 af[4], bfr[2];
#pragma unroll
                for (int a = 0; a < 4; ++a) af[a] = *(const LAS bf16x8*)(lds + cur + (wm * 128 + a * 32) * 128 + foff[ks]);
#pragma unroll
                for (int b = 0; b < 2; ++b) bfr[b] = *(const LAS bf16x8*)(lds + cur + 32768 + (wn * 64 + b * 32) * 128 + foff[ks]);
#pragma unroll
                for (int a = 0; a < 4; ++a)
#pragma unroll
                    for (int b = 0; b < 2; ++b) acc[a][b] = __builtin_amdgcn_mfma_f32_32x32x16_bf16(bfr[b], af[a], acc[a][b], 0, 0, 0);
            }
            VM_WAIT(); __syncthreads();
        }
#pragma unroll
        for (int a = 0; a < 4; ++a) { bf16* orow = O + (size_t)(u.pm * 256 + wm * 128 + a * 32 + l31) * ldc + u.pn * 256 + wn * 64;
#pragma unroll
            for (int b = 0; b < 2; ++b)
#pragma unroll
                for (int g = 0; g < 4; ++g) { uint2 o; o.x = pg8::cvt_pk_bf16(acc[a][b][4 * g], acc[a][b][4 * g + 1]); o.y = pg8::cvt_pk_bf16(acc[a][b][4 * g + 2], acc[a][b][4 * g + 3]);
                    *(uint2*)(orow + 32 * b + 8 * g + 4 * hh) = o; } }
    }
}

constexpr int CH = 64, NCHUNK = NTOK / CH, NCTXCH = NCTX / CH;
constexpr int LS = 65;
constexpr int LS2 = 129;
template <class FA, class FB> __device__ __forceinline__ f32x16 mm32(FA a, FB b, int K, int l31, int hh) {
    f32x16 acc;
#pragma unroll
    for (int i = 0; i < 16; ++i) acc[i] = 0.f;
#pragma unroll 8
    for (int k = 0; k < K; k += 2) acc = __builtin_amdgcn_mfma_f32_32x32x2f32(a(l31, k + hh), b(k + hh, l31), acc, 0, 0, 0);
    return acc;
}
template <class FA, class FB> __device__ __forceinline__ f32x16 mm32b(FA a, FB b, int K, int l31, int hh) {
    f32x16 acc;
#pragma unroll
    for (int i = 0; i < 16; ++i) acc[i] = 0.f;
#pragma unroll 2
    for (int k = 0; k < K; k += 16) { const int k0 = k + 8 * hh;
        v4u af, bf;
#pragma unroll
        for (int j = 0; j < 4; ++j) { af[j] = pg8::cvt_pk_bf16(a(l31, k0 + 2 * j), a(l31, k0 + 2 * j + 1)); bf[j] = pg8::cvt_pk_bf16(b(k0 + 2 * j, l31), b(k0 + 2 * j + 1, l31)); }
        acc = __builtin_amdgcn_mfma_f32_32x32x16_bf16(__builtin_bit_cast(bf16x8, af), __builtin_bit_cast(bf16x8, bf), acc, 0, 0, 0); }
    return acc;
}
#ifndef MM32
#define MM32 mm32b
#endif
#define GBF(i, j) ((((j) >> 4) * 4 + ((i) >> 4)) * 256 + ((((i) & 15) >> 2) * 16 + ((j) & 15)) * 4 + ((i) & 3))
#define KPERM(j) (16 * (2 * ((j) >> 5) + (((j) >> 3) & 1)) + 8 * (((j) >> 2) & 1) + 4 * (((j) >> 4) & 1) + ((j) & 3))
#define ACC_ROW(r, hh) (((r) & 3) + 8 * ((r) >> 2) + 4 * (hh))

__device__ __forceinline__ size_t gdn_slot(int d, int h, int n) { return ((size_t)(d * 8 + h) * NCHUNK + n) * 4096; }
__device__ __forceinline__ void ph_gdn_a(const Frame& F, int l, bool skip_solve = false) {
    const float* GQ = (const float*)(F.ws + WS_GQ); const float* GK = (const float*)(F.ws + WS_GK); const float* GV = (const float*)(F.ws + WS_GV);
    const float* GBETA = (const float*)(F.ws + WS_GBETA); const float* GDEC = (const float*)(F.ws + WS_GDEC);
    bf16* GB = (bf16*)(F.ws + WS_GB); bf16* GQP = (bf16*)(F.ws + WS_GQP); bf16* GOP = (bf16*)(F.ws + WS_GOP);
    LAS float* Qs = (LAS float*)F.lds; LAS float* Ks = Qs + 64 * LS; LAS float* Vs = Ks + 64 * LS; LAS float* As = Vs + 64 * LS; LAS float* Us = As + 64 * LS; LAS float* Ws = Us + 64 * LS;
    LAS float* Lt = Ws + 64 * LS;
    LAS float* Gv0 = Lt + 64 * 68;
    LAS float* misc = Gv0 + 512;
    LAS float* Dinv = misc + 16;
    const int tid = F.tid, lane = F.lane, w = F.wave, l31 = lane & 31, hh = lane >> 5;
#pragma unroll 1
    for (int unit = F.bid; unit < NCHUNK * 8; unit += F.G) {
        const int n = unit >> 3, h = unit & 7, r0 = n * CH;
        __syncthreads();
        {
            float tq[8], tk[8], tv[8];
#pragma unroll
            for (int q = 0; q < 8; ++q) { const int e = tid + NTHR * q, i = e >> 6, c = e & 63; const size_t g = (size_t)(r0 + i) * 512 + h * 64 + c; tq[q] = GQ[g]; tk[q] = GK[g]; tv[q] = GV[g]; }
#pragma unroll
            for (int q = 0; q < 8; ++q) { const int e = tid + NTHR * q, i = e >> 6, c = e & 63; Qs[i * LS + c] = tq[q] * 0.125f; Ks[i * LS + c] = tk[q]; Vs[i * LS + c] = tv[q]; } }
        if (w < 2) {
            const int d = w; LAS float* Gv = Gv0 + 256 * d;
            const int i = d ? 63 - lane : lane; float g = GDEC[(size_t)(r0 + i) * 16 + d * 8 + h];
#pragma unroll
            for (int o = 1; o < 64; o <<= 1) { const float t = __shfl_up(g, o); if (lane >= o) g += t; }
            const float gl = __shfl(g, 63);
            Gv[i] = g; Gv[64 + i] = __expf(g); Gv[128 + i] = __expf(gl - g); Gv[192 + i] = GBETA[(size_t)(r0 + i) * 16 + d * 8 + h];
            if (lane == 0) misc[d] = __expf(gl);
        }
#pragma unroll 1
        for (int d = 0; d < 2; ++d) {
            LAS float* Gv = Gv0 + 256 * d; LAS float* EGv = Gv + 64; LAS float* Fv = Gv + 128; LAS float* Bv = Gv + 192;
            __syncthreads();
            {
                const int t = w & 3, ti = t >> 1, tj = t & 1; const bool isq = w >= 4; LAS float* X = isq ? Qs : Ks;
                const f32x16 acc = MM32([&](int i, int k) { return X[(32 * ti + i) * LS + k]; }, [&](int k, int j) { return Ks[(32 * tj + j) * LS + k]; }, 64, l31, hh);
                const int j = 32 * tj + l31; const float gj = Gv[j];
#pragma unroll
                for (int r = 0; r < 16; ++r) { const int i = 32 * ti + ACC_ROW(r, hh); const float gi = Gv[i];
                    const bool before = d ? (j > i) : (j < i); const float dec = (before || i == j) ? __expf(gi - gj) : 0.f;
                    if (isq) As[i * LS + j] = acc[r] * dec;
                    else { const int is = d ? 63 - i : i, js = d ? 63 - j : j; Lt[is * 68 + js] = before ? Bv[i] * acc[r] * dec : 0.f; } }
            }
            __syncthreads();
            if (tid < 64 && !skip_solve) {
                const int I = tid >> 4, c = tid & 15; LAS float* Lb = Lt + (16 * I) * 68 + 16 * I; asm volatile("" : "+v"(Lb));
                float y[16];
#pragma unroll
                for (int i = 0; i < 16; ++i) { float v = (i == c) ? 1.0f : 0.0f;
#pragma unroll
                    for (int j4 = 0; j4 < (i + 3) / 4; ++j4) { const f32x4 lv = *(const LAS f32x4*)(Lb + i * 68 + 4 * j4);
                        if (4 * j4 + 0 < i) v -= lv[0] * y[4 * j4 + 0]; if (4 * j4 + 1 < i) v -= lv[1] * y[4 * j4 + 1];
                        if (4 * j4 + 2 < i) v -= lv[2] * y[4 * j4 + 2]; if (4 * j4 + 3 < i) v -= lv[3] * y[4 * j4 + 3]; }
                    y[i] = v; Dinv[(I * 16 + i) * 20 + c] = v; }
            }
            __syncthreads();
            if (!skip_solve) {
                const int li = lane & 15, g = lane >> 4, c = 16 * (w & 3) + li; const bool isw = w >= 4;
                LAS float* R = isw ? Ks : Vs; LAS float* X = isw ? Ws : Us;
                f32x4 Xb[4];
#pragma unroll
                for (int I = 0; I < 4; ++I) {
                    f32x4 z;
#pragma unroll
                    for (int r = 0; r < 4; ++r) { const int is = 16 * I + 4 * g + r, i = d ? 63 - is : is; z[r] = Bv[i] * R[i * LS + c] * (isw ? EGv[i] : 1.0f); }
#pragma unroll
                    for (int J = 0; J < I; ++J) { const f32x4 lf = *(const LAS f32x4*)(Lt + (16 * I + li) * 68 + 16 * J + 4 * g);
#pragma unroll
                        for (int r = 0; r < 4; ++r) z = __builtin_amdgcn_mfma_f32_16x16x4f32(-lf[r], Xb[J][r], z, 0, 0, 0); }
                    const f32x4 df = *(const LAS f32x4*)(Dinv + (I * 16 + li) * 20 + 4 * g);
                    f32x4 xi = (f32x4){0.f, 0.f, 0.f, 0.f};
#pragma unroll
                    for (int r = 0; r < 4; ++r) xi = __builtin_amdgcn_mfma_f32_16x16x4f32(df[r], z[r], xi, 0, 0, 0);
                    Xb[I] = xi;
#pragma unroll
                    for (int r = 0; r < 4; ++r) { const int is = 16 * I + 4 * g + r, i = d ? 63 - is : is; X[i * LS + c] = xi[r]; }
                }
            }
            __syncthreads();
            {
                const int p = w >> 1; const float egl = misc[d];
                if (tid == 0) ((float*)(F.ws + WS_EGL))[gdn_slot(d, h, n) >> 12] = egl;
                 bf16* dstB = GB + gdn_slot(d, h, n); bf16* dstQ = GQP + gdn_slot(d, h, n); bf16* dstO = GOP + gdn_slot(d, h, n);
#pragma unroll 1
                for (int tt = 0; tt < 2; ++tt) { const int t = 2 * (w & 1) + tt, ti = t >> 1, tj = t & 1;
                    LAS float* Xr = (p == 0 || p == 2) ? Ws : Us;
                    f32x16 acc;
                    if (p < 2) acc = MM32([&](int i, int k) { return Ks[k * LS + 32 * ti + i] * Fv[k]; }, [&](int k, int j) { return Xr[k * LS + 32 * tj + j]; }, 64, l31, hh);
                    else       acc = MM32([&](int i, int k) { return As[(32 * ti + i) * LS + k]; }, [&](int k, int j) { return Xr[k * LS + 32 * tj + j]; }, 64, l31, hh);
                    const int j = 32 * tj + l31;
#pragma unroll
                    for (int r = 0; r < 16; ++r) { const int i = 32 * ti + ACC_ROW(r, hh);
                        if (p == 0) Lt[i * 68 + j] = -acc[r];
                        else if (p == 1) dstB[GBF(i, j)] = (bf16)f2bf(acc[r]);
                        else if (p == 2) dstQ[i * 64 + KPERM(j)] = (bf16)f2bf(Qs[i * LS + j] * EGv[i] - acc[r]);
                        else dstO[i * 64 + j] = (bf16)f2bf(acc[r]); } }
            }
            __syncthreads();
            {
                const int f = tid, mo = f >> 7, sx = (f >> 6) & 1, il = f & 15, gx = (f & 63) >> 4; float mv[8];
#pragma unroll
                for (int jj = 0; jj < 8; ++jj) mv[jj] = Lt[(16 * mo + il) * 68 + 32 * sx + 16 * (jj >> 2) + 4 * gx + (jj & 3)];
                *(v4u*)((bf16*)(F.ws + WS_GA) + gdn_slot(d, h, n) + f * 8) = pack8(mv);
            }
        }
    }
}

__device__ __forceinline__ size_t gla_slot(int d, int h, int n) { return (size_t)(d * 4 + h) * NCHUNK + n; }
__device__ __forceinline__ void ph_gla_a(const Frame& F, int l) {
    const bf16* P = (const bf16*)(F.ws + WS_P); const float* LOGA = (const float*)(F.ws + WS_LOGA);
    bf16* OL = (bf16*)(F.ws + WS_OL); float* DS = (float*)(F.ws + WS_DS); float* ACH = (float*)(F.ws + WS_ACH); bf16* GQB = (bf16*)(F.ws + WS_GQB);
    LAS float* Qi = (LAS float*)F.lds; LAS float* Ko = Qi + 64 * LS; LAS float* Vs = Ko + 64 * LS; LAS float* Bs = Vs + 64 * LS2; LAS float* At = Bs + 64 * LS;
    const int tid = F.tid, lane = F.lane, w = F.wave, l31 = lane & 31, hh = lane >> 5;
#pragma unroll 1
    for (int unit = F.G - 1 - F.bid; unit < NCHUNK * 8; unit += F.G) {
        const int n = unit >> 3, h = (unit >> 1) & 3, d = unit & 1, r0 = n * CH;
        __syncthreads();
        float tq[8], tk[8];
        {   float tb[8]; unsigned tv[8];
#pragma unroll
            for (int q = 0; q < 8; ++q) { const int e = tid + NTHR * q, i = e >> 6, c = e & 63; tb[q] = LOGA[(size_t)(r0 + i) * 512 + d * 256 + h * 64 + c];
                tq[q] = bf2f(P[(size_t)(r0 + i) * PWP + C_LQ + h * 64 + c]) * 0.125f; tk[q] = bf2f(P[(size_t)(r0 + i) * PWP + C_LK + h * 64 + c]);
                const int i2 = e >> 6, c2 = (e & 63) * 2; tv[q] = *(const unsigned*)(P + (size_t)(r0 + i2) * PWP + C_LV + h * 128 + c2); }
#pragma unroll
            for (int q = 0; q < 8; ++q) { const int e = tid + NTHR * q, i = e >> 6, c = e & 63; Bs[i * LS + c] = tb[q];
                Vs[i * LS2 + 2 * c] = __builtin_bit_cast(float, tv[q] << 16); Vs[i * LS2 + 2 * c + 1] = __builtin_bit_cast(float, tv[q] & 0xffff0000u); } }
        __syncthreads();
        if (tid < 64) {
            float s = 0.f;
#pragma unroll 8
            for (int is = 0; is < 64; ++is) { const int i = d ? 63 - is : is; s += Bs[i * LS + tid]; Bs[i * LS + tid] = s; }
            ACH[gla_slot(d, h, n) * 64 + tid] = __expf(s);
        }
        __syncthreads();
#pragma unroll
        for (int qq = 0; qq < 8; ++qq) { const int e = tid + NTHR * qq, i = e >> 6, c = e & 63; const int il = d ? 0 : 63;
            const float b = Bs[i * LS + c], bl = Bs[il * LS + c];
            const float q = tq[qq], k = tk[qq];
            Qi[i * LS + c] = q * __expf(b - bl); Ko[i * LS + c] = k * __expf(bl - b);
            GQB[(gla_slot(d, h, n) * 64 + i) * 64 + c] = (bf16)f2bf(q * __expf(b)); }
        __syncthreads();
        if (w < 4) {
            const int ti = w >> 1, tj = w & 1;
            const f32x16 acc = MM32([&](int i, int k) { return Qi[(32 * ti + i) * LS + k]; }, [&](int k, int j) { return Ko[(32 * tj + j) * LS + k]; }, 64, l31, hh);
            const int j = 32 * tj + l31;
#pragma unroll
            for (int r = 0; r < 16; ++r) { const int i = 32 * ti + ACC_ROW(r, hh); const bool ok = d ? (j >= i) : (j <= i); At[i * LS + j] = ok ? acc[r] : 0.f; }
        }
        __syncthreads();
        {
            const int ti = w >> 2, tj = w & 3;
            { const f32x16 acc = MM32([&](int i, int k) { return At[(32 * ti + i) * LS + k]; }, [&](int k, int j) { return Vs[k * LS2 + 32 * tj + j]; }, 64, l31, hh);
              bf16* dst = OL + (size_t)d * NTOK * 512;
#pragma unroll
              for (int r = 0; r < 16; ++r) { const int i = 32 * ti + ACC_ROW(r, hh); dst[(size_t)(r0 + i) * 512 + h * 128 + 32 * tj + l31] = (bf16)f2bf(acc[r]); } }
            { const f32x16 acc = MM32([&](int i, int k) { return Ko[k * LS + 32 * ti + i]; }, [&](int k, int j) { return Vs[k * LS2 + 32 * tj + j]; }, 64, l31, hh);
              float* dst = DS + gla_slot(d, h, n) * 8192;
#pragma unroll
              for (int r = 0; r < 16; ++r) { const int i = 32 * ti + ACC_ROW(r, hh); dst[i * 128 + 32 * tj + l31] = acc[r]; } }
        }
    }
}

__device__ __forceinline__ int chain_chunk(int d, int step) { const int rev = (step < NCTXCH ? NCTXCH - 1 : NCHUNK + NCTXCH - 1) - step; return d ? rev : step; }
typedef unsigned v2u __attribute__((ext_vector_type(2)));
__device__ __forceinline__ void gla_scan(const Frame& F, int gtid) {
    const float* DS = (const float*)(F.ws + WS_DS); const float* ACH = (const float*)(F.ws + WS_ACH); v2u* GLS = (v2u*)(F.ws + WS_GLS);
    const int dh = gtid >> 11, e4 = gtid & 2047, kq = e4 >> 7, dv = e4 & 127, d = dh >> 2;
    float s[4] = {0.f, 0.f, 0.f, 0.f};
#pragma unroll 1
    for (int s0 = 0; s0 < NCHUNK; s0 += 10) {
        float x[10][4]; f32x4 a[10];
#pragma unroll
        for (int q = 0; q < 10; ++q) { const size_t slot = (size_t)(dh * NCHUNK + chain_chunk(d, s0 + q));
#pragma unroll
            for (int r = 0; r < 4; ++r) x[q][r] = DS[slot * 8192 + (4 * kq + r) * 128 + dv];
            a[q] = *(const f32x4*)(ACH + slot * 64 + 4 * kq); }
#pragma unroll
        for (int q = 0; q < 10; ++q) { const size_t slot = (size_t)(dh * NCHUNK + chain_chunk(d, s0 + q));
            v2u o; o[0] = pg8::cvt_pk_bf16(s[0], s[1]); o[1] = pg8::cvt_pk_bf16(s[2], s[3]); GLS[slot * 2048 + kq * 128 + dv] = o;
#pragma unroll
            for (int r = 0; r < 4; ++r) s[r] = a[q][r] * s[r] + x[q][r]; }
    }
}
constexpr int SCB = 4;
__device__ __forceinline__ void gdn_scan(const Frame& F) {
    const bf16* GM = (const bf16*)(F.ws + WS_GA); const v2u* GB = (const v2u*)(F.ws + WS_GB); bf16* GST = (bf16*)(F.ws + WS_GST); const float* EGL = (const float*)(F.ws + WS_EGL);
    const int lane = F.lane, w = F.wave, tid = F.tid, ci = w >> 2, slice = w & 3, chain = 2 * F.bid + ci, d = chain >> 3;
    LAS unsigned char* lds = F.lds;
    f32x4 S[4];
#pragma unroll
    for (int m = 0; m < 4; ++m) S[m] = (f32x4){0.f, 0.f, 0.f, 0.f};
    v4u R[8]; v2u Bn[SCB][4], Bc[SCB][4]; float en[SCB], ec[SCB];
#define SC_ISSUE(batch) do { const int b_ = (batch) < NCHUNK / SCB ? (batch) : NCHUNK / SCB - 1; \
        _Pragma("unroll") for (int i_ = 0; i_ < 8; ++i_) { const int q_ = tid + NTHR * i_, cq_ = q_ >> 11, jq_ = (q_ >> 9) & 3, r_ = q_ & 511; \
            const int ch_ = 2 * F.bid + cq_; const size_t slot_ = (size_t)ch_ * NCHUNK + chain_chunk(ch_ >> 3, b_ * SCB + jq_); \
            R[i_] = *(const v4u*)(GM + slot_ * 4096 + r_ * 8); } \
        _Pragma("unroll") for (int j_ = 0; j_ < SCB; ++j_) { const size_t slot_ = (size_t)chain * NCHUNK + chain_chunk(d, b_ * SCB + j_); en[j_] = EGL[slot_]; \
            _Pragma("unroll") for (int m_ = 0; m_ < 4; ++m_) Bn[j_][m_] = GB[slot_ * 1024 + (slice * 4 + m_) * 64 + lane]; } } while (0)
#define SC_COMMIT() do { _Pragma("unroll") for (int i_ = 0; i_ < 8; ++i_) { const int q_ = tid + NTHR * i_; *(LAS v4u*)(lds + q_ * 16) = R[i_]; } \
        _Pragma("unroll") for (int j_ = 0; j_ < SCB; ++j_) { ec[j_] = en[j_]; _Pragma("unroll") for (int m_ = 0; m_ < 4; ++m_) Bc[j_][m_] = Bn[j_][m_]; } } while (0)
    const unsigned scrap = 100000u + (unsigned)w * 256u;
#define SC_PREF1(ptr) asm volatile("s_mov_b32 m0, %1\n\tglobal_load_lds_dword %0, off" :: "v"(ptr), "s"(scrap) : "memory", "m0")
#define SC_PREF(batch) do { const int b_ = (batch) < NCHUNK / SCB ? (batch) : NCHUNK / SCB - 1; \
        const int ch_ = 2 * F.bid + (w >> 2); const size_t slot_ = (size_t)ch_ * NCHUNK + chain_chunk(ch_ >> 3, b_ * SCB + (w & 3)); \
        SC_PREF1(GM + slot_ * 4096 + lane * 64); SC_PREF1(GB + slot_ * 1024 + lane * 16); } while (0)
    __syncthreads();
    SC_ISSUE(0); SC_COMMIT();
    __syncthreads();
#pragma unroll 1
    for (int b = 0; b < NCHUNK / SCB; ++b) {
        SC_ISSUE(b + 1);
#pragma unroll
        for (int j = 0; j < SCB; ++j) {
            LAS unsigned char* base = lds + (ci * SCB + j) * 8192;
            v4u mf[8]; f32x4 acc[4];
#pragma unroll
            for (int q = 0; q < 8; ++q) mf[q] = *(const LAS v4u*)(base + (q * 64 + lane) * 16);
#pragma unroll
            for (int m = 0; m < 4; ++m) { const v2u bb = Bc[j][m]; f32x4 bf_;
                bf_[0] = __builtin_bit_cast(float, bb[0] << 16); bf_[1] = __builtin_bit_cast(float, bb[0] & 0xffff0000u); bf_[2] = __builtin_bit_cast(float, bb[1] << 16); bf_[3] = __builtin_bit_cast(float, bb[1] & 0xffff0000u);
                acc[m] = S[m] * ec[j] + bf_; }
            v4u sb[2];
#pragma unroll
            for (int s2 = 0; s2 < 2; ++s2) { sb[s2][0] = pg8::cvt_pk_bf16(S[2 * s2][0], S[2 * s2][1]); sb[s2][1] = pg8::cvt_pk_bf16(S[2 * s2][2], S[2 * s2][3]);
                sb[s2][2] = pg8::cvt_pk_bf16(S[2 * s2 + 1][0], S[2 * s2 + 1][1]); sb[s2][3] = pg8::cvt_pk_bf16(S[2 * s2 + 1][2], S[2 * s2 + 1][3]); }
            const size_t slot = (size_t)chain * NCHUNK + chain_chunk(d, b * SCB + j);
#pragma unroll
            for (int s2 = 0; s2 < 2; ++s2) *(v4u*)(GST + slot * 4096 + ((slice * 2 + s2) * 64 + lane) * 8) = sb[s2];
#pragma unroll
            for (int s2 = 0; s2 < 2; ++s2)
#pragma unroll
                for (int mo = 0; mo < 4; ++mo) acc[mo] = __builtin_amdgcn_mfma_f32_16x16x32_bf16(__builtin_bit_cast(bf16x8, mf[mo * 2 + s2]), __builtin_bit_cast(bf16x8, sb[s2]), acc[mo], 0, 0, 0);
#pragma unroll
            for (int m = 0; m < 4; ++m) S[m] = acc[m];
        }
        SC_PREF(b + 2);
        __syncthreads();
        SC_COMMIT();
        __syncthreads();
    }
    asm volatile("s_waitcnt vmcnt(0)" ::: "memory");
    __syncthreads();
#undef SC_PREF
#undef SC_PREF1
#undef SC_ISSUE
#undef SC_COMMIT
}
__device__ __forceinline__ void ph_scan(const Frame& F) {
    if (F.bid < 8) gdn_scan(F);
    else if (F.bid < 40) gla_scan(F, (F.bid - 8) * NTHR + F.tid);
}

template <int NT>
__device__ __forceinline__ void final_unit(const Frame& F, const ArgView& A, int l, int n, int h, int ti) {
    const int lane = F.lane, l31 = lane & 31, hh = lane >> 5, r0 = n * CH;
    constexpr bool GDN = (NT == 2); constexpr int NV = 32 * NT;
    f32x16 acc[NT];
#pragma unroll
    for (int t = 0; t < NT; ++t)
#pragma unroll
        for (int i = 0; i < 16; ++i) acc[t][i] = 0.f;
#pragma unroll 1
    for (int d = 0; d < 2; ++d) {
        const bf16* Aq; const v2u* Gl = nullptr; const bf16* Gs = nullptr; const bf16* Ol; int ols;
        if (GDN) { Aq = (const bf16*)(F.ws + WS_GQP) + gdn_slot(d, h, n); Gs = (const bf16*)(F.ws + WS_GST) + gdn_slot(d, h, n); Ol = (const bf16*)(F.ws + WS_GOP) + gdn_slot(d, h, n); ols = 64; }
        else { Aq = (const bf16*)(F.ws + WS_GQB) + gla_slot(d, h, n) * 4096; Gl = (const v2u*)(F.ws + WS_GLS) + gla_slot(d, h, n) * 2048;
               Ol = (const bf16*)(F.ws + WS_OL) + (size_t)d * NTOK * 512 + (size_t)r0 * 512 + h * 128; ols = 512; }
#pragma unroll
        for (int t = 0; t < NT; ++t)
#pragma unroll
            for (int r = 0; r < 16; ++r) acc[t][r] += bf2f(Ol[(size_t)(32 * ti + ACC_ROW(r, hh)) * ols + 32 * t + l31]);
        v4u av[2], bv[2][NT];
#define FIN_LOAD(buf, s) do { av[buf] = *(const v4u*)(Aq + (32 * ti + l31) * 64 + 16 * (s) + 8 * hh); \
        _Pragma("unroll") for (int t_ = 0; t_ < NT; ++t_) { \
            if (GDN) bv[buf][t_] = *(const v4u*)(Gs + ((((2 * t_ + (l31 >> 4)) * 2 + ((s) >> 1)) * 64 + (2 * ((s) & 1) + hh) * 16 + (l31 & 15)) * 8)); \
            else { const v2u b0_ = Gl[(4 * (s) + 2 * hh) * 128 + 32 * t_ + l31], b1_ = Gl[(4 * (s) + 2 * hh + 1) * 128 + 32 * t_ + l31]; \
                   bv[buf][t_][0] = b0_[0]; bv[buf][t_][1] = b0_[1]; bv[buf][t_][2] = b1_[0]; bv[buf][t_][3] = b1_[1]; } } } while (0)
        FIN_LOAD(0, 0);
#pragma unroll
        for (int s = 0; s < 4; ++s) {
            if (s < 3) FIN_LOAD((s + 1) & 1, s + 1);
            const v4u af = av[s & 1];
#pragma unroll
            for (int t = 0; t < NT; ++t) {
                const v4u bf = bv[s & 1][t];
                acc[t] = __builtin_amdgcn_mfma_f32_32x32x16_bf16(__builtin_bit_cast(bf16x8, af), __builtin_bit_cast(bf16x8, bf), acc[t], 0, 0, 0); }
            __builtin_amdgcn_sched_barrier(0);
        }
#undef FIN_LOAD
    }
    const bf16* P = (const bf16*)(F.ws + WS_P); bf16* mix = (bf16*)(F.ws + WS_MIX);
    const float* gain = A.in[GDN ? I_GONORM : I_LONORM] + l * NV; const int gcol = (GDN ? C_GGATE + h * 64 : C_LR + h * 128), mcol = (GDN ? h * 64 : 1024 + h * 128);
    float gn[NT];
#pragma unroll
    for (int t = 0; t < NT; ++t) gn[t] = gain[32 * t + l31];
#pragma unroll
    for (int r = 0; r < 16; ++r) {
        float ss = 0.f;
#pragma unroll
        for (int t = 0; t < NT; ++t) ss += acc[t][r] * acc[t][r];
        ss += __shfl_xor(ss, 1); ss += __shfl_xor(ss, 2); ss += __shfl_xor(ss, 4); ss += __shfl_xor(ss, 8); ss += __shfl_xor(ss, 16);
        const float rs = 1.0f / sqrtf(ss * (1.f / NV) + NEPS);
        const size_t row = (size_t)(r0 + 32 * ti + ACC_ROW(r, hh));
#pragma unroll
        for (int t = 0; t < NT; ++t) { const float g = bf2f(P[row * PWP + gcol + 32 * t + l31]);
            mix[row * 2048 + mcol + 32 * t + l31] = (bf16)f2bf(acc[t][r] * rs * gn[t] * siluf(g)); }
    }
}
__device__ __forceinline__ void ph_final(const Frame& F, const ArgView& A, int l, int chunk_lo) {
    const int gw = F.bid * NWAVES + F.wave, NGW = F.G * NWAVES, nun = (NCHUNK - chunk_lo) * 24;
#pragma unroll 1
    for (int unit = gw; unit < nun; unit += NGW) { const int n = chunk_lo + unit / 24, u = unit % 24;
        if (u < 16) final_unit<2>(F, A, l, n, u >> 1, u & 1);
        else final_unit<4>(F, A, l, n, (u - 16) >> 1, u & 1); }
}

constexpr int PH_PER_LAYER = 15, N_PHASES = 1 + 2 * PH_PER_LAYER;
#ifndef MOEDN_ALIGN
#define MOEDN_ALIGN true
#endif
#ifndef MOEDN_SP2
#define MOEDN_SP2 true
#endif
#ifndef REPEAT_MODE
#define REPEAT_MODE 1
#endif
#ifndef MK_SINGLE
#define MK_SINGLE 0
#endif
template <int KIND> __global__ void __launch_bounds__(NTHR, 2) fwd(Args args) {
    extern __shared__ __attribute__((aligned(16))) unsigned char lds_raw[];
    Frame F; ArgView AV; AV.in.p = (CArgsP)__builtin_amdgcn_kernarg_segment_ptr();
    F.lds = (LAS unsigned char*)lds_raw; F.ws = args.ws; F.ctl = (unsigned*)(args.ws + WS_CTL); F.out = args.out;
    F.tid = threadIdx.x; F.lane = F.tid & 63; F.wave = __builtin_amdgcn_readfirstlane(F.tid >> 6); F.G = gridDim.x; F.bid = blockIdx.x;
    for (int u = F.tid; u < (LDS_BYTES - LDSCTL_OFF) / 4; u += NTHR) ((LAS unsigned*)(F.lds + LDSCTL_OFF))[u] = 0u;
    __syncthreads();
    const int lo = args.ph_lo, hi = args.ph_hi;
#ifdef ACQ_START
    __builtin_amdgcn_fence(__ATOMIC_ACQUIRE, "agent"); asm volatile("s_waitcnt vmcnt(0)" ::: "memory");
#endif
    XcdBarrier bar; bar.bar = F.ctl + CW_BAR; bar.x = 0; bar.st = nullptr;
    if (KIND < 0 || hi - lo > 1) bar = xcd_barrier_post(F.ctl + CW_BAR, (volatile LAS unsigned*)(F.lds + MISC_OFF) + 8);
#define EN(j) (KIND < 0 || (j) == KIND)
#define IN(k) (KIND < 0 || (lo <= (k) && (k) < hi))
#define SEAM(k) do { if (KIND < 0 ? ((k) + 1 < N_PHASES) : (IN(k) && IN((k) + 1))) xcd_barrier(bar); } while (0)
#define FRESH() do { int l_; asm volatile("v_mbcnt_lo_u32_b32 %0, -1, 0\n\tv_mbcnt_hi_u32_b32 %0, -1, %0" : "=v"(l_)); F.lane = l_; F.tid = F.wave * 64 + l_; { CArgsP ka_ = (CArgsP)__builtin_amdgcn_kernarg_segment_ptr(); asm volatile("" : "+s"(ka_)); AV.in.p = ka_; } { unsigned char* w_ = args.ws; asm volatile("" : "+s"(w_)); F.ws = w_; F.ctl = (unsigned*)w_; float* o_ = args.out; asm volatile("" : "+s"(o_)); F.out = o_; } } while (0)

    if (EN(100) && IN(0)) { FRESH(); ph_prologue(F, AV); }
    SEAM(0);
    { constexpr int l = 0;
    {
        const int b = 1 + PH_PER_LAYER * l;
#define XLAT (l == 0 ? AV.in[I_X] : (const float*)F.out)
#define XCTX (l == 0 ? AV.in[I_CTX] : (const float*)(F.ws + WS_XCTX))
        const int out_lo = l == 0 ? 0 : NCTX;
        if (EN(0) && IN(b + 0)) { FRESH(); ph_convert(F, AV, l); }
        SEAM(b + 0);
        if (EN(1) && IN(b + 1)) { FRESH(); ph_norm<0>(F, AV, l, XLAT, XCTX, 0); }
        SEAM(b + 1);
        if (EN(2) && IN(b + 2)) { FRESH();
            pg8::Gemm g{(const bf16*)(F.ws + WS_HBUF), (const bf16*)(F.ws + WS_WIN), NTOK, PWP, DM}; pg8::StaticOrder S; S.init(NTOK, PWP, DM, F.G, F.bid);
            pg8::EpiBf16 E{(bf16*)(F.ws + WS_P), PWP};
            pg8::gemm_phase<pg8::EpiBf16, pg8::StaticOrder, true, true>(F.lds, g, S, E, F.tid);
        }
        SEAM(b + 2);
        if (EN(3) && IN(b + 3)) { FRESH(); ph_prep(F, AV, l); }
        SEAM(b + 3);
        if (EN(4) && IN(b + 4)) { const int rp_ = KIND < 0 ? 0 : args.rep; FRESH(); if (rp_ != 4) ph_gdn_a(F, l, rp_ == 3); FRESH(); if (rp_ < 2 || rp_ == 4) ph_gla_a(F, l); }
        SEAM(b + 4);
        if (EN(5) && IN(b + 5)) { FRESH(); if (KIND < 0 || args.rep == 0) ph_scan(F); FRESH(); ph_mix(F, AV, l); }
        SEAM(b + 5);
        if (EN(6) && IN(b + 6)) { FRESH(); ph_final(F, AV, l, out_lo / CH); }
        SEAM(b + 6);
        if (EN(7) && IN(b + 7)) { FRESH();
            const int M = NTOK - out_lo;
            pg8::Gemm g{(const bf16*)(F.ws + WS_MIX) + (size_t)out_lo * DM, (const bf16*)(F.ws + WS_WOUT), M, DM, DM}; pg8::StaticOrder S; S.init(M, DM, DM, F.G, F.bid);
            pg8::EpiResid E{XLAT, F.out, XCTX, (float*)(F.ws + WS_XCTX), modv_ptr(F, l, 0) + 2 * DM, modv_ptr(F, l, 1) + 2 * DM, NCTX, out_lo};
            pg8::gemm_phase<pg8::EpiResid, pg8::StaticOrder, true, true>(F.lds, g, S, E, F.tid);
        }
        SEAM(b + 7);
        if (EN(8) && IN(b + 8)) { FRESH(); ph_norm<1>(F, AV, l, F.out, (const float*)(F.ws + WS_XCTX), out_lo);
#ifdef ZERO_MOE
            { unsigned zu_ = 0u; asm volatile("" : "+v"(zu_)); v4u* z = (v4u*)(F.ws + WS_AMOE); const size_t n = ((size_t)MAXSLOT * 2048 * 2 + (size_t)MAXSLOT * 512 * 2) / 16;
              for (size_t i = (size_t)F.bid * NTHR + F.tid; i < n; i += (size_t)F.G * NTHR) z[i] = (v4u){zu_, zu_, zu_, zu_}; }
#endif
        }
        SEAM(b + 8);
        if (EN(9) && IN(b + 9)) { FRESH();
            const int M = NTOK - out_lo;
            pg8::Gemm g{(const bf16*)(F.ws + WS_HBUF) + (size_t)out_lo * DM, (const bf16*)(F.ws + WS_WR), M, 256, DM}; pg8::StaticOrder S; S.init(M, 256, DM, F.G, F.bid);
            pg8::EpiRouter E{AV.in[I_RGB] + l * 4, AV.in[I_REB] + l * 32, (int*)(F.ws + WS_TOKE), (float*)(F.ws + WS_TOKW), F.ctl + CW_CNT + 64 * l, out_lo};
            pg8::gemm_phase<pg8::EpiRouter, pg8::StaticOrder, false, true>(F.lds, g, S, E, F.tid);
        }
        SEAM(b + 9);
        if (EN(10) && IN(b + 10)) { FRESH(); ph_assign(F, l, out_lo); }
        SEAM(b + 10);
        if (EN(11) && IN(b + 11)) { FRESH(); ph_route(F, l, out_lo); }
        SEAM(b + 11);
        if (EN(12) && IN(b + 12)) { FRESH();
            build_tile_table(F, l);
            const LAS int* tab = (const LAS int*)(F.lds + TILE_TAB_OFF);
            pg8::Gemm g{(const bf16*)(F.ws + WS_AMOE), (const bf16*)(F.ws + WS_WUP), MAXSLOT, 1024, DM}; GroupedOrder S; S.init(tab, 4, DM, 1024, F.G, F.bid);
            pg8::EpiSwiGLU E{(bf16*)(F.ws + WS_HMOE), 512};
            pg8::gemm_phase<pg8::EpiSwiGLU, GroupedOrder, true, true>(F.lds, g, S, E, F.tid);
        }
        SEAM(b + 12);
        if (EN(13) && IN(b + 13)) { FRESH();
            build_tile_table(F, l);
            const LAS int* tab = (const LAS int*)(F.lds + TILE_TAB_OFF);
#if defined(TEST_W2COPY)
            pg8::Gemm g{(const bf16*)(F.ws + WS_HMOE), (const bf16*)(F.ws + WS_PARK), MAXSLOT, DM, 512}; GroupedOrder S; S.init(tab, 8, 512, 0, F.G, F.bid);
#elif defined(TEST_K512D0)
            pg8::Gemm g{(const bf16*)(F.ws + WS_HMOE), (const bf16*)(F.ws + WS_WDN), MAXSLOT, DM, 512}; GroupedOrder S; S.init(tab, 8, 512, 0, F.G, F.bid);
#elif defined(TEST_K512W)
            pg8::Gemm g{(const bf16*)(F.ws + WS_HMOE), (const bf16*)(F.ws + WS_WOUT), MAXSLOT, DM, 512}; GroupedOrder S; S.init(tab, 8, 512, 0, F.G, F.bid);
#elif defined(TEST_K1024)
            pg8::Gemm g{(const bf16*)(F.ws + WS_AMOE), (const bf16*)(F.ws + WS_WDN), MAXSLOT, DM, 1024}; GroupedOrder S; S.init(tab, 4, 1024, 1024, F.G, F.bid);
#elif defined(TEST_K512A)
            pg8::Gemm g{(const bf16*)(F.ws + WS_AMOE), (const bf16*)(F.ws + WS_WDN), MAXSLOT, DM, 512}; GroupedOrder S; S.init(tab, 8, 512, DM, F.G, F.bid);
#elif defined(TEST_K2048)
            pg8::Gemm g{(const bf16*)(F.ws + WS_AMOE), (const bf16*)(F.ws + WS_WOUT), MAXSLOT, DM, DM}; GroupedOrder S; S.init(tab, 8, DM, 0, F.G, F.bid);
#else
            pg8::Gemm g{(const bf16*)(F.ws + WS_HMOE), (const bf16*)(F.ws + WS_WDN), MAXSLOT, DM, 512}; GroupedOrder S; S.init(tab, 8, 512, DM, F.G, F.bid);
#endif
            pg8::EpiBf16 E{(bf16*)(F.ws + WS_YMOE), DM};
#if defined(MOEDN_SGEMM)
            sgemm_bf16out(F, g.A, g.Bt, g.K, S, (bf16*)(F.ws + WS_YMOE), DM);
#elif defined(MOEDN_ONEUNIT)
#pragma unroll 1
            for (int i = 0; i * F.G + F.bid < S.nunits; ++i) { OneUnit<GroupedOrder> S1{S, i}; pg8::gemm_phase<pg8::EpiBf16, OneUnit<GroupedOrder>, false, true>(F.lds, g, S1, E, F.tid); }
#else
            pg8::gemm_phase<pg8::EpiBf16, GroupedOrder, MOEDN_ALIGN, MOEDN_SP2>(F.lds, g, S, E, F.tid);
#endif
        }
        SEAM(b + 13);
        if (EN(14) && IN(b + 14)) { FRESH(); ph_combine(F, l, out_lo); }
        SEAM(b + 14);
    }
    }
    { constexpr int l = 1;
    {
        const int b = 1 + PH_PER_LAYER * l;
#define XLAT (l == 0 ? AV.in[I_X] : (const float*)F.out)
#define XCTX (l == 0 ? AV.in[I_CTX] : (const float*)(F.ws + WS_XCTX))
        const int out_lo = l == 0 ? 0 : NCTX;
        if (EN(0) && IN(b + 0)) { FRESH(); ph_convert(F, AV, l); }
        SEAM(b + 0);
        if (EN(1) && IN(b + 1)) { FRESH(); ph_norm<0>(F, AV, l, XLAT, XCTX, 0); }
        SEAM(b + 1);
        if (EN(2) && IN(b + 2)) { FRESH();
            pg8::Gemm g{(const bf16*)(F.ws + WS_HBUF), (const bf16*)(F.ws + WS_WIN), NTOK, PWP, DM}; pg8::StaticOrder S; S.init(NTOK, PWP, DM, F.G, F.bid);
            pg8::EpiBf16 E{(bf16*)(F.ws + WS_P), PWP};
            pg8::gemm_phase<pg8::EpiBf16, pg8::StaticOrder, true, true>(F.lds, g, S, E, F.tid);
        }
        SEAM(b + 2);
        if (EN(3) && IN(b + 3)) { FRESH(); ph_prep(F, AV, l); }
        SEAM(b + 3);
        if (EN(4) && IN(b + 4)) { const int rp_ = KIND < 0 ? 0 : args.rep; FRESH(); if (rp_ != 4) ph_gdn_a(F, l, rp_ == 3); FRESH(); if (rp_ < 2 || rp_ == 4) ph_gla_a(F, l); }
        SEAM(b + 4);
        if (EN(5) && IN(b + 5)) { FRESH(); if (KIND < 0 || args.rep == 0) ph_scan(F); FRESH(); ph_mix(F, AV, l); }
        SEAM(b + 5);
        if (EN(6) && IN(b + 6)) { FRESH(); ph_final(F, AV, l, out_lo / CH); }
        SEAM(b + 6);
        if (EN(7) && IN(b + 7)) { FRESH();
            const int M = NTOK - out_lo;
            pg8::Gemm g{(const bf16*)(F.ws + WS_MIX) + (size_t)out_lo * DM, (const bf16*)(F.ws + WS_WOUT), M, DM, DM}; pg8::StaticOrder S; S.init(M, DM, DM, F.G, F.bid);
            pg8::EpiResid E{XLAT, F.out, XCTX, (float*)(F.ws + WS_XCTX), modv_ptr(F, l, 0) + 2 * DM, modv_ptr(F, l, 1) + 2 * DM, NCTX, out_lo};
            pg8::gemm_phase<pg8::EpiResid, pg8::StaticOrder, true, true>(F.lds, g, S, E, F.tid);
        }
        SEAM(b + 7);
        if (EN(8) && IN(b + 8)) { FRESH(); ph_norm<1>(F, AV, l, F.out, (const float*)(F.ws + WS_XCTX), out_lo);
#ifdef ZERO_MOE
            { unsigned zu_ = 0u; asm volatile("" : "+v"(zu_)); v4u* z = (v4u*)(F.ws + WS_AMOE); const size_t n = ((size_t)MAXSLOT * 2048 * 2 + (size_t)MAXSLOT * 512 * 2) / 16;
              for (size_t i = (size_t)F.bid * NTHR + F.tid; i < n; i += (size_t)F.G * NTHR) z[i] = (v4u){zu_, zu_, zu_, zu_}; }
#endif
        }
        SEAM(b + 8);
        if (EN(9) && IN(b + 9)) { FRESH();
            const int M = NTOK - out_lo;
            pg8::Gemm g{(const bf16*)(F.ws + WS_HBUF) + (size_t)out_lo * DM, (const bf16*)(F.ws + WS_WR), M, 256, DM}; pg8::StaticOrder S; S.init(M, 256, DM, F.G, F.bid);
            pg8::EpiRouter E{AV.in[I_RGB] + l * 4, AV.in[I_REB] + l * 32, (int*)(F.ws + WS_TOKE), (float*)(F.ws + WS_TOKW), F.ctl + CW_CNT + 64 * l, out_lo};
            pg8::gemm_phase<pg8::EpiRouter, pg8::StaticOrder, false, true>(F.lds, g, S, E, F.tid);
        }
        SEAM(b + 9);
        if (EN(10) && IN(b + 10)) { FRESH(); ph_assign(F, l, out_lo); }
        SEAM(b + 10);
        if (EN(11) && IN(b + 11)) { FRESH(); ph_route(F, l, out_lo); }
        SEAM(b + 11);
        if (EN(12) && IN(b + 12)) { FRESH();
            build_tile_table(F, l);
            const LAS int* tab = (const LAS int*)(F.lds + TILE_TAB_OFF);
            pg8::Gemm g{(const bf16*)(F.ws + WS_AMOE), (const bf16*)(F.ws + WS_WUP), MAXSLOT, 1024, DM}; GroupedOrder S; S.init(tab, 4, DM, 1024, F.G, F.bid);
            pg8::EpiSwiGLU E{(bf16*)(F.ws + WS_HMOE), 512};
            pg8::gemm_phase<pg8::EpiSwiGLU, GroupedOrder, true, true>(F.lds, g, S, E, F.tid);
        }
        SEAM(b + 12);
        if (EN(13) && IN(b + 13)) { FRESH();
            build_tile_table(F, l);
            const LAS int* tab = (const LAS int*)(F.lds + TILE_TAB_OFF);
#if defined(TEST_W2COPY)
            pg8::Gemm g{(const bf16*)(F.ws + WS_HMOE), (const bf16*)(F.ws + WS_PARK), MAXSLOT, DM, 512}; GroupedOrder S; S.init(tab, 8, 512, 0, F.G, F.bid);
#elif defined(TEST_K512D0)
            pg8::Gemm g{(const bf16*)(F.ws + WS_HMOE), (const bf16*)(F.ws + WS_WDN), MAXSLOT, DM, 512}; GroupedOrder S; S.init(tab, 8, 512, 0, F.G, F.bid);
#elif defined(TEST_K512W)
            pg8::Gemm g{(const bf16*)(F.ws + WS_HMOE), (const bf16*)(F.ws + WS_WOUT), MAXSLOT, DM, 512}; GroupedOrder S; S.init(tab, 8, 512, 0, F.G, F.bid);
#elif defined(TEST_K1024)
            pg8::Gemm g{(const bf16*)(F.ws + WS_AMOE), (const bf16*)(F.ws + WS_WDN), MAXSLOT, DM, 1024}; GroupedOrder S; S.init(tab, 4, 1024, 1024, F.G, F.bid);
#elif defined(TEST_K512A)
            pg8::Gemm g{(const bf16*)(F.ws + WS_AMOE), (const bf16*)(F.ws + WS_WDN), MAXSLOT, DM, 512}; GroupedOrder S; S.init(tab, 8, 512, DM, F.G, F.bid);
#elif defined(TEST_K2048)
            pg8::Gemm g{(const bf16*)(F.ws + WS_AMOE), (const bf16*)(F.ws + WS_WOUT), MAXSLOT, DM, DM}; GroupedOrder S; S.init(tab, 8, DM, 0, F.G, F.bid);
#else
            pg8::Gemm g{(const bf16*)(F.ws + WS_HMOE), (const bf16*)(F.ws + WS_WDN), MAXSLOT, DM, 512}; GroupedOrder S; S.init(tab, 8, 512, DM, F.G, F.bid);
#endif
            pg8::EpiBf16 E{(bf16*)(F.ws + WS_YMOE), DM};
#if defined(MOEDN_SGEMM)
            sgemm_bf16out(F, g.A, g.Bt, g.K, S, (bf16*)(F.ws + WS_YMOE), DM);
#elif defined(MOEDN_ONEUNIT)
#pragma unroll 1
            for (int i = 0; i * F.G + F.bid < S.nunits; ++i) { OneUnit<GroupedOrder> S1{S, i}; pg8::gemm_phase<pg8::EpiBf16, OneUnit<GroupedOrder>, false, true>(F.lds, g, S1, E, F.tid); }
#else
            pg8::gemm_phase<pg8::EpiBf16, GroupedOrder, MOEDN_ALIGN, MOEDN_SP2>(F.lds, g, S, E, F.tid);
#endif
        }
        SEAM(b + 13);
        if (EN(14) && IN(b + 14)) { FRESH(); ph_combine(F, l, out_lo); }
        SEAM(b + 14);
    }
    }

#undef IN
#undef SEAM
}

#ifndef CHK_SCALE
#define CHK_SCALE 1.0f
#endif
#if defined(CHK_REGION) || defined(TOUCH_WDN)
__global__ void chk_kernel(const unsigned short* p, size_t n, float* out) {
    const size_t t = (size_t)blockIdx.x * blockDim.x + threadIdx.x, T = (size_t)gridDim.x * blockDim.x; float s = 0.f;
    for (size_t i = t; i < n; i += T) s += __builtin_bit_cast(float, (unsigned)p[i] << 16);
    out[t] += s * CHK_SCALE;
}
#endif
template <int KIND> static void launch_kind(int grid, const Args& a, hipStream_t stream) {
    static bool attr = false;
    if (!attr) { (void)hipFuncSetAttribute((const void*)fwd<KIND>, hipFuncAttributeMaxDynamicSharedMemorySize, LDS_BYTES); attr = true; }
    hipLaunchKernelGGL(fwd<KIND>, dim3(grid), dim3(NTHR), LDS_BYTES, stream, a);
}
extern "C" void kernel_launch(void* const* d_in, const int* in_sizes, int n_in, void* d_out, int out_size, void* d_ws, size_t ws_size, hipStream_t stream) {
    static int grid = 0;
    if (grid == 0) {
        if (n_in != N_IN || out_size != SEQ * DM || ws_size < WS_END) { fprintf(stderr, "kernel_launch: unexpected shapes: n_in %d out %d ws %zu (need %zu)\n", n_in, out_size, ws_size, (size_t)WS_END); grid = -1; return; }
        int dev = 0, cus = 0;
        if (hipGetDevice(&dev) != hipSuccess || hipDeviceGetAttribute(&cus, hipDeviceAttributeMultiprocessorCount, dev) != hipSuccess) { grid = -1; return; }
        grid = cus;
    }
    if (grid < 0) return;
    (void)hipMemsetAsync((char*)d_ws + WS_CTL, 0, CTL_ZERO_BYTES, stream);
#ifdef MEMSET_WDN
    (void)hipMemsetAsync((char*)d_ws + WS_WDN, 0, 64 * MiB, stream);
#endif
    Args a{};
    for (int i = 0; i < N_IN; ++i) a.in[i] = (const float*)d_in[i];
    a.out = (float*)d_out; a.ws = (unsigned char*)d_ws;
#if MK_SINGLE
    a.ph_lo = 0; a.ph_hi = N_PHASES;
    launch_kind<-1>(grid, a, stream);
#else
#ifndef P_END
#define P_END N_PHASES
#endif
    for (int p = 0; p < P_END; ++p) { a.ph_lo = p; a.ph_hi = p + 1;
        const int k = p == 0 ? 100 : (p - 1) % PH_PER_LAYER;
#ifdef SKIP_MOE_GEMM
        if (k == 12 || k == 13) continue;
#endif
#ifdef TEST_H
        if (k == 13) continue;
#endif
#ifdef TOUCH_WDN
        if (k == 11) hipLaunchKernelGGL(chk_kernel, dim3(256), dim3(512), 0, stream, (const unsigned short*)((char*)d_ws + WS_WDN), (size_t)(64 * MiB) / 2, (float*)((char*)d_ws + WS_PARK));
#endif
#ifdef TEST_W2COPY
        if (k == 11) (void)hipMemcpyAsync((char*)d_ws + WS_PARK, (char*)d_ws + WS_WDN, 2 * MiB, hipMemcpyDeviceToDevice, stream);
#endif
#ifdef TWICE_MOEDN
        if (k == 11) launch_kind<11>(grid, a, stream);
#endif
#ifdef REPEAT_KIND
        if (k == REPEAT_KIND) { a.rep = REPEAT_MODE; for (int q = 0; q < REPEAT_N; ++q) launch_kind<REPEAT_KIND>(grid, a, stream); a.rep = 0; }
#endif
        switch (k) {
            case 100: launch_kind<100>(grid, a, stream); break;
            case 0: launch_kind<0>(grid, a, stream); break; case 1: launch_kind<1>(grid, a, stream); break; case 2: launch_kind<2>(grid, a, stream); break;
            case 3: launch_kind<3>(grid, a, stream); break; case 4: launch_kind<4>(grid, a, stream); break; case 5: launch_kind<5>(grid, a, stream); break;
            case 6: launch_kind<6>(grid, a, stream); break; case 7: launch_kind<7>(grid, a, stream); break; case 8: launch_kind<8>(grid, a, stream); break;
            case 9: launch_kind<9>(grid, a, stream); break; case 10: launch_kind<10>(grid, a, stream); break; case 11: launch_kind<11>(grid, a, stream); break; case 12: launch_kind<12>(grid, a, stream); break; case 13: launch_kind<13>(grid, a, stream); break; case 14: launch_kind<14>(grid, a, stream); break;
        } }
#endif
#ifdef CHK_REGION
    hipLaunchKernelGGL(chk_kernel, dim3(256), dim3(512), 0, stream, (const unsigned short*)((char*)d_ws + CHK_REGION), (size_t)CHK_BYTES / 2, (float*)d_out);
#endif
}
```

```cpp
#define MK_SINGLE 1
#include <hip/hip_runtime.h>
#include <cstdio>
#include <cstdint>

#ifndef GSCALE
#define GSCALE 1.0f
#endif
namespace pg8 {
#define PG8_LAS __attribute__((address_space(3)))
typedef unsigned short bf16_t;
typedef short bf16x8 __attribute__((ext_vector_type(8)));
typedef float f32x4 __attribute__((ext_vector_type(4)));
typedef unsigned u32x4 __attribute__((ext_vector_type(4)));
constexpr int BM = 256, BK = 64, HALF = 128, HTB = HALF * BK * 2  , STAGE_BYTES = 8 * HTB, NXCD = 8, WGM = 8;

__host__ __device__ __forceinline__ int lds_byte(int r, int c) { const int st = (r >> 4) * 2 + (c >> 5), rr = r & 15, cc = c & 31, ob = rr * 64 + cc * 2; return st * 1024 + (ob ^ (((ob >> 9) & 1) << 5)); }
__host__ __device__ __forceinline__ void stage_rc(int b, int& R, int& C) { const int st = b / 1024, sb = b % 1024, swz = sb ^ (((sb >> 9) & 1) << 5); R = (st >> 1) * 16 + swz / 64; C = (st & 1) * 32 + (swz % 64) / 2; }
__host__ __device__ __forceinline__ int perm32(int rho) { const int n = rho >> 4, i = rho & 15; return 8 * (i >> 2) + 4 * n + (i & 3); }

struct Unit { int pm, pn; size_t aoff, boff; };
struct Gemm { const bf16_t* A; const bf16_t* Bt; int M, N, K; };

struct StaticOrder {
    int nM, nN, nwg, G, c; size_t tstep;
    __host__ __device__ void init(int M, int N, int K, int G_, int c_) { nM = M / BM; nN = N / BM; nwg = nM * nN; G = G_; c = c_; tstep = (size_t)BM * K * 2; }
    __host__ __device__ bool next(int i, Unit& u) const {
        const long L = (long)i * G + c; if (L >= nwg) return false;
        int wgid = (int)L; { const int q = nwg / NXCD, r = nwg % NXCD, xcd = wgid % NXCD, off = wgid / NXCD; wgid = (xcd < r ? xcd * (q + 1) : r * (q + 1) + (xcd - r) * q) + off; }
        const int nig = WGM * nN, gid = wgid / nig, fm = gid * WGM, gsz = (nM - fm) < WGM ? (nM - fm) : WGM;
        u.pm = fm + ((wgid % nig) % gsz); u.pn = (wgid % nig) / gsz; u.aoff = (size_t)u.pm * tstep; u.boff = (size_t)u.pn * tstep; return true;
    }
    __device__ __forceinline__ void a_ready(const Unit&) const {}
    __device__ __forceinline__ void done(const Unit&) const {}
};

__device__ __forceinline__ unsigned cvt_pk_bf16(float lo, float hi) { unsigned r; asm volatile("v_cvt_pk_bf16_f32 %0, %1, %2" : "=v"(r) : "v"(lo), "v"(hi)); return r; }

struct EpiBf16 {
    static constexpr bool PERM = true, AFTER_DRAIN = false;
    bf16_t* O; int ldc;
    __device__ __forceinline__ void operator()(const f32x4 (&acc)[2][2][4][2], const Unit& u, int wr, int wc, int fr, int fq) const {
        const int row0 = u.pm * BM + wr * 64 + fr; const int col0 = u.pn * BM + wc * 32 + 8 * fq;
#pragma unroll
        for (int ai = 0; ai < 2; ++ai)
#pragma unroll
            for (int m = 0; m < 4; ++m) { bf16_t* rowp = O + (size_t)(row0 + ai * HALF + m * 16) * ldc + col0;
#pragma unroll
                for (int bj = 0; bj < 2; ++bj) { const f32x4 v0 = acc[ai][bj][m][0], v1 = acc[ai][bj][m][1];
                    u32x4 w; w.x = cvt_pk_bf16(v0[0], v0[1]); w.y = cvt_pk_bf16(v0[2], v0[3]); w.z = cvt_pk_bf16(v1[0], v1[1]); w.w = cvt_pk_bf16(v1[2], v1[3]);
                    *(u32x4*)(rowp + bj * HALF) = w; } }
    }
};
struct EpiSwiGLU {
    static constexpr bool PERM = true, AFTER_DRAIN = false;
    bf16_t* O; int ldc;
    __device__ __forceinline__ void operator()(const f32x4 (&acc)[2][2][4][2], const Unit& u, int wr, int wc, int fr, int fq) const {
        const int row0 = u.pm * BM + wr * 64 + fr; const int col0 = u.pn * HALF + wc * 32 + 8 * fq;
#pragma unroll
        for (int ai = 0; ai < 2; ++ai)
#pragma unroll
            for (int m = 0; m < 4; ++m) { bf16_t* rowp = O + (size_t)(row0 + ai * HALF + m * 16) * ldc + col0;
                float r[8];
#pragma unroll
                for (int n = 0; n < 2; ++n)
#pragma unroll
                    for (int j = 0; j < 4; ++j) { const float g = acc[ai][0][m][n][j], up = acc[ai][1][m][n][j]; r[n * 4 + j] = g * __builtin_amdgcn_rcpf(1.0f + __expf(-g)) * up; }
                u32x4 w; w.x = cvt_pk_bf16(r[0], r[1]); w.y = cvt_pk_bf16(r[2], r[3]); w.z = cvt_pk_bf16(r[4], r[5]); w.w = cvt_pk_bf16(r[6], r[7]);
                *(u32x4*)rowp = w; }
    }
};
struct EpiRouter {
    static constexpr bool PERM = false, AFTER_DRAIN = true;
    const float* bias_g; const float* bias_e; int* toke; float* tokw; unsigned* cnt; int row_base;
    __device__ __forceinline__ void fused(const f32x4 (&acc)[2][2][4][2], const Unit& u, int wr, int wc, int fr, int fq, PG8_LAS unsigned char* lds, int wid, int lane) const {
        PG8_LAS float* T = (PG8_LAS float*)lds;
        if (wc == 0 || (wc == 1 && fq == 0)) {
#pragma unroll
            for (int ai = 0; ai < 2; ++ai)
#pragma unroll
                for (int m = 0; m < 4; ++m) { const int row = ai * HALF + wr * 64 + m * 16 + fr;
#pragma unroll
                    for (int n = 0; n < 2; ++n) { if (wc == 1 && n == 1) continue; const int c0 = 32 * wc + 16 * n + 4 * fq;
#pragma unroll
                        for (int j = 0; j < 4; ++j) T[row * 37 + c0 + j] = acc[ai][0][m][n][j]; } }
        }
        asm volatile("s_waitcnt lgkmcnt(0)" ::: "memory"); __builtin_amdgcn_s_barrier(); asm volatile("" ::: "memory");
        const int row = wid * 64 + lane;
        if (row < 256) {
            float lg[4], e8[8];
#pragma unroll
            for (int q = 0; q < 4; ++q) lg[q] = T[row * 37 + q] + bias_g[q];
            int gi = 0; float gm = lg[0];
#pragma unroll
            for (int q = 1; q < 4; ++q) if (lg[q] > gm) { gm = lg[q]; gi = q; }
            float gs = 0.f;
#pragma unroll
            for (int q = 0; q < 4; ++q) gs += __expf(lg[q] - gm);
            const float gp = 1.0f / gs;
#pragma unroll
            for (int q = 0; q < 8; ++q) e8[q] = T[row * 37 + 4 + gi * 8 + q] + bias_e[gi * 8 + q];
            int i1 = 0; float m1 = e8[0];
#pragma unroll
            for (int q = 1; q < 8; ++q) if (e8[q] > m1) { m1 = e8[q]; i1 = q; }
            int i2 = -1; float m2 = -3.0e38f;
#pragma unroll
            for (int q = 0; q < 8; ++q) if (q != i1 && e8[q] > m2) { m2 = e8[q]; i2 = q; }
            const float a2 = __expf(m2 - m1), w1 = gp / (1.0f + a2), w2 = gp * a2 / (1.0f + a2);
            const int t = row_base + u.pm * BM + row, e1 = gi * 8 + i1, e2 = gi * 8 + i2;
            toke[t * 2] = e1; toke[t * 2 + 1] = e2; tokw[t * 2] = w1; tokw[t * 2 + 1] = w2;
            atomicAdd(cnt + e1, 1u); atomicAdd(cnt + e2, 1u);
        }
    }
};
struct EpiResid {
    static constexpr bool PERM = false, AFTER_DRAIN = false;
    const float* src_lat; float* dst_lat; const float* src_ctx; float* dst_ctx; const float* gate_lat; const float* gate_ctx; int nctx; int row_base;
    __device__ __forceinline__ void operator()(const f32x4 (&acc)[2][2][4][2], const Unit& u, int wr, int wc, int fr, int fq) const {
        const int row0 = row_base + u.pm * BM + wr * 64 + fr, col0 = u.pn * BM + wc * 32 + 4 * fq;
        const bool isctx = (row_base + u.pm * BM) < nctx;
        const float* gate = isctx ? gate_ctx : gate_lat;
        f32x4 gv[2][2];
#pragma unroll
        for (int bj = 0; bj < 2; ++bj)
#pragma unroll
            for (int n = 0; n < 2; ++n) gv[bj][n] = *(const f32x4*)(gate + col0 + bj * HALF + n * 16);
#pragma unroll
        for (int ai = 0; ai < 2; ++ai)
#pragma unroll
            for (int m = 0; m < 4; ++m) { const int r = row0 + ai * HALF + m * 16;
                const float* sp = isctx ? src_ctx + (size_t)r * 2048 : src_lat + (size_t)(r - nctx) * 2048;
                float* dp = isctx ? dst_ctx + (size_t)r * 2048 : dst_lat + (size_t)(r - nctx) * 2048;
#pragma unroll
                for (int bj = 0; bj < 2; ++bj)
#pragma unroll
                    for (int n = 0; n < 2; ++n) { const int c = col0 + bj * HALF + n * 16; const f32x4 s = *(const f32x4*)(sp + c); *(f32x4*)(dp + c) = s + gv[bj][n] * acc[ai][bj][m][n] * GSCALE; } }
    }
};
template <class Epi, class Sched, bool ALIGN_EPI = false, bool SP2 = false>
__device__ __forceinline__ void gemm_phase(PG8_LAS unsigned char* lds, const Gemm g, const Sched& S, const Epi& E, const int tid) {
    const int wid = __builtin_amdgcn_readfirstlane(tid >> 6), lane = tid & 63, wr = wid >> 2, wc = wid & 3, fr = lane & 15, fq = lane >> 4;
    const int K = g.K, nt = K / BK;
    unsigned voffA[2], voffB[2];
#pragma unroll
    for (int i = 0; i < 2; ++i) { int R, C; stage_rc(tid * 16 + i * 8192, R, C); const int Rb = Epi::PERM ? ((R & ~31) + perm32(R & 31)) : R;
        voffA[i] = (unsigned)(R * K + C) * 2u; voffB[i] = (unsigned)(Rb * K + C) * 2u; }
    const size_t kstep = (size_t)(BK * 2);
    const size_t hstep = (size_t)HALF * K * 2;
    const size_t tstep = 2 * hstep;
    const unsigned ldsw = (unsigned)wid * 1024u;
    const int aoff = lds_byte(wr * 64 + fr, fq * 8), boff = lds_byte(wc * 32 + fr, fq * 8);
#define PG8_SA(b, h) (((b) * 2 + (h)) * HTB)
#define PG8_SB(b, h) ((4 + (b) * 2 + (h)) * HTB)
#define PG8_STAGE(bufoff, gbase, voff) do { _Pragma("unroll") for (int _i = 0; _i < 2; ++_i) \
        __builtin_amdgcn_global_load_lds((const unsigned*)((const char*)(gbase) + (voff)[_i]), (PG8_LAS unsigned*)(lds + (bufoff) + ldsw + _i * 8192), 16, 0, 0); } while (0)
#define PG8_LDA(dst, b, h) do { _Pragma("unroll") for (int m = 0; m < 4; ++m) _Pragma("unroll") for (int k = 0; k < 2; ++k) dst[m][k] = *(const PG8_LAS bf16x8*)(lds + PG8_SA(b, h) + aoff + m * 2048 + k * 1024); } while (0)
#define PG8_LDB(dst, b, h) do { _Pragma("unroll") for (int n = 0; n < 2; ++n) _Pragma("unroll") for (int k = 0; k < 2; ++k) dst[n][k] = *(const PG8_LAS bf16x8*)(lds + PG8_SB(b, h) + boff + n * 2048 + k * 1024); } while (0)
#define PG8_MMA(ai, bj, At, Bt) do { __builtin_amdgcn_s_setprio(1); _Pragma("unroll") for (int m = 0; m < 4; ++m) _Pragma("unroll") for (int n = 0; n < 2; ++n) _Pragma("unroll") for (int k = 0; k < 2; ++k) \
        acc[ai][bj][m][n] = __builtin_amdgcn_mfma_f32_16x16x32_bf16(Bt[n][k], At[m][k], acc[ai][bj][m][n], 0, 0, 0); __builtin_amdgcn_s_setprio(0); } while (0)
#define PG8_WAIT_V(n) asm volatile("s_waitcnt vmcnt(" #n ")" ::: "memory")
#define PG8_WAIT_L(n) asm volatile("s_waitcnt lgkmcnt(" #n ")" ::: "memory")
#define PG8_BAR __builtin_amdgcn_s_barrier()
#define PG8_SCHED __builtin_amdgcn_sched_barrier(0)
    Unit cur, nxt; int ui = 0;
    if (!S.next(0, cur)) return;
    f32x4 acc[2][2][4][2];
    float zz_ = 0.f; asm volatile("" : "+v"(zz_));
#pragma unroll
    for (int a = 0; a < 2; ++a)
#pragma unroll
        for (int b = 0; b < 2; ++b)
#pragma unroll
            for (int m = 0; m < 4; ++m)
#pragma unroll
                for (int n = 0; n < 2; ++n) acc[a][b][m][n] = (f32x4){zz_, zz_, zz_, zz_};
    bf16x8 At[4][2], B0[2][2], B1[2][2];
    const char* cA = (const char*)g.A + cur.aoff; const char* cB = (const char*)g.Bt + cur.boff;
    S.a_ready(cur);
    if constexpr (SP2) {
        PG8_STAGE(PG8_SB(0, 0), cB, voffB); PG8_STAGE(PG8_SB(0, 1), cB + hstep, voffB); PG8_STAGE(PG8_SA(0, 0), cA, voffA); PG8_STAGE(PG8_SA(0, 1), cA + hstep, voffA);
        if (wr == 1) PG8_BAR;
        PG8_WAIT_V(2); PG8_BAR;
        PG8_STAGE(PG8_SB(1, 0), cB + kstep, voffB); PG8_STAGE(PG8_SA(1, 0), cA + kstep, voffA); PG8_STAGE(PG8_SB(1, 1), cB + hstep + kstep, voffB);
        PG8_WAIT_V(6); PG8_BAR;
    } else {
        PG8_STAGE(PG8_SB(0, 0), cB, voffB); PG8_STAGE(PG8_SA(0, 0), cA, voffA); PG8_STAGE(PG8_SB(0, 1), cB + hstep, voffB); PG8_STAGE(PG8_SA(0, 1), cA + hstep, voffA);
        if (wr == 1) PG8_BAR;
        PG8_WAIT_V(4); PG8_BAR;
        PG8_STAGE(PG8_SB(1, 0), cB + kstep, voffB); PG8_STAGE(PG8_SA(1, 0), cA + kstep, voffA); PG8_STAGE(PG8_SB(1, 1), cB + hstep + kstep, voffB);
        PG8_WAIT_V(6); PG8_BAR;
    }
    for (;;) {
        const bool has_next = S.next(ui + 1, nxt);
        const char* nA = has_next ? (const char*)g.A + nxt.aoff : cA; const char* nB = has_next ? (const char*)g.Bt + nxt.boff : cB;
        for (int t = 0; t < nt; t += 2) {
            const bool last = (t == nt - 2);
            const char* a1 = cA + (size_t)(t + 1) * kstep;
            const char* a2 = last ? nA : cA + (size_t)(t + 2) * kstep; const char* b2 = last ? nB : cB + (size_t)(t + 2) * kstep;
            const char* a3 = a2 + kstep; const char* b3 = b2 + kstep;
            if (last && has_next) S.a_ready(nxt);
            if constexpr (SP2) {
            PG8_LDB(B0, 0, 0); PG8_LDB(B1, 0, 1); PG8_SCHED; PG8_LDA(At, 0, 0); PG8_STAGE(PG8_SA(1, 1), a1 + hstep, voffA);
            PG8_WAIT_V(8); PG8_WAIT_L(0); PG8_BAR; PG8_MMA(0, 0, At, B0); PG8_MMA(0, 1, At, B1); PG8_BAR; PG8_SCHED;
            PG8_LDA(At, 0, 1); PG8_STAGE(PG8_SB(0, 0), b2, voffB); PG8_STAGE(PG8_SB(0, 1), b2 + hstep, voffB); PG8_STAGE(PG8_SA(0, 0), a2, voffA);
            PG8_WAIT_V(8); PG8_WAIT_L(0); PG8_BAR; PG8_MMA(1, 0, At, B0); PG8_MMA(1, 1, At, B1); PG8_BAR; PG8_SCHED;
            PG8_LDB(B0, 1, 0); PG8_LDB(B1, 1, 1); PG8_SCHED; PG8_LDA(At, 1, 0); PG8_STAGE(PG8_SA(0, 1), a2 + hstep, voffA);
            PG8_WAIT_V(8); PG8_WAIT_L(0); PG8_BAR; PG8_MMA(0, 0, At, B0); PG8_MMA(0, 1, At, B1); PG8_BAR; PG8_SCHED;
            PG8_LDA(At, 1, 1); PG8_STAGE(PG8_SB(1, 0), b3, voffB); PG8_STAGE(PG8_SB(1, 1), b3 + hstep, voffB); PG8_STAGE(PG8_SA(1, 0), a3, voffA);
            PG8_WAIT_V(8); PG8_WAIT_L(0); PG8_BAR; PG8_MMA(1, 0, At, B0); PG8_MMA(1, 1, At, B1); PG8_BAR; PG8_SCHED;
            } else {
            PG8_LDB(B0, 0, 0); PG8_SCHED; PG8_LDA(At, 0, 0); PG8_STAGE(PG8_SA(1, 1), a1 + hstep, voffA);
            PG8_WAIT_L(8); PG8_BAR; PG8_WAIT_L(0); PG8_MMA(0, 0, At, B0); PG8_BAR; PG8_SCHED;
            PG8_LDB(B1, 0, 1); PG8_STAGE(PG8_SB(0, 0), b2, voffB);
            PG8_BAR; PG8_WAIT_L(0); PG8_MMA(0, 1, At, B1); PG8_BAR;
            PG8_LDA(At, 0, 1); PG8_STAGE(PG8_SA(0, 0), a2, voffA);
            PG8_BAR; PG8_WAIT_L(0); PG8_MMA(1, 0, At, B0); PG8_BAR; PG8_SCHED;
            PG8_STAGE(PG8_SB(0, 1), b2 + hstep, voffB);
            PG8_WAIT_V(6); PG8_BAR; PG8_MMA(1, 1, At, B1); PG8_BAR;
            PG8_LDB(B0, 1, 0); PG8_SCHED; PG8_LDA(At, 1, 0); PG8_STAGE(PG8_SA(0, 1), a2 + hstep, voffA);
            PG8_WAIT_L(8); PG8_BAR; PG8_WAIT_L(0); PG8_MMA(0, 0, At, B0); PG8_BAR; PG8_SCHED;
            PG8_LDB(B1, 1, 1); PG8_STAGE(PG8_SB(1, 0), b3, voffB);
            PG8_BAR; PG8_WAIT_L(0); PG8_MMA(0, 1, At, B1); PG8_BAR;
            PG8_LDA(At, 1, 1); PG8_STAGE(PG8_SA(1, 0), a3, voffA);
            PG8_BAR; PG8_WAIT_L(0); PG8_MMA(1, 0, At, B0); PG8_BAR; PG8_SCHED;
            PG8_STAGE(PG8_SB(1, 1), b3 + hstep, voffB);
            PG8_WAIT_V(6); PG8_BAR; PG8_MMA(1, 1, At, B1); PG8_BAR;
            }
        }
        if constexpr (ALIGN_EPI) { if (wr == 0) PG8_BAR; }
        if constexpr (!Epi::AFTER_DRAIN) { E(acc, cur, wr, wc, fr, fq); S.done(cur); }
        if (!has_next) break;
#pragma unroll
        for (int a = 0; a < 2; ++a)
#pragma unroll
            for (int b = 0; b < 2; ++b)
#pragma unroll
                for (int m = 0; m < 4; ++m)
#pragma unroll
                    for (int n = 0; n < 2; ++n) acc[a][b][m][n] = (f32x4){zz_, zz_, zz_, zz_};
        cur = nxt; cA = nA; cB = nB; ++ui;
        if constexpr (ALIGN_EPI) { if (wr == 1) PG8_BAR; }
    }
    PG8_WAIT_V(0);
    if constexpr (!ALIGN_EPI) { if (wr == 0) PG8_BAR; }
    PG8_BAR;
    if constexpr (Epi::AFTER_DRAIN) { E.fused(acc, cur, wr, wc, fr, fq, lds, wid, lane); S.done(cur); }
#undef PG8_SA
#undef PG8_SB
#undef PG8_STAGE
#undef PG8_LDA
#undef PG8_LDB
#undef PG8_MMA
#undef PG8_WAIT_V
#undef PG8_WAIT_L
#undef PG8_BAR
#undef PG8_SCHED
}
}


constexpr int NWAVES = 8, NTHR = 512;
constexpr int DM = 2048, SEQ = 16384, NCTX = 256, NTOK = SEQ + NCTX, PW = 6720, PWP = 6912, NEXP = 32;
constexpr int C_GQKV = 0, C_GGATE = 1536, C_GBETA = 2048, C_GALPHA = 2064, C_SCB = 2080, C_SCC = 2592, C_SCX = 3104, C_LQ = 3616, C_LK = 3872, C_LV = 4128, C_LR = 4640,
              C_LLR = 5152, C_DQ = 5184, C_DK = 5696, C_DV = 6208;
constexpr int MAXSLOT = 41472;
constexpr float NEPS = 1e-6f;
enum { I_X = 0, I_C, I_CTX, I_CCTX, I_WMOD, I_BMOD, I_NORM1, I_NORM2, I_WIN, I_WOUT, I_GCONV, I_GALOG, I_GDT, I_GONORM, I_SCCONV, I_LGUP, I_LGBIAS, I_LONORM,
       I_DQN, I_DKN, I_DLAM, I_DON, I_RG, I_RGB, I_RE, I_REB, I_W1, I_W3, I_W2, N_IN };

constexpr size_t MiB = 1u << 20;
constexpr size_t WS_CTL = 0, CTL_ZERO_BYTES = 1 * MiB;
constexpr int CW_BAR = 4096;
constexpr int CW_CNT = 8192, CW_CUR = 8192 + 128;
constexpr size_t CTL_MODV = 256 * 1024;
constexpr size_t WS_SMALL = 1 * MiB;
constexpr size_t SM_ROPER = 0, SM_ROPEC = 32768, SM_LAM = 32768 + 8192;
constexpr size_t WS_MODP = 930 * MiB;
constexpr size_t WS_XCTX = 2 * MiB;
constexpr size_t WS_TOKE = 4 * MiB, WS_TOKW = WS_TOKE + 160 * 1024, WS_TOKS = WS_TOKW + 160 * 1024;
constexpr size_t WS_GBETA = 5 * MiB, WS_GDEC = WS_GBETA + 1280 * 1024;
constexpr size_t WS_WIN = 8 * MiB, WS_WOUT = 35 * MiB, WS_WUP = 43 * MiB, WS_WDN = 171 * MiB;
constexpr size_t WS_HBUF = 235 * MiB, WS_P = 300 * MiB, WS_MIX = 520 * MiB;
constexpr size_t WS_QR = 585 * MiB, WS_KR = 602 * MiB, WS_VT = 619 * MiB;
constexpr size_t WS_GQ = 636 * MiB, WS_GK = 669 * MiB, WS_GV = 702 * MiB, WS_LOGA = 735 * MiB;
constexpr size_t WS_OGDN = 768 * MiB, WS_OGLA = 833 * MiB, WS_PARK = 898 * MiB;
constexpr size_t WS_GQP = WS_OGDN, WS_GOP = WS_OGLA; constexpr size_t WS_GST = WS_GQP + 65 * MiB / 2; constexpr size_t WS_GLS = WS_GOP + 65 * MiB / 2;
constexpr size_t WS_GA = 936 * MiB, WS_GB = 1001 * MiB, WS_OL = 1066 * MiB;
constexpr size_t WS_DS = WS_HBUF;
constexpr size_t WS_GQB = 1131 * MiB, WS_ACH = 1164 * MiB, WS_EGL = 1164 * MiB + 640 * 1024, WS_WR = 1165 * MiB  , WS_END = 1166 * MiB;
constexpr size_t WS_AMOE = WS_P, WS_HMOE = WS_P + 162 * MiB;
static_assert(WS_HMOE + (size_t)MAXSLOT * 512 * 2 <= WS_MIX, "moe overlay");
#ifdef Y_SEPARATE
constexpr size_t WS_YMOE = WS_MIX;
#else
constexpr size_t WS_YMOE = WS_AMOE;
#endif

constexpr int RING_BYTES = 131072, LDSCTL_OFF = RING_BYTES, MISC_OFF = LDSCTL_OFF + 320, TILE_TAB_OFF = LDSCTL_OFF + 1024, LDS_BYTES = 147456;

#define GAS __attribute__((address_space(1)))
#define LAS __attribute__((address_space(3)))
typedef unsigned short bf16;
typedef unsigned v4u __attribute__((ext_vector_type(4)));
typedef float f32x4 __attribute__((ext_vector_type(4)));
typedef float f32x16 __attribute__((ext_vector_type(16)));
typedef short bf16x8 __attribute__((ext_vector_type(8)));
#define LDS_WAIT() asm volatile("s_waitcnt lgkmcnt(0)" ::: "memory")
#define VM_WAIT() asm volatile("s_waitcnt vmcnt(0)" ::: "memory")
__device__ __forceinline__ unsigned f2bf(float f) { unsigned u = __builtin_bit_cast(unsigned, f); return (u + 0x7fffu + ((u >> 16) & 1u)) >> 16; }
__device__ __forceinline__ unsigned pk2(float lo, float hi) { return f2bf(lo) | (f2bf(hi) << 16); }
__device__ __forceinline__ float bf2f(unsigned short b) { return __builtin_bit_cast(float, (unsigned)b << 16); }
__device__ __forceinline__ void unpack8(const v4u v, float (&f)[8]) {
#pragma unroll
    for (int i = 0; i < 4; ++i) { f[2 * i] = __builtin_bit_cast(float, v[i] << 16); f[2 * i + 1] = __builtin_bit_cast(float, v[i] & 0xffff0000u); }
}
__device__ __forceinline__ void load8(const bf16* p, float (&f)[8]) { unpack8(*(const v4u*)p, f); }
__device__ __forceinline__ v4u pack8(const float (&f)[8]) { v4u w; w.x = pk2(f[0], f[1]); w.y = pk2(f[2], f[3]); w.z = pk2(f[4], f[5]); w.w = pk2(f[6], f[7]); return w; }
__device__ __forceinline__ float siluf(float x) { return x / (1.0f + __expf(-x)); }
__device__ __forceinline__ float sigmoidf_(float x) { return 1.0f / (1.0f + __expf(-x)); }
__device__ __forceinline__ float softplusf_(float x) { return fmaxf(x, 0.f) + __logf(1.0f + __expf(-fabsf(x))); }
__device__ __forceinline__ float wave_sum(float v) {
#pragma unroll
    for (int o = 1; o < 64; o <<= 1) v += __shfl_xor(v, o);
    return v;
}

#define XB_TMO      128
#define XB_XCNT(j)  (256  + 64 * (j))
#define XB_XSUB(j)  (1280 + 64 * (j))
#define XB_XGEN(j)  (2304 + 64 * (j))
#define XB_TOP      3328
#define XB_TOPGEN   3392
#define XCD_BAR_WORDS 3456
#define XB_SPIN_CAP (1u << 18)
__device__ __forceinline__ unsigned xb_ld(unsigned* p)              { return __hip_atomic_load(p, __ATOMIC_RELAXED, __HIP_MEMORY_SCOPE_AGENT); }
__device__ __forceinline__ unsigned xb_add(unsigned* p, unsigned v) { return __hip_atomic_fetch_add(p, v, __ATOMIC_RELAXED, __HIP_MEMORY_SCOPE_AGENT); }
__device__ __forceinline__ unsigned xb_xcc_id() { return (unsigned)__builtin_amdgcn_s_getreg((3 << 11) | 20) & 0xFu; }
#define XB_SPIN(cond, bar) do { unsigned _sp = 0; while (cond) { __builtin_amdgcn_s_sleep(1); \
    if ((++_sp & 255u) == 0u) { if (xb_ld(&(bar)[XB_TMO])) break; if (_sp > XB_SPIN_CAP) { atomicAdd(&(bar)[XB_TMO], 1u); break; } } } } while (0)
struct XcdBarrier { unsigned* bar; unsigned x; volatile LAS unsigned* st; };
__device__ __forceinline__ XcdBarrier xcd_barrier_post(unsigned* bar, volatile LAS unsigned* st) {
    XcdBarrier b; b.bar = bar; b.x = xb_xcc_id(); b.st = st;
    if (threadIdx.x == 0) (void)xb_add(&bar[XB_XCNT(b.x)], 1u);
    return b;
}
__device__ __forceinline__ unsigned long long xcd_barrier_complete(unsigned* bar, unsigned x) {
    const unsigned G = gridDim.x * gridDim.y * gridDim.z;
    unsigned sum, cnt, mine, sp = 0u;
    for (;;) {
        sum = 0u; cnt = 0u; mine = 0u;
#pragma unroll
        for (unsigned j = 0; j < 16; ++j) { const unsigned c = xb_ld(&bar[XB_XCNT(j)]); sum += c; cnt += (c > 0u) ? 1u : 0u; mine = (j == x) ? c : mine; }
        if (sum == G) break;
        __builtin_amdgcn_s_sleep(1);
        if ((++sp & 255u) == 0u) { if (xb_ld(&bar[XB_TMO])) break; if (sp > XB_SPIN_CAP) { atomicAdd(&bar[XB_TMO], 1u); break; } }
    }
    const unsigned nloc = mine > 0u ? mine : 1u, nx = cnt > 0u ? cnt : 1u;
    return ((unsigned long long)nx << 32) | nloc;
}
__device__ __forceinline__ void xcd_barrier(const XcdBarrier& b) {
    asm volatile("s_waitcnt vmcnt(0)" ::: "memory");
    __syncthreads();
    if (threadIdx.x == 0) {
        unsigned* bar = b.bar;
        __builtin_amdgcn_s_waitcnt(0);
        unsigned nloc = b.st[0], nx = b.st[1];
        if (nloc == 0u) { const unsigned long long r_ = xcd_barrier_complete(bar, b.x); nloc = (unsigned)r_; nx = (unsigned)(r_ >> 32); b.st[0] = nloc; b.st[1] = nx; }
        const unsigned old = xb_add(&bar[XB_XSUB(b.x)], 1u);
        const unsigned gen = old / nloc;
        if (old + 1u == (gen + 1u) * nloc) {
            __builtin_amdgcn_fence(__ATOMIC_RELEASE, "agent");
            asm volatile("s_waitcnt vmcnt(0)" ::: "memory");
            const unsigned og = xb_add(&bar[XB_TOP], 1u);
            const unsigned tg = og / nx;
            if (og + 1u == (tg + 1u) * nx) xb_add(&bar[XB_TOPGEN], 1u);
            else XB_SPIN(xb_ld(&bar[XB_TOPGEN]) == tg, bar);
            __builtin_amdgcn_fence(__ATOMIC_ACQUIRE, "agent");
            xb_add(&bar[XB_XGEN(b.x)], 1u);
            asm volatile("s_waitcnt vmcnt(0)" ::: "memory");
        } else {
            XB_SPIN(xb_ld(&bar[XB_XGEN(b.x)]) == gen, bar);
            __builtin_amdgcn_fence(__ATOMIC_ACQUIRE, "agent");
            asm volatile("s_waitcnt vmcnt(0)" ::: "memory");
        }
    }
    __syncthreads();
}

struct Args { const float* in[N_IN]; float* out; unsigned char* ws; int ph_lo, ph_hi, rep, pad; };
typedef const __attribute__((address_space(4))) Args* CArgsP;
struct InProxy { CArgsP p; __device__ __forceinline__ const float* operator[](int i) const { return p->in[i]; } };
struct ArgView { InProxy in; };
struct Frame {
    LAS unsigned char* lds;
    unsigned char* ws; unsigned* ctl;
    float* out;
    int tid, lane, wave, G, bid;
};
__device__ __forceinline__ float* modv_ptr(const Frame& F, int l, int which  ) { return (float*)(F.ws + WS_CTL + CTL_MODV) + (size_t)(l * 2 + which) * 12288; }

__device__ __forceinline__ void ph_prologue(const Frame& F, const ArgView& A) {
    const float* cvec = A.in[I_C]; const float* cctx = A.in[I_CCTX];
    for (int item = F.bid; item < 768; item += F.G) {
        const int l = item / 384, rem = item % 384, cc = rem / 32, ks = rem % 32, col = cc * 1024 + F.tid * 2;
        const float* W = A.in[I_WMOD] + (size_t)l * 2048 * 12288;
        float a0 = 0.f, a1 = 0.f, b0 = 0.f, b1 = 0.f;
#pragma unroll 16
        for (int i = ks * 64; i < ks * 64 + 64; ++i) {
            const float sl = siluf(cvec[i]), sx = siluf(cctx[i]);
            const float2 w = *(const float2*)(W + (size_t)i * 12288 + col);
            a0 += sl * w.x; a1 += sl * w.y; b0 += sx * w.x; b1 += sx * w.y;
        }
        float* pl = (float*)(F.ws + WS_MODP) + ((size_t)((l * 32 + ks) * 2 + 0)) * 12288 + col; float* pc = pl + 12288;
        *(float2*)pl = make_float2(a0, a1); *(float2*)pc = make_float2(b0, b1);
    }
    float* small = (float*)(F.ws + WS_SMALL);
    for (int i = F.bid * NTHR + F.tid; i < 320 * 16; i += F.G * NTHR) {
        const int pos = i / 16, fi = i % 16; const float inv = powf(10000.f, -(float)fi / 16.f);
        const float ang = (float)(pos < 256 ? pos : pos - 256) * inv;
        float* dst = pos < 256 ? small + SM_ROPER / 4 + (pos * 16 + fi) * 2 : small + SM_ROPEC / 4 + ((pos - 256) * 16 + fi) * 2;
        dst[0] = cosf(ang); dst[1] = sinf(ang);
    }
    if (F.bid == 0 && F.wave == 0) {
#pragma unroll
        for (int l = 0; l < 2; ++l) {
            const float* lp = A.in[I_DLAM] + l * 256;
            const float s1 = wave_sum(lp[F.lane] * lp[64 + F.lane]), s2 = wave_sum(lp[128 + F.lane] * lp[192 + F.lane]);
            const float lam_init = 0.8f - 0.6f * expf(-0.3f * (float)l);
            if (F.lane == 0) small[SM_LAM / 4 + l] = expf(s1) - expf(s2) + lam_init;
        }
    }
}

__device__ __forceinline__ void transpose_item(const float* W, int K, int N, bf16* WT, int k0, int n0, int drow0, LAS float* scr, int lane) {
#pragma unroll 8
    for (int i = 0; i < 32; ++i) { const int kk = 2 * i + (lane >> 5); scr[kk * 33 + (lane & 31)] = W[(size_t)(k0 + kk) * N + n0 + (lane & 31)]; }
    LDS_WAIT(); asm volatile("" ::: "memory");
    const int c = lane & 7;
#pragma unroll
    for (int j = 0; j < 4; ++j) { const int n = (lane >> 3) + 8 * j; const LAS float* s = scr + (8 * c) * 33 + n;
        v4u o; o.x = pk2(s[0 * 33], s[1 * 33]); o.y = pk2(s[2 * 33], s[3 * 33]); o.z = pk2(s[4 * 33], s[5 * 33]); o.w = pk2(s[6 * 33], s[7 * 33]);
        *(v4u*)(WT + (size_t)(drow0 + n) * K + k0 + 8 * c) = o; }
    LDS_WAIT(); asm volatile("" ::: "memory");
}
__device__ __forceinline__ void ph_convert(const Frame& F, const ArgView& A, int l) {
    LAS float* scr = (LAS float*)(F.lds + F.wave * 16384);
    const int gw = F.bid * NWAVES + F.wave, NGW = F.G * NWAVES;
    constexpr int I_IN = 32 * 210, I_OUT = 32 * 64, I_E13 = 32 * 16, I_E2 = 8 * 64;
    constexpr int NITEMS = I_IN + I_OUT + NEXP * (2 * I_E13 + I_E2);
    bf16* win = (bf16*)(F.ws + WS_WIN); bf16* wout = (bf16*)(F.ws + WS_WOUT); bf16* wup = (bf16*)(F.ws + WS_WUP); bf16* wdn = (bf16*)(F.ws + WS_WDN);
    for (int it = gw; it < NITEMS; it += NGW) {
        int r = it;
        if (r < I_IN) { const int kb = r / 210, nb = r % 210; transpose_item(A.in[I_WIN] + (size_t)l * 2048 * PW, 2048, PW, win, 64 * kb, 32 * nb, 32 * nb, scr, F.lane); continue; } r -= I_IN;
        if (r < I_OUT) { const int kb = r / 64, nb = r % 64; transpose_item(A.in[I_WOUT] + (size_t)l * 2048 * 2048, 2048, 2048, wout, 64 * kb, 32 * nb, 32 * nb, scr, F.lane); continue; } r -= I_OUT;
        const int e = r / (2 * I_E13 + I_E2); r %= (2 * I_E13 + I_E2);
        if (r < 2 * I_E13) { const int w3 = r / I_E13, q = r % I_E13, kb = q / 16, nb = q % 16, n0 = 32 * nb;
            const float* W = (w3 ? A.in[I_W3] : A.in[I_W1]) + ((size_t)l * NEXP + e) * 2048 * 512;
            transpose_item(W, 2048, 512, wup + (size_t)e * 1024 * 2048, 64 * kb, n0, (n0 / 128) * 256 + (n0 % 128) + (w3 ? 128 : 0), scr, F.lane); continue; }
        r -= 2 * I_E13;
        { const int kb = r / 64, nb = r % 64; const float* W = A.in[I_W2] + ((size_t)l * NEXP + e) * 512 * 2048;
          transpose_item(W, 512, 2048, wdn + (size_t)e * 2048 * 512, 64 * kb, 32 * nb, 32 * nb, scr, F.lane); }
    }
    if (l == 0) {
        for (int i = F.bid * NTHR + F.tid; i < 2 * 2 * 12288; i += F.G * NTHR) { const int ll = i / (2 * 12288), which = (i / 12288) & 1, col = i % 12288;
            float sacc = A.in[I_BMOD][ll * 12288 + col];
            for (int ks = 0; ks < 32; ++ks) sacc += ((const float*)(F.ws + WS_MODP))[((size_t)((ll * 32 + ks) * 2 + which)) * 12288 + col];
            modv_ptr(F, ll, which)[col] = sacc; }
    }
    {
        bf16* wr = (bf16*)(F.ws + WS_WR); const float* rg = A.in[I_RG] + (size_t)l * 2048 * 4; const float* re = A.in[I_RE] + (size_t)l * 2048 * 32;
        for (int i = F.bid * NTHR + F.tid; i < 256 * 2048; i += F.G * NTHR) { const int n = i >> 11, k = i & 2047;
            const float v = n < 4 ? rg[k * 4 + n] : (n < 36 ? re[k * 32 + (n - 4)] : 0.f); wr[i] = (bf16)f2bf(v); }
    }
    unsigned zu_ = 0u; asm volatile("" : "+v"(zu_));
    v4u* z = (v4u*)(win + (size_t)PW * 2048);
    for (int i = F.bid * NTHR + F.tid; i < (PWP - PW) * 2048 / 8; i += F.G * NTHR) z[i] = (v4u){zu_, zu_, zu_, zu_};
}

template <int WHICH>
__device__ __forceinline__ void ph_norm(const Frame& F, const ArgView& A, int l, const float* xlat, const float* xctx, int row_lo) {
    const int gw = F.bid * NWAVES + F.wave, NGW = F.G * NWAVES;
    const float* gain = A.in[WHICH == 0 ? I_NORM1 : I_NORM2] + l * 2048;
    bf16* hb = (bf16*)(F.ws + WS_HBUF);
    unsigned* cnt = F.ctl + CW_CNT + 64 * l;
    int* toke = (int*)(F.ws + WS_TOKE); float* tokw = (float*)(F.ws + WS_TOKW);
    const float* rg = A.in[I_RG] + (size_t)l * 2048 * 4; const float* re = A.in[I_RE] + (size_t)l * 2048 * 32;
    for (int r = row_lo + gw; r < NTOK; r += NGW) {
        const bool isctx = r < NCTX;
        const float* xr = isctx ? xctx + (size_t)r * 2048 : xlat + (size_t)(r - NCTX) * 2048;
        const float* mod = modv_ptr(F, l, isctx ? 1 : 0);
        const float* shift = mod + (WHICH == 0 ? 0 : 3) * 2048; const float* scale = mod + (WHICH == 0 ? 1 : 4) * 2048;
        f32x4 v[8]; float ss = 0.f;
#pragma unroll
        for (int j = 0; j < 8; ++j) { v[j] = *(const f32x4*)(xr + 4 * F.lane + 256 * j); ss += (v[j].x * v[j].x + v[j].y * v[j].y) + (v[j].z * v[j].z + v[j].w * v[j].w); }
        const float rs = 1.0f / sqrtf(wave_sum(ss) * (1.f / 2048.f) + NEPS);
#pragma unroll
        for (int j = 0; j < 8; ++j) { const int c = 4 * F.lane + 256 * j;
            const f32x4 g = *(const f32x4*)(gain + c), sh = *(const f32x4*)(shift + c), sc = *(const f32x4*)(scale + c);
            v[j] = (v[j] * rs * g) * (sc + 1.0f) + sh;
            uint2 o; o.x = pk2(v[j].x, v[j].y); o.y = pk2(v[j].z, v[j].w);
            *(uint2*)(hb + (size_t)r * 2048 + c) = o; }
    }
}

__device__ __forceinline__ void ph_prep(const Frame& F, const ArgView& A, int l) {
    const int gw = F.bid * NWAVES + F.wave, NGW = F.G * NWAVES, lane = F.lane;
    const bf16* P = (const bf16*)(F.ws + WS_P);
    bf16* mix = (bf16*)(F.ws + WS_MIX);
    float* GQ = (float*)(F.ws + WS_GQ); float* GK = (float*)(F.ws + WS_GK); float* GV = (float*)(F.ws + WS_GV);
    float* GBETA = (float*)(F.ws + WS_GBETA); float* GDEC = (float*)(F.ws + WS_GDEC); float* LOGA = (float*)(F.ws + WS_LOGA);
    bf16* QR = (bf16*)(F.ws + WS_QR); bf16* KR = (bf16*)(F.ws + WS_KR);
    const float* small = (const float*)(F.ws + WS_SMALL);
    const float* scw = A.in[I_SCCONV] + l * 3 * 512; const float* gcw = A.in[I_GCONV] + l * 3 * 1536;
    const float* gup = A.in[I_LGUP] + l * 2 * 16 * 256; const float* gbias = A.in[I_LGBIAS] + l * 512;
    for (int r = gw; r < NTOK; r += NGW) {
        const bf16* pr = P + (size_t)r * PWP;
        const int seg_lo = r < NCTX ? 0 : NCTX, seg_hi = r < NCTX ? NCTX : NTOK;
        const bool hp = r > seg_lo, hn = r + 1 < seg_hi;
        const bf16* pm = hp ? pr - PWP : pr; const bf16* pn = hn ? pr + PWP : pr;
        { const int col = 8 * lane; float c0[8], x0[8], cm[8], xm[8], cn[8], xn[8], b[8], w0[8], w1[8], w2[8], y[8];
          load8(pr + C_SCC + col, c0); load8(pr + C_SCX + col, x0); load8(pr + C_SCB + col, b);
          load8(pm + C_SCC + col, cm); load8(pm + C_SCX + col, xm); load8(pn + C_SCC + col, cn); load8(pn + C_SCX + col, xn);
#pragma unroll
          for (int j = 0; j < 8; ++j) { w0[j] = scw[col + j]; w1[j] = scw[512 + col + j]; w2[j] = scw[1024 + col + j]; }
#pragma unroll
          for (int j = 0; j < 8; ++j) { const float um = hp ? cm[j] * xm[j] : 0.f, un = hn ? cn[j] * xn[j] : 0.f; y[j] = b[j] * (w0[j] * um + w1[j] * (c0[j] * x0[j]) + w2[j] * un); }
          *(v4u*)(mix + (size_t)r * 2048 + 512 + col) = pack8(y); }
    }
    asm volatile("" ::: "memory");
    for (int r = gw; r < NTOK; r += NGW) {
        const bf16* pr = P + (size_t)r * PWP;
        const int seg_lo = r < NCTX ? 0 : NCTX, seg_hi = r < NCTX ? NCTX : NTOK;
        const bool hp = r > seg_lo, hn = r + 1 < seg_hi;
        const bf16* pm = hp ? pr - PWP : pr; const bf16* pn = hn ? pr + PWP : pr;
#pragma unroll 1
        for (int part = 0; part < 3; ++part) { __builtin_amdgcn_sched_barrier(0); const int col = part * 512 + 8 * lane; float x0[8], xm[8], xn[8], y[8];
          load8(pr + C_GQKV + col, x0); load8(pm + C_GQKV + col, xm); load8(pn + C_GQKV + col, xn);
          float ss = 0.f;
#pragma unroll
          for (int j = 0; j < 8; ++j) { const float a = gcw[col + j] * (hp ? xm[j] : 0.f) + gcw[1536 + col + j] * x0[j] + gcw[3072 + col + j] * (hn ? xn[j] : 0.f); y[j] = siluf(a); ss += y[j] * y[j]; }
          if (part < 2) { ss += __shfl_xor(ss, 1); ss += __shfl_xor(ss, 2); ss += __shfl_xor(ss, 4); const float rs = 1.0f / sqrtf(ss + NEPS);
#pragma unroll
            for (int j = 0; j < 8; ++j) y[j] *= rs; }
          float* dst = (part == 0 ? GQ : part == 1 ? GK : GV) + (size_t)r * 512 + 8 * lane;
          *(f32x4*)dst = (f32x4){y[0], y[1], y[2], y[3]}; *(f32x4*)(dst + 4) = (f32x4){y[4], y[5], y[6], y[7]}; }
        if (lane < 16) { const float be = sigmoidf_(bf2f(pr[C_GBETA + lane])), al = bf2f(pr[C_GALPHA + lane]);
          const float g = -expf(A.in[I_GALOG][l * 16 + lane]) * softplusf_(al + A.in[I_GDT][l * 16 + lane]);
          GBETA[r * 16 + lane] = be; GDEC[r * 16 + lane] = g; }
    }
    asm volatile("" ::: "memory");
    for (int r = gw; r < NTOK; r += NGW) {
        const bf16* pr = P + (size_t)r * PWP;
        const int seg_lo = r < NCTX ? 0 : NCTX, seg_hi = r < NCTX ? NCTX : NTOK;
        const bool hp = r > seg_lo, hn = r + 1 < seg_hi;
        const bf16* pm = hp ? pr - PWP : pr; const bf16* pn = hn ? pr + PWP : pr;
        { const int dir = lane >> 5, c = (8 * lane) & 255; float lr[16];
          { float t0[8], t1[8]; load8(pr + C_LLR + dir * 16, t0); load8(pr + C_LLR + dir * 16 + 8, t1);
#pragma unroll
            for (int j = 0; j < 8; ++j) { lr[j] = t0[j]; lr[8 + j] = t1[j]; } }
          float z[8];
#pragma unroll
          for (int j = 0; j < 8; ++j) z[j] = gbias[dir * 256 + c + j];
#pragma unroll
          for (int q = 0; q < 16; ++q) { const float* gp = gup + (dir * 16 + q) * 256 + c; const f32x4 g0 = *(const f32x4*)gp, g1 = *(const f32x4*)(gp + 4);
            z[0] += lr[q] * g0.x; z[1] += lr[q] * g0.y; z[2] += lr[q] * g0.z; z[3] += lr[q] * g0.w; z[4] += lr[q] * g1.x; z[5] += lr[q] * g1.y; z[6] += lr[q] * g1.z; z[7] += lr[q] * g1.w; }
#pragma unroll
          for (int j = 0; j < 8; ++j) z[j] = -(softplusf_(-z[j])) * (1.0f / 16.0f);
          float* dst = LOGA + (size_t)r * 512 + 8 * lane;
          *(f32x4*)dst = (f32x4){z[0], z[1], z[2], z[3]}; *(f32x4*)(dst + 4) = (f32x4){z[4], z[5], z[6], z[7]}; }
    }
    asm volatile("" ::: "memory");
    for (int r = gw; r < NTOK; r += NGW) {
        const bf16* pr = P + (size_t)r * PWP;
        const int seg_lo = r < NCTX ? 0 : NCTX, seg_hi = r < NCTX ? NCTX : NTOK;
        const bool hp = r > seg_lo, hn = r + 1 < seg_hi;
        const bf16* pm = hp ? pr - PWP : pr; const bf16* pn = hn ? pr + PWP : pr;
#pragma unroll 1
        for (int which = 0; which < 2; ++which) { __builtin_amdgcn_sched_barrier(0); float x[8]; load8(pr + (which == 0 ? C_DQ : C_DK) + 8 * lane, x);
          float ss = 0.f;
#pragma unroll
          for (int j = 0; j < 8; ++j) ss += x[j] * x[j];
          ss += __shfl_xor(ss, 1); ss += __shfl_xor(ss, 2); ss += __shfl_xor(ss, 4);
          const float rs = 1.0f / sqrtf(ss * (1.f / 64.f) + NEPS); const int sub = lane & 7;
          const float* gn = A.in[which == 0 ? I_DQN : I_DKN] + l * 64 + 8 * sub;
#pragma unroll
          for (int j = 0; j < 8; ++j) x[j] = x[j] * rs * gn[j];
          if (r >= NCTX) { const int pos = r - NCTX, prow = pos >> 6, pcol = pos & 63, quarter = sub >> 1;
            const float* tab = quarter < 2 ? small + SM_ROPER / 4 + (prow * 16 + 8 * (sub & 1)) * 2 : small + SM_ROPEC / 4 + (pcol * 16 + 8 * (sub & 1)) * 2;
#pragma unroll
            for (int j = 0; j < 8; ++j) { const float partner = __shfl_xor(x[j], 2); const float cs = tab[2 * j], sn = tab[2 * j + 1];
              x[j] = (quarter & 1) ? x[j] * cs + partner * sn : x[j] * cs - partner * sn; } }
          if (which == 0) {
#pragma unroll
            for (int j = 0; j < 8; ++j) x[j] *= 0.18033688011112042f; }
          const int h = lane >> 4;
          *(v4u*)((which == 0 ? QR : KR) + ((size_t)h * NTOK + r) * 128 + 8 * (lane & 15)) = pack8(x); }
    }
    bf16* VT = (bf16*)(F.ws + WS_VT);
    LAS bf16* tl = (LAS bf16*)F.lds;
    for (int it = F.bid; it < 4 * (NTOK / 64); it += F.G) {
        const int h = it / (NTOK / 64), key0 = (it % (NTOK / 64)) * 64;
#pragma unroll
        for (int i = 0; i < 2; ++i) { const int id = F.tid + 512 * i, key = id >> 4, dvc = id & 15;
            const v4u v = *(const v4u*)(P + (size_t)(key0 + key) * PWP + C_DV + h * 128 + 8 * dvc);
            const int k16 = key & 15, pos = (key & ~15) | ((k16 >= 4 && k16 < 8) ? k16 + 4 : (k16 >= 8 && k16 < 12) ? k16 - 4 : k16);
#pragma unroll
            for (int j = 0; j < 4; ++j) { tl[(8 * dvc + 2 * j) * 72 + pos] = (bf16)(v[j] & 0xffffu); tl[(8 * dvc + 2 * j + 1) * 72 + pos] = (bf16)(v[j] >> 16); } }
        __syncthreads();
#pragma unroll
        for (int i = 0; i < 2; ++i) { const int id = F.tid + 512 * i, dv = id >> 3, ch = id & 7;
            const v4u v = *(const LAS v4u*)(tl + dv * 72 + 8 * ch);
            *(v4u*)(VT + ((size_t)h * 128 + dv) * NTOK + key0 + 8 * ch) = v; }
        __syncthreads();
    }
}

__device__ __forceinline__ float rdl(float v, int i) { return __builtin_bit_cast(float, __builtin_amdgcn_readlane(__builtin_bit_cast(int, v), i)); }
__device__ __forceinline__ void gdn_seq_chain(const Frame& F, int h, int d) {
    const float* GQ = (const float*)(F.ws + WS_GQ); const float* GK = (const float*)(F.ws + WS_GK); const float* GV = (const float*)(F.ws + WS_GV);
    const float* GBETA = (const float*)(F.ws + WS_GBETA); const float* GDEC = (const float*)(F.ws + WS_GDEC);
    float* OG = (float*)(F.ws + WS_OGDN) + (size_t)d * NTOK * 512;
    const int lane = F.lane;
    float S[64];
#pragma unroll
    for (int i = 0; i < 64; ++i) S[i] = 0.f;
    auto rowof = [&](int step) { return d == 0 ? step : (step < NCTX ? NCTX - 1 - step : NTOK - 1 - (step - NCTX)); };
    int r = rowof(0);
    float nk = GK[(size_t)r * 512 + h * 64 + lane], nq = GQ[(size_t)r * 512 + h * 64 + lane], nv = GV[(size_t)r * 512 + h * 64 + lane], ng = GDEC[r * 16 + d * 8 + h], nb = GBETA[r * 16 + d * 8 + h];
    for (int step = 0; step < NTOK; ++step) {
        const float kk = nk, qq = nq, vv = nv, g = ng, b = nb; const int rc = r;
        if (step + 1 < NTOK) { r = rowof(step + 1);
            nk = GK[(size_t)r * 512 + h * 64 + lane]; nq = GQ[(size_t)r * 512 + h * 64 + lane]; nv = GV[(size_t)r * 512 + h * 64 + lane]; ng = GDEC[r * 16 + d * 8 + h]; nb = GBETA[r * 16 + d * 8 + h]; }
        const float eg = __expf(g);
        float ks = 0.f;
#pragma unroll
        for (int i = 0; i < 64; ++i) ks += rdl(kk, i) * S[i];
        const float vn = b * (vv - eg * ks);
        float o = 0.f;
#pragma unroll
        for (int i = 0; i < 64; ++i) { S[i] = eg * S[i] + rdl(kk, i) * vn; o += rdl(qq, i) * S[i]; }
        OG[(size_t)rc * 512 + h * 64 + lane] = o * 0.125f;
    }
}
__device__ __forceinline__ void gla_seq_chain(const Frame& F, int h, int d, int half) {
    const bf16* P = (const bf16*)(F.ws + WS_P); const float* LOGA = (const float*)(F.ws + WS_LOGA);
    float* OL = (float*)(F.ws + WS_OGLA) + (size_t)d * NTOK * 512;
    const int lane = F.lane;
    float S[64];
#pragma unroll
    for (int i = 0; i < 64; ++i) S[i] = 0.f;
    auto rowof = [&](int step) { return d == 0 ? step : (step < NCTX ? NCTX - 1 - step : NTOK - 1 - (step - NCTX)); };
    int r = rowof(0);
    float na = LOGA[(size_t)r * 512 + d * 256 + h * 64 + lane]; unsigned short nk = P[(size_t)r * PWP + C_LK + h * 64 + lane], nq = P[(size_t)r * PWP + C_LQ + h * 64 + lane], nv = P[(size_t)r * PWP + C_LV + h * 128 + half * 64 + lane];
    for (int step = 0; step < NTOK; ++step) {
        const float a = __expf(na), kk = bf2f(nk), qq = bf2f(nq) * 0.125f, vv = bf2f(nv); const int rc = r;
        if (step + 1 < NTOK) { r = rowof(step + 1);
            na = LOGA[(size_t)r * 512 + d * 256 + h * 64 + lane]; nk = P[(size_t)r * PWP + C_LK + h * 64 + lane]; nq = P[(size_t)r * PWP + C_LQ + h * 64 + lane]; nv = P[(size_t)r * PWP + C_LV + h * 128 + half * 64 + lane]; }
        float o = 0.f;
#pragma unroll
        for (int i = 0; i < 64; ++i) { S[i] = rdl(a, i) * S[i] + rdl(kk, i) * vv; o += rdl(qq, i) * S[i]; }
        OL[(size_t)rc * 512 + h * 128 + half * 64 + lane] = o;
    }
}

constexpr int ATT_BUF = 24576;
__device__ __forceinline__ int att_swz(int row) { return ((row >> 1) & 1) | (((row >> 3) & 1) << 1) | (((row >> 4) & 1) << 2); }
__device__ __forceinline__ int fresh_lane() { int l_; asm volatile("v_mbcnt_lo_u32_b32 %0, -1, 0\n\tv_mbcnt_hi_u32_b32 %0, -1, %0" : "=v"(l_)); return l_; }
__device__ __forceinline__ void attn_unit(const Frame& F, const ArgView& A, int l, int h, int qrow0, int ntiles) {
    const bf16* QRh = (const bf16*)(F.ws + WS_QR) + (size_t)h * NTOK * 128; const bf16* KRh = (const bf16*)(F.ws + WS_KR) + (size_t)h * NTOK * 128;
    const bf16* VTh = (const bf16*)(F.ws + WS_VT) + (size_t)h * 128 * NTOK;
    const int w = F.wave;
    LAS unsigned char* lds = F.lds;
#pragma unroll 1
    for (int c = 0; c < 2; ++c) {
        bf16x8 qf[4]; int foff[4];
        { const int ln = fresh_lane(), l31 = ln & 31, hh = ln >> 5; const unsigned qoff = (unsigned)((qrow0 + 32 * w + l31) * 128 + 8 * hh) + 64u * c;
#pragma unroll
          for (int ks = 0; ks < 4; ++ks) { qf[ks] = *(const bf16x8*)(QRh + (qoff + 16u * ks)); foff[ks] = l31 * 128 + (((2 * ks + hh) ^ att_swz(l31)) << 4); } }
        f32x16 O[4];
        float zf_ = 0.f; asm volatile("" : "+v"(zf_));
#pragma unroll
        for (int mv = 0; mv < 4; ++mv)
#pragma unroll
            for (int i = 0; i < 16; ++i) O[mv][i] = zf_;
        float lsum = zf_;
        __syncthreads();
        { const int tl = w * 64 + fresh_lane(), kr = tl >> 3, kl = (tl & 7) ^ att_swz(kr);
          const unsigned kx = (unsigned)(kr * 128 + 8 * kl) + 64u * c, vx = (unsigned)(kr * NTOK + 8 * kl);
          const v4u k0 = *(const v4u*)(KRh + kx), v0 = *(const v4u*)(VTh + vx), v1 = *(const v4u*)(VTh + (vx + 64u * NTOK));
          *(LAS v4u*)(lds + tl * 16) = k0; *(LAS v4u*)(lds + 8192 + tl * 16) = v0; *(LAS v4u*)(lds + 16384 + tl * 16) = v1; }
        __syncthreads();
        bf16x8 pfp[2];
#pragma unroll
        for (int s = 0; s < 2; ++s) pfp[s] = __builtin_bit_cast(bf16x8, (v4u){0u, 0u, 0u, 0u});
        int vprev = 8192;
        int cur = 0;
#pragma unroll 1
        for (int t = 0; t < ntiles; ++t) {
            const int nxt = cur == 2 * ATT_BUF ? 0 : cur + ATT_BUF;
            v4u sk, sv0, sv1;
            {
                const int tn = t + 1 < ntiles ? t + 1 : t; const int tl = w * 64 + fresh_lane(), kr = tl >> 3, kl = (tl & 7) ^ att_swz(kr);
                const unsigned kx = (unsigned)(kr * 128 + 8 * kl) + 64u * c + (unsigned)tn * 8192u, vx = (unsigned)(kr * NTOK + 8 * kl) + (unsigned)tn * 64u;
                sk = *(const v4u*)(KRh + kx); sv0 = *(const v4u*)(VTh + vx); sv1 = *(const v4u*)(VTh + (vx + 64u * NTOK)); }
#pragma unroll
            for (int mt = 0; mt < 2; ++mt) {
                f32x16 S;
#pragma unroll
                for (int i = 0; i < 16; ++i) S[i] = 0.f;
#pragma unroll
                for (int ks = 0; ks < 4; ++ks) {
                    const bf16x8 kf = *(const LAS bf16x8*)(lds + cur + mt * 4096 + foff[ks]);
                    S = __builtin_amdgcn_mfma_f32_32x32x16_bf16(kf, qf[ks], S, 0, 0, 0);
                }
#pragma unroll
                for (int sp = 0; sp < 2; ++sp)
#pragma unroll
                    for (int mv = 0; mv < 4; ++mv) {
                        const bf16x8 vf = *(const LAS bf16x8*)(lds + vprev + mv * 4096 + foff[2 * (1 - mt) + sp]);
                        O[mv] = __builtin_amdgcn_mfma_f32_32x32x16_bf16(vf, pfp[sp], O[mv], 0, 0, 0);
                    }
                __builtin_amdgcn_sched_barrier(0);
#pragma unroll
                for (int s = 0; s < 2; ++s) {
                    unsigned w0[4];
#pragma unroll
                    for (int j = 0; j < 4; ++j) {
                        const float a0 = __builtin_amdgcn_exp2f(S[8 * s + 2 * j]), a1 = __builtin_amdgcn_exp2f(S[8 * s + 2 * j + 1]);
                        lsum += a0 + a1;
                        w0[j] = pg8::cvt_pk_bf16(a0, a1);
                    }
                    pfp[s] = __builtin_bit_cast(bf16x8, (v4u){w0[0], w0[1], w0[2], w0[3]});
                }
                vprev = cur + 8192;
                __builtin_amdgcn_sched_barrier(0);
            }
            { const int tl = w * 64 + fresh_lane();
                *(LAS v4u*)(lds + nxt + tl * 16) = sk; *(LAS v4u*)(lds + nxt + 8192 + tl * 16) = sv0; *(LAS v4u*)(lds + nxt + 16384 + tl * 16) = sv1; }
            __syncthreads();
            cur = nxt;
        }
#pragma unroll
        for (int sp = 0; sp < 2; ++sp)
#pragma unroll
            for (int mv = 0; mv < 4; ++mv) {
                const bf16x8 vf = *(const LAS bf16x8*)(lds + vprev + mv * 4096 + foff[2 + sp]);
                O[mv] = __builtin_amdgcn_mfma_f32_32x32x16_bf16(vf, pfp[sp], O[mv], 0, 0, 0);
            }
        lsum += __shfl_xor(lsum, 32);
        const float inv = 1.0f / lsum;
        const int ln = fresh_lane(), l31 = ln & 31, hh = ln >> 5;
        float* park = (float*)(F.ws + WS_PARK) + ((size_t)F.bid * NWAVES + w) * 4096 + ln * 4;
        if (c == 0) {
#pragma unroll
            for (int mv = 0; mv < 4; ++mv)
#pragma unroll
                for (int g = 0; g < 4; ++g) *(f32x4*)(park + (mv * 4 + g) * 256) = (f32x4){O[mv][4 * g] * inv, O[mv][4 * g + 1] * inv, O[mv][4 * g + 2] * inv, O[mv][4 * g + 3] * inv};
        } else {
            const float lam = ((const float*)(F.ws + WS_SMALL))[SM_LAM / 4 + l];
            const float post = 1.0f - (0.8f - 0.6f * expf(-0.3f * (float)l));
            const float* onorm = A.in[I_DON] + l * 128;
            float ssq = 0.f;
#pragma unroll
            for (int mv = 0; mv < 4; ++mv)
#pragma unroll
                for (int g = 0; g < 4; ++g) { const f32x4 o0 = *(const f32x4*)(park + (mv * 4 + g) * 256);
#pragma unroll
                    for (int j = 0; j < 4; ++j) { const float o = o0[j] - lam * O[mv][4 * g + j] * inv; O[mv][4 * g + j] = o; ssq += o * o; } }
            ssq += __shfl_xor(ssq, 32);
            const float rs = post / sqrtf(ssq * (1.f / 128.f) + NEPS);
            bf16* orow = (bf16*)(F.ws + WS_MIX) + 1536 + h * 128 + (size_t)(qrow0 + 32 * w + l31) * 2048;
#pragma unroll
            for (int mv = 0; mv < 4; ++mv)
#pragma unroll
                for (int g = 0; g < 4; ++g) { const int dv = 32 * mv + 8 * g + 4 * hh; const f32x4 gn = *(const f32x4*)(onorm + dv);
                    uint2 o; o.x = pk2(O[mv][4 * g] * rs * gn.x, O[mv][4 * g + 1] * rs * gn.y); o.y = pk2(O[mv][4 * g + 2] * rs * gn.z, O[mv][4 * g + 3] * rs * gn.w);
                    *(uint2*)(orow + dv) = o; }
        }
    }
}

#ifndef MIX_ONLY
#define MIX_ONLY 0
#endif
__device__ __forceinline__ void ph_mix(const Frame& F0, const ArgView& A, int l) {
    Frame F = F0;
#ifdef SEQ_SCANS
    if (MIX_ONLY == 0 || MIX_ONLY == 1) if (F.bid < 16) { if (F.wave == 0) gdn_seq_chain(F, F.bid & 7, F.bid >> 3); }
    if (MIX_ONLY == 0 || MIX_ONLY == 2) if (F.bid >= 16 && F.bid < 32) { const int b = F.bid - 16; if (F.wave == 0) gla_seq_chain(F, b & 3, (b >> 2) & 1, b >> 3); }
#endif
    if (MIX_ONLY == 0 || MIX_ONLY == 3) {
    { int l_; asm volatile("v_mbcnt_lo_u32_b32 %0, -1, 0\n\tv_mbcnt_hi_u32_b32 %0, -1, %0" : "=v"(l_)); F.lane = l_; F.tid = F.wave * 64 + l_; }
    const int ctxu = (l == 0 && F.bid >= F.G - 4) ? 256 + (F.G - 1 - F.bid) : -1;
    int u = F.bid < 256 ? F.bid : ctxu;
#pragma unroll 1
    while (u >= 0) {
        const bool lat = u < 256; const int h = lat ? (u & 7) >> 1 : u - 256, qb = (u >> 3) * 2 + (u & 1);
        attn_unit(F, A, l, h, lat ? NCTX + 256 * qb : 0, lat ? NTOK / 64 : NCTX / 64);
        if (lat) { u += F.G; if (u >= 256) u = ctxu; } else u = -1; }
    }
}

__device__ __forceinline__ void ph_post(const Frame& F, const ArgView& A, int l, int row_lo) {
    const int gw = F.bid * NWAVES + F.wave, NGW = F.G * NWAVES, lane = F.lane;
    const bf16* P = (const bf16*)(F.ws + WS_P); bf16* mix = (bf16*)(F.ws + WS_MIX);
    const float* OG = (const float*)(F.ws + WS_OGDN); const float* OL = (const float*)(F.ws + WS_OGLA);
    const float* gon = A.in[I_GONORM] + l * 64 + 8 * (lane & 7); const float* lon = A.in[I_LONORM] + l * 128 + 8 * (lane & 15);
    for (int r = row_lo + gw; r < NTOK; r += NGW) {
        { const float* a = OG + (size_t)r * 512 + 8 * lane; const float* b = a + (size_t)NTOK * 512; float o[8], g[8];
          const f32x4 a0 = *(const f32x4*)a, a1 = *(const f32x4*)(a + 4), b0 = *(const f32x4*)b, b1 = *(const f32x4*)(b + 4);
          o[0] = a0.x + b0.x; o[1] = a0.y + b0.y; o[2] = a0.z + b0.z; o[3] = a0.w + b0.w; o[4] = a1.x + b1.x; o[5] = a1.y + b1.y; o[6] = a1.z + b1.z; o[7] = a1.w + b1.w;
          float ss = 0.f;
#pragma unroll
          for (int j = 0; j < 8; ++j) ss += o[j] * o[j];
          ss += __shfl_xor(ss, 1); ss += __shfl_xor(ss, 2); ss += __shfl_xor(ss, 4);
          const float rs = 1.0f / sqrtf(ss * (1.f / 64.f) + NEPS);
          load8(P + (size_t)r * PWP + C_GGATE + 8 * lane, g);
#pragma unroll
          for (int j = 0; j < 8; ++j) o[j] = o[j] * rs * gon[j] * siluf(g[j]);
          *(v4u*)(mix + (size_t)r * 2048 + 8 * lane) = pack8(o); }
        { const float* a = OL + (size_t)r * 512 + 8 * lane; const float* b = a + (size_t)NTOK * 512; float o[8], g[8];
          const f32x4 a0 = *(const f32x4*)a, a1 = *(const f32x4*)(a + 4), b0 = *(const f32x4*)b, b1 = *(const f32x4*)(b + 4);
          o[0] = a0.x + b0.x; o[1] = a0.y + b0.y; o[2] = a0.z + b0.z; o[3] = a0.w + b0.w; o[4] = a1.x + b1.x; o[5] = a1.y + b1.y; o[6] = a1.z + b1.z; o[7] = a1.w + b1.w;
          float ss = 0.f;
#pragma unroll
          for (int j = 0; j < 8; ++j) ss += o[j] * o[j];
          ss += __shfl_xor(ss, 1); ss += __shfl_xor(ss, 2); ss += __shfl_xor(ss, 4); ss += __shfl_xor(ss, 8);
          const float rs = 1.0f / sqrtf(ss * (1.f / 128.f) + NEPS);
          load8(P + (size_t)r * PWP + C_LR + 8 * lane, g);
#pragma unroll
          for (int j = 0; j < 8; ++j) o[j] = o[j] * rs * lon[j] * siluf(g[j]);
          *(v4u*)(mix + (size_t)r * 2048 + 1024 + 8 * lane) = pack8(o); }
#ifdef MIX_KEEP
        { unsigned zu_ = 0u; asm volatile("" : "+v"(zu_));
#pragma unroll
          for (int gq = 0; gq < 4; ++gq) if (gq != MIX_KEEP) *(v4u*)(mix + (size_t)r * 2048 + gq * 512 + 8 * lane) = (v4u){zu_, zu_, zu_, zu_}; }
#endif
    }
}

__device__ __forceinline__ void ph_assign(const Frame& F, int l, int row_lo) {
    const int lane = F.lane, w = F.wave, e = F.bid;
    if (e >= NEXP) return;
    const unsigned* cnt = F.ctl + CW_CNT + 64 * l;
    const int* toke = (const int*)(F.ws + WS_TOKE); int* toks = (int*)(F.ws + WS_TOKS);
    LAS unsigned* wc = (LAS unsigned*)F.lds;
    const int n64 = (NTOK - row_lo) * 2 / 64, per = (n64 + NWAVES - 1) / NWAVES, b0 = w * per, b1 = (b0 + per < n64) ? b0 + per : n64;
    unsigned c = 0;
    for (int b = b0; b < b1; ++b) c += (unsigned)__popcll(__ballot(toke[row_lo * 2 + b * 64 + lane] == e));
    if (lane == 0) wc[w] = c;
    __syncthreads();
    unsigned pos = 0;
    for (int q = 0; q < e; ++q) pos += (__hip_atomic_load(cnt + q, __ATOMIC_RELAXED, __HIP_MEMORY_SCOPE_AGENT) + 255u) & ~255u;
    for (int q = 0; q < w; ++q) pos += wc[q];
    for (int b = b0; b < b1; ++b) { const int idx = row_lo * 2 + b * 64 + lane; const bool m = toke[idx] == e;
        const unsigned long long mask = __ballot(m);
        if (m) toks[idx] = (int)(pos + (unsigned)__popcll(mask & ((1ull << lane) - 1ull)));
        pos += (unsigned)__popcll(mask); }
}
__device__ __forceinline__ void ph_route(const Frame& F, int l, int row_lo) {
    const int gw = F.bid * NWAVES + F.wave, NGW = F.G * NWAVES, lane = F.lane;
    const int* toks = (const int*)(F.ws + WS_TOKS);
    const bf16* hb = (const bf16*)(F.ws + WS_HBUF); bf16* am = (bf16*)(F.ws + WS_AMOE);
    for (int t = row_lo + gw; t < NTOK; t += NGW) {
        const int s0 = toks[t * 2], s1 = toks[t * 2 + 1];
        const v4u* src = (const v4u*)(hb + (size_t)t * 2048); v4u* d0 = (v4u*)(am + (size_t)s0 * 2048); v4u* d1 = (v4u*)(am + (size_t)s1 * 2048);
#pragma unroll
        for (int j = 0; j < 4; ++j) { const v4u v = src[lane + 64 * j]; d0[lane + 64 * j] = v; d1[lane + 64 * j] = v; }
    }
}
__device__ __forceinline__ void build_tile_table(const Frame& F, int l) {
    LAS int* tab = (LAS int*)(F.lds + TILE_TAB_OFF);
    if (F.tid == 0) { const unsigned* cnt = F.ctl + CW_CNT + 64 * l; int nt = 0;
        for (int e = 0; e < NEXP; ++e) { const int k = (int)((__hip_atomic_load(cnt + e, __ATOMIC_RELAXED, __HIP_MEMORY_SCOPE_AGENT) + 255u) >> 8); for (int j = 0; j < k && nt < MAXSLOT / 256; ++j) tab[1 + nt++] = e; }
        tab[0] = nt; }
    __syncthreads();
}
struct GroupedOrder {
    const LAS int* tab; int nN, G, c, nunits; size_t a_tstep, b_estride, b_tstep;
    __device__ void init(const LAS int* tab_, int nN_, int K, int nrows_per_expert, int G_, int c_) { tab = tab_; nN = nN_; G = G_; c = c_; nunits = tab_[0] * nN_;
        a_tstep = (size_t)256 * K * 2; b_tstep = a_tstep; b_estride = (size_t)nrows_per_expert * K * 2; }
    __device__ bool next(int i, pg8::Unit& u) const {
        const int L = i * G + c; if (L >= nunits) return false;
        const int tile = L / nN; u.pm = tile; u.pn = L % nN; const int e = tab[1 + tile];
        u.aoff = (size_t)tile * a_tstep; u.boff = (size_t)e * b_estride + (size_t)u.pn * b_tstep; return true; }
    __device__ __forceinline__ void a_ready(const pg8::Unit&) const {}
    __device__ __forceinline__ void done(const pg8::Unit&) const {}
};
template <class Base> struct OneUnit {
    const Base& B; int i0;
    __device__ bool next(int i, pg8::Unit& u) const { return i == 0 ? B.next(i0, u) : false; }
    __device__ __forceinline__ void a_ready(const pg8::Unit&) const {}
    __device__ __forceinline__ void done(const pg8::Unit&) const {}
};
__device__ __forceinline__ void ph_combine(const Frame& F, int l, int row_lo) {
    const int gw = F.bid * NWAVES + F.wave, NGW = F.G * NWAVES, lane = F.lane;
    const int* toks = (const int*)(F.ws + WS_TOKS); const float* tokw = (const float*)(F.ws + WS_TOKW);
    const bf16* Y = (const bf16*)(F.ws + WS_YMOE);
    for (int t = row_lo + gw; t < NTOK; t += NGW) {
        const bool isctx = t < NCTX;
        float* dst = isctx ? (float*)(F.ws + WS_XCTX) + (size_t)t * 2048 : F.out + (size_t)(t - NCTX) * 2048;
        const float* gate = modv_ptr(F, l, isctx ? 1 : 0) + 5 * 2048;
        const int s0 = toks[t * 2], s1 = toks[t * 2 + 1]; const float w0 = tokw[t * 2], w1 = tokw[t * 2 + 1];
#pragma unroll
        for (int j = 0; j < 4; ++j) { const int c = 8 * (lane + 64 * j); float a[8], b[8];
#ifdef TEST_H
            if (j > 0) continue;
            load8((const bf16*)(F.ws + WS_HMOE) + (size_t)s0 * 512 + c, a); load8((const bf16*)(F.ws + WS_HMOE) + (size_t)s1 * 512 + c, b);
#else
            load8(Y + (size_t)s0 * 2048 + c, a); load8(Y + (size_t)s1 * 2048 + c, b);
#endif
            f32x4 d0 = *(f32x4*)(dst + c), d1 = *(f32x4*)(dst + c + 4); const f32x4 g0 = *(const f32x4*)(gate + c), g1 = *(const f32x4*)(gate + c + 4);
            d0.x += g0.x * (w0 * a[0] + w1 * b[0]); d0.y += g0.y * (w0 * a[1] + w1 * b[1]); d0.z += g0.z * (w0 * a[2] + w1 * b[2]); d0.w += g0.w * (w0 * a[3] + w1 * b[3]);
            d1.x += g1.x * (w0 * a[4] + w1 * b[4]); d1.y += g1.y * (w0 * a[5] + w1 * b[5]); d1.z += g1.z * (w0 * a[6] + w1 * b[6]); d1.w += g1.w * (w0 * a[7] + w1 * b[7]);
            *(f32x4*)(dst + c) = d0; *(f32x4*)(dst + c + 4) = d1; }
    }
}

template <class Sched>
__device__ __forceinline__ void sgemm_bf16out(const Frame& F, const bf16* A, const bf16* Bt, int K, const Sched& S, bf16* O, int ldc) {
    const int lane = F.lane, w = F.wave, tid = F.tid, l31 = lane & 31, hh = lane >> 5, wm = w >> 2, wn = w & 3;
    LAS unsigned char* lds = F.lds;
    const int nt = K / 64;
    int foff[4];
#pragma unroll
    for (int ks = 0; ks < 4; ++ks) foff[ks] = l31 * 128 + (((2 * ks + hh) ^ att_swz(l31)) << 4);
    pg8::Unit u;
#pragma unroll 1
    for (int ui = 0; S.next(ui, u); ++ui) {
        const bf16* Au = (const bf16*)((const char*)A + u.aoff); const bf16* Bu = (const bf16*)((const char*)Bt + u.boff);
        f32x16 acc[4][2];
        float zf_ = 0.f; asm volatile("" : "+v"(zf_));
#pragma unroll
        for (int a = 0; a < 4; ++a)
#pragma unroll
            for (int b = 0; b < 2; ++b)
#pragma unroll
                for (int i = 0; i < 16; ++i) acc[a][b][i] = zf_;
        __syncthreads();
#pragma unroll
        for (int i = 0; i < 4; ++i) { const int id = tid + 512 * i, row = id >> 3, lg = (id & 7) ^ (row & 7); const unsigned so = (unsigned)(row * K + 8 * lg);
            __builtin_amdgcn_global_load_lds((const unsigned*)(Au + so), (LAS unsigned*)(lds + (w * 64 + 512 * i) * 16), 16, 0, 0);
            __builtin_amdgcn_global_load_lds((const unsigned*)(Bu + so), (LAS unsigned*)(lds + 32768 + (w * 64 + 512 * i) * 16), 16, 0, 0); }
        VM_WAIT(); __syncthreads();
#pragma unroll 1
        for (int t = 0; t < nt; ++t) {
            const int cur = (t & 1) * 65536, nxt = 65536 - cur;
            if (t + 1 < nt) { int tl = tid; asm volatile("" : "+v"(tl));
#pragma unroll
                for (int i = 0; i < 4; ++i) { const int id = tl + 512 * i, row = id >> 3, lg = (id & 7) ^ (row & 7); const unsigned so = (unsigned)(row * K + 8 * lg + 64 * (t + 1));
                    __builtin_amdgcn_global_load_lds((const unsigned*)(Au + so), (LAS unsigned*)(lds + nxt + (w * 64 + 512 * i) * 16), 16, 0, 0);
                    __builtin_amdgcn_global_load_lds((const unsigned*)(Bu + so), (LAS unsigned*)(lds + nxt + 32768 + (w * 64 + 512 * i) * 16), 16, 0, 0); } }
#pragma unroll
            for (int ks = 0; ks < 4; ++ks) {
                bf16x8 af[4], bfr[2];
#pragma unroll
                for (int a = 0; a < 4; ++a) af[a] = *(const LAS bf16x8*)(lds + cur + (wm * 128 + a * 32) * 128 + foff[ks]);
#pragma unroll
                for (int b = 0; b < 2; ++b) bfr[b] = *(const LAS bf16x8*)(lds + cur + 32768 + (wn * 64 + b * 32) * 128 + foff[ks]);
#pragma unroll
                for (int a = 0; a < 4; ++a)
#pragma unroll
                    for (int b = 0; b < 2; ++b) acc[a][b] = __builtin_amdgcn_mfma_f32_32x32x16_bf16(bfr[b], af[a], acc[a][b], 0, 0, 0);
            }
            VM_WAIT(); __syncthreads();
        }
#pragma unroll
        for (int a = 0; a < 4; ++a) { bf16* orow = O + (size_t)(u.pm * 256 + wm * 128 + a * 32 + l31) * ldc + u.pn * 256 + wn * 64;
#pragma unroll
            for (int b = 0; b < 2; ++b)
#pragma unroll
                for (int g = 0; g < 4; ++g) { uint2 o; o.x = pg8::cvt_pk_bf16(acc[a][b][4 * g], acc[a][b][4 * g + 1]); o.y = pg8::cvt_pk_bf16(acc[a][b][4 * g + 2], acc[a][b][4 * g + 3]);
                    *(uint2*)(orow + 32 * b + 8 * g + 4 * hh) = o; } }
    }
}

constexpr int CH = 64, NCHUNK = NTOK / CH, NCTXCH = NCTX / CH;
constexpr int LS = 65;
constexpr int LS2 = 129;
template <class FA, class FB> __device__ __forceinline__ f32x16 mm32(FA a, FB b, int K, int l31, int hh) {
    f32x16 acc;
#pragma unroll
    for (int i = 0; i < 16; ++i) acc[i] = 0.f;
#pragma unroll 8
    for (int k = 0; k < K; k += 2) acc = __builtin_amdgcn_mfma_f32_32x32x2f32(a(l31, k + hh), b(k + hh, l31), acc, 0, 0, 0);
    return acc;
}
template <class FA, class FB> __device__ __forceinline__ f32x16 mm32b(FA a, FB b, int K, int l31, int hh) {
    f32x16 acc;
#pragma unroll
    for (int i = 0; i < 16; ++i) acc[i] = 0.f;
#pragma unroll 2
    for (int k = 0; k < K; k += 16) { const int k0 = k + 8 * hh;
        v4u af, bf;
#pragma unroll
        for (int j = 0; j < 4; ++j) { af[j] = pg8::cvt_pk_bf16(a(l31, k0 + 2 * j), a(l31, k0 + 2 * j + 1)); bf[j] = pg8::cvt_pk_bf16(b(k0 + 2 * j, l31), b(k0 + 2 * j + 1, l31)); }
        acc = __builtin_amdgcn_mfma_f32_32x32x16_bf16(__builtin_bit_cast(bf16x8, af), __builtin_bit_cast(bf16x8, bf), acc, 0, 0, 0); }
    return acc;
}
#ifndef MM32
#define MM32 mm32b
#endif
#define GBF(i, j) ((((j) >> 4) * 4 + ((i) >> 4)) * 256 + ((((i) & 15) >> 2) * 16 + ((j) & 15)) * 4 + ((i) & 3))
#define KPERM(j) (16 * (2 * ((j) >> 5) + (((j) >> 3) & 1)) + 8 * (((j) >> 2) & 1) + 4 * (((j) >> 4) & 1) + ((j) & 3))
#define ACC_ROW(r, hh) (((r) & 3) + 8 * ((r) >> 2) + 4 * (hh))

__device__ __forceinline__ size_t gdn_slot(int d, int h, int n) { return ((size_t)(d * 8 + h) * NCHUNK + n) * 4096; }
__device__ __forceinline__ void ph_gdn_a(const Frame& F, int l, bool skip_solve = false) {
    const float* GQ = (const float*)(F.ws + WS_GQ); const float* GK = (const float*)(F.ws + WS_GK); const float* GV = (const float*)(F.ws + WS_GV);
    const float* GBETA = (const float*)(F.ws + WS_GBETA); const float* GDEC = (const float*)(F.ws + WS_GDEC);
    float* GB = (float*)(F.ws + WS_GB); bf16* GQP = (bf16*)(F.ws + WS_GQP); bf16* GOP = (bf16*)(F.ws + WS_GOP);
    LAS float* Qs = (LAS float*)F.lds; LAS float* Ks = Qs + 64 * LS; LAS float* Vs = Ks + 64 * LS; LAS float* As = Vs + 64 * LS; LAS float* Us = As + 64 * LS; LAS float* Ws = Us + 64 * LS;
    LAS float* Lt = Ws + 64 * LS;
    LAS float* Gv0 = Lt + 64 * 68;
    LAS float* misc = Gv0 + 512;
    LAS float* Dinv = misc + 16;
    const int tid = F.tid, lane = F.lane, w = F.wave, l31 = lane & 31, hh = lane >> 5;
#pragma unroll 1
    for (int unit = F.bid; unit < NCHUNK * 8; unit += F.G) {
        const int n = unit >> 3, h = unit & 7, r0 = n * CH;
        __syncthreads();
        {
            float tq[8], tk[8], tv[8];
#pragma unroll
            for (int q = 0; q < 8; ++q) { const int e = tid + NTHR * q, i = e >> 6, c = e & 63; const size_t g = (size_t)(r0 + i) * 512 + h * 64 + c; tq[q] = GQ[g]; tk[q] = GK[g]; tv[q] = GV[g]; }
#pragma unroll
            for (int q = 0; q < 8; ++q) { const int e = tid + NTHR * q, i = e >> 6, c = e & 63; Qs[i * LS + c] = tq[q] * 0.125f; Ks[i * LS + c] = tk[q]; Vs[i * LS + c] = tv[q]; } }
        if (w < 2) {
            const int d = w; LAS float* Gv = Gv0 + 256 * d;
            const int i = d ? 63 - lane : lane; float g = GDEC[(size_t)(r0 + i) * 16 + d * 8 + h];
#pragma unroll
            for (int o = 1; o < 64; o <<= 1) { const float t = __shfl_up(g, o); if (lane >= o) g += t; }
            const float gl = __shfl(g, 63);
            Gv[i] = g; Gv[64 + i] = __expf(g); Gv[128 + i] = __expf(gl - g); Gv[192 + i] = GBETA[(size_t)(r0 + i) * 16 + d * 8 + h];
            if (lane == 0) misc[d] = __expf(gl);
        }
#pragma unroll 1
        for (int d = 0; d < 2; ++d) {
            LAS float* Gv = Gv0 + 256 * d; LAS float* EGv = Gv + 64; LAS float* Fv = Gv + 128; LAS float* Bv = Gv + 192;
            __syncthreads();
            {
                const int t = w & 3, ti = t >> 1, tj = t & 1; const bool isq = w >= 4; LAS float* X = isq ? Qs : Ks;
                const f32x16 acc = MM32([&](int i, int k) { return X[(32 * ti + i) * LS + k]; }, [&](int k, int j) { return Ks[(32 * tj + j) * LS + k]; }, 64, l31, hh);
                const int j = 32 * tj + l31; const float gj = Gv[j];
#pragma unroll
                for (int r = 0; r < 16; ++r) { const int i = 32 * ti + ACC_ROW(r, hh); const float gi = Gv[i];
                    const bool before = d ? (j > i) : (j < i); const float dec = (before || i == j) ? __expf(gi - gj) : 0.f;
                    if (isq) As[i * LS + j] = acc[r] * dec;
                    else { const int is = d ? 63 - i : i, js = d ? 63 - j : j; Lt[is * 68 + js] = before ? Bv[i] * acc[r] * dec : 0.f; } }
            }
            __syncthreads();
            if (tid < 64 && !skip_solve) {
                const int I = tid >> 4, c = tid & 15; LAS float* Lb = Lt + (16 * I) * 68 + 16 * I; asm volatile("" : "+v"(Lb));
                float y[16];
#pragma unroll
                for (int i = 0; i < 16; ++i) { float v = (i == c) ? 1.0f : 0.0f;
#pragma unroll
                    for (int j4 = 0; j4 < (i + 3) / 4; ++j4) { const f32x4 lv = *(const LAS f32x4*)(Lb + i * 68 + 4 * j4);
                        if (4 * j4 + 0 < i) v -= lv[0] * y[4 * j4 + 0]; if (4 * j4 + 1 < i) v -= lv[1] * y[4 * j4 + 1];
                        if (4 * j4 + 2 < i) v -= lv[2] * y[4 * j4 + 2]; if (4 * j4 + 3 < i) v -= lv[3] * y[4 * j4 + 3]; }
                    y[i] = v; Dinv[(I * 16 + i) * 20 + c] = v; }
            }
            __syncthreads();
            if (!skip_solve) {
                const int li = lane & 15, g = lane >> 4, c = 16 * (w & 3) + li; const bool isw = w >= 4;
                LAS float* R = isw ? Ks : Vs; LAS float* X = isw ? Ws : Us;
                f32x4 Xb[4];
#pragma unroll
                for (int I = 0; I < 4; ++I) {
                    f32x4 z;
#pragma unroll
                    for (int r = 0; r < 4; ++r) { const int is = 16 * I + 4 * g + r, i = d ? 63 - is : is; z[r] = Bv[i] * R[i * LS + c] * (isw ? EGv[i] : 1.0f); }
#pragma unroll
                    for (int J = 0; J < I; ++J) { const f32x4 lf = *(const LAS f32x4*)(Lt + (16 * I + li) * 68 + 16 * J + 4 * g);
#pragma unroll
                        for (int r = 0; r < 4; ++r) z = __builtin_amdgcn_mfma_f32_16x16x4f32(-lf[r], Xb[J][r], z, 0, 0, 0); }
                    const f32x4 df = *(const LAS f32x4*)(Dinv + (I * 16 + li) * 20 + 4 * g);
                    f32x4 xi = (f32x4){0.f, 0.f, 0.f, 0.f};
#pragma unroll
                    for (int r = 0; r < 4; ++r) xi = __builtin_amdgcn_mfma_f32_16x16x4f32(df[r], z[r], xi, 0, 0, 0);
                    Xb[I] = xi;
#pragma unroll
                    for (int r = 0; r < 4; ++r) { const int is = 16 * I + 4 * g + r, i = d ? 63 - is : is; X[i * LS + c] = xi[r]; }
                }
            }
            __syncthreads();
            {
                const int p = w >> 1; const float egl = misc[d];
                if (tid == 0) ((float*)(F.ws + WS_EGL))[gdn_slot(d, h, n) >> 12] = egl;
                 float* dstB = GB + gdn_slot(d, h, n); bf16* dstQ = GQP + gdn_slot(d, h, n); bf16* dstO = GOP + gdn_slot(d, h, n);
#pragma unroll 1
                for (int tt = 0; tt < 2; ++tt) { const int t = 2 * (w & 1) + tt, ti = t >> 1, tj = t & 1;
                    LAS float* Xr = (p == 0 || p == 2) ? Ws : Us;
                    f32x16 acc;
                    if (p < 2) acc = MM32([&](int i, int k) { return Ks[k * LS + 32 * ti + i] * Fv[k]; }, [&](int k, int j) { return Xr[k * LS + 32 * tj + j]; }, 64, l31, hh);
                    else       acc = MM32([&](int i, int k) { return As[(32 * ti + i) * LS + k]; }, [&](int k, int j) { return Xr[k * LS + 32 * tj + j]; }, 64, l31, hh);
                    const int j = 32 * tj + l31;
#pragma unroll
                    for (int r = 0; r < 16; ++r) { const int i = 32 * ti + ACC_ROW(r, hh);
                        if (p == 0) Lt[i * 68 + j] = -acc[r];
                        else if (p == 1) dstB[GBF(i, j)] = acc[r];
                        else if (p == 2) dstQ[i * 64 + KPERM(j)] = (bf16)f2bf(Qs[i * LS + j] * EGv[i] - acc[r]);
                        else dstO[i * 64 + j] = (bf16)f2bf(acc[r]); } }
            }
            __syncthreads();
            {
                const int f = tid, mo = f >> 7, sx = (f >> 6) & 1, il = f & 15, gx = (f & 63) >> 4; float mv[8];
#pragma unroll
                for (int jj = 0; jj < 8; ++jj) mv[jj] = Lt[(16 * mo + il) * 68 + 32 * sx + 16 * (jj >> 2) + 4 * gx + (jj & 3)];
                *(v4u*)((bf16*)(F.ws + WS_GA) + gdn_slot(d, h, n) + f * 8) = pack8(mv);
            }
        }
    }
}

__device__ __forceinline__ size_t gla_slot(int d, int h, int n) { return (size_t)(d * 4 + h) * NCHUNK + n; }
__device__ __forceinline__ void ph_gla_a(const Frame& F, int l) {
    const bf16* P = (const bf16*)(F.ws + WS_P); const float* LOGA = (const float*)(F.ws + WS_LOGA);
    bf16* OL = (bf16*)(F.ws + WS_OL); float* DS = (float*)(F.ws + WS_DS); float* ACH = (float*)(F.ws + WS_ACH); bf16* GQB = (bf16*)(F.ws + WS_GQB);
    LAS float* Qi = (LAS float*)F.lds; LAS float* Ko = Qi + 64 * LS; LAS float* Vs = Ko + 64 * LS; LAS float* Bs = Vs + 64 * LS2; LAS float* At = Bs + 64 * LS;
    const int tid = F.tid, lane = F.lane, w = F.wave, l31 = lane & 31, hh = lane >> 5;
#pragma unroll 1
    for (int unit = F.G - 1 - F.bid; unit < NCHUNK * 8; unit += F.G) {
        const int n = unit >> 3, h = (unit >> 1) & 3, d = unit & 1, r0 = n * CH;
        __syncthreads();
        float tq[8], tk[8];
        {   float tb[8]; unsigned tv[8];
#pragma unroll
            for (int q = 0; q < 8; ++q) { const int e = tid + NTHR * q, i = e >> 6, c = e & 63; tb[q] = LOGA[(size_t)(r0 + i) * 512 + d * 256 + h * 64 + c];
                tq[q] = bf2f(P[(size_t)(r0 + i) * PWP + C_LQ + h * 64 + c]) * 0.125f; tk[q] = bf2f(P[(size_t)(r0 + i) * PWP + C_LK + h * 64 + c]);
                const int i2 = e >> 6, c2 = (e & 63) * 2; tv[q] = *(const unsigned*)(P + (size_t)(r0 + i2) * PWP + C_LV + h * 128 + c2); }
#pragma unroll
            for (int q = 0; q < 8; ++q) { const int e = tid + NTHR * q, i = e >> 6, c = e & 63; Bs[i * LS + c] = tb[q];
                Vs[i * LS2 + 2 * c] = __builtin_bit_cast(float, tv[q] << 16); Vs[i * LS2 + 2 * c + 1] = __builtin_bit_cast(float, tv[q] & 0xffff0000u); } }
        __syncthreads();
        if (tid < 64) {
            float s = 0.f;
#pragma unroll 8
            for (int is = 0; is < 64; ++is) { const int i = d ? 63 - is : is; s += Bs[i * LS + tid]; Bs[i * LS + tid] = s; }
            ACH[gla_slot(d, h, n) * 64 + tid] = __expf(s);
        }
        __syncthreads();
#pragma unroll
        for (int qq = 0; qq < 8; ++qq) { const int e = tid + NTHR * qq, i = e >> 6, c = e & 63; const int il = d ? 0 : 63;
            const float b = Bs[i * LS + c], bl = Bs[il * LS + c];
            const float q = tq[qq], k = tk[qq];
            Qi[i * LS + c] = q * __expf(b - bl); Ko[i * LS + c] = k * __expf(bl - b);
            GQB[(gla_slot(d, h, n) * 64 + i) * 64 + c] = (bf16)f2bf(q * __expf(b)); }
        __syncthreads();
        if (w < 4) {
            const int ti = w >> 1, tj = w & 1;
            const f32x16 acc = MM32([&](int i, int k) { return Qi[(32 * ti + i) * LS + k]; }, [&](int k, int j) { return Ko[(32 * tj + j) * LS + k]; }, 64, l31, hh);
            const int j = 32 * tj + l31;
#pragma unroll
            for (int r = 0; r < 16; ++r) { const int i = 32 * ti + ACC_ROW(r, hh); const bool ok = d ? (j >= i) : (j <= i); At[i * LS + j] = ok ? acc[r] : 0.f; }
        }
        __syncthreads();
        {
            const int ti = w >> 2, tj = w & 3;
            { const f32x16 acc = MM32([&](int i, int k) { return At[(32 * ti + i) * LS + k]; }, [&](int k, int j) { return Vs[k * LS2 + 32 * tj + j]; }, 64, l31, hh);
              bf16* dst = OL + (size_t)d * NTOK * 512;
#pragma unroll
              for (int r = 0; r < 16; ++r) { const int i = 32 * ti + ACC_ROW(r, hh); dst[(size_t)(r0 + i) * 512 + h * 128 + 32 * tj + l31] = (bf16)f2bf(acc[r]); } }
            { const f32x16 acc = MM32([&](int i, int k) { return Ko[k * LS + 32 * ti + i]; }, [&](int k, int j) { return Vs[k * LS2 + 32 * tj + j]; }, 64, l31, hh);
              float* dst = DS + gla_slot(d, h, n) * 8192;
#pragma unroll
              for (int r = 0; r < 16; ++r) { const int i = 32 * ti + ACC_ROW(r, hh); dst[i * 128 + 32 * tj + l31] = acc[r]; } }
        }
    }
}

__device__ __forceinline__ int chain_chunk(int d, int step) { const int rev = (step < NCTXCH ? NCTXCH - 1 : NCHUNK + NCTXCH - 1) - step; return d ? rev : step; }
typedef unsigned v2u __attribute__((ext_vector_type(2)));
__device__ __forceinline__ void gla_scan(const Frame& F, int gtid) {
    const float* DS = (const float*)(F.ws + WS_DS); const float* ACH = (const float*)(F.ws + WS_ACH); v2u* GLS = (v2u*)(F.ws + WS_GLS);
    const int dh = gtid >> 11, e4 = gtid & 2047, kq = e4 >> 7, dv = e4 & 127, d = dh >> 2;
    float s[4] = {0.f, 0.f, 0.f, 0.f};
#pragma unroll 1
    for (int s0 = 0; s0 < NCHUNK; s0 += 13) {
        float x[13][4]; f32x4 a[13];
#pragma unroll
        for (int q = 0; q < 13; ++q) { const size_t slot = (size_t)(dh * NCHUNK + chain_chunk(d, s0 + q));
#pragma unroll
            for (int r = 0; r < 4; ++r) x[q][r] = DS[slot * 8192 + (4 * kq + r) * 128 + dv];
            a[q] = *(const f32x4*)(ACH + slot * 64 + 4 * kq); }
#pragma unroll
        for (int q = 0; q < 13; ++q) { const size_t slot = (size_t)(dh * NCHUNK + chain_chunk(d, s0 + q));
            v2u o; o[0] = pg8::cvt_pk_bf16(s[0], s[1]); o[1] = pg8::cvt_pk_bf16(s[2], s[3]); GLS[slot * 2048 + kq * 128 + dv] = o;
#pragma unroll
            for (int r = 0; r < 4; ++r) s[r] = a[q][r] * s[r] + x[q][r]; }
    }
}
constexpr int SCB = 4;
__device__ __forceinline__ void gdn_scan(const Frame& F) {
    const bf16* GM = (const bf16*)(F.ws + WS_GA); const float* GB = (const float*)(F.ws + WS_GB); bf16* GST = (bf16*)(F.ws + WS_GST); const float* EGL = (const float*)(F.ws + WS_EGL);
    const int lane = F.lane, w = F.wave, tid = F.tid, ci = w >> 2, slice = w & 3, chain = 2 * F.bid + ci, d = chain >> 3;
    LAS unsigned char* lds = F.lds;
    f32x4 S[4];
#pragma unroll
    for (int m = 0; m < 4; ++m) S[m] = (f32x4){0.f, 0.f, 0.f, 0.f};
    v4u R[8]; f32x4 Bn[SCB][4], Bc[SCB][4]; float en[SCB], ec[SCB];
#define SC_ISSUE(batch) do { const int b_ = (batch) < NCHUNK / SCB ? (batch) : NCHUNK / SCB - 1; \
        _Pragma("unroll") for (int i_ = 0; i_ < 8; ++i_) { const int q_ = tid + NTHR * i_, cq_ = q_ >> 11, jq_ = (q_ >> 9) & 3, r_ = q_ & 511; \
            const int ch_ = 2 * F.bid + cq_; const size_t slot_ = (size_t)ch_ * NCHUNK + chain_chunk(ch_ >> 3, b_ * SCB + jq_); \
            R[i_] = *(const v4u*)(GM + slot_ * 4096 + r_ * 8); } \
        _Pragma("unroll") for (int j_ = 0; j_ < SCB; ++j_) { const size_t slot_ = (size_t)chain * NCHUNK + chain_chunk(d, b_ * SCB + j_); en[j_] = EGL[slot_]; \
            _Pragma("unroll") for (int m_ = 0; m_ < 4; ++m_) Bn[j_][m_] = *(const f32x4*)(GB + slot_ * 4096 + ((slice * 4 + m_) * 64 + lane) * 4); } } while (0)
#define SC_COMMIT() do { _Pragma("unroll") for (int i_ = 0; i_ < 8; ++i_) { const int q_ = tid + NTHR * i_; *(LAS v4u*)(lds + q_ * 16) = R[i_]; } \
        _Pragma("unroll") for (int j_ = 0; j_ < SCB; ++j_) { ec[j_] = en[j_]; _Pragma("unroll") for (int m_ = 0; m_ < 4; ++m_) Bc[j_][m_] = Bn[j_][m_]; } } while (0)
    __syncthreads();
    SC_ISSUE(0); SC_COMMIT();
    __syncthreads();
#pragma unroll 1
    for (int b = 0; b < NCHUNK / SCB; ++b) {
        SC_ISSUE(b + 1);
#pragma unroll
        for (int j = 0; j < SCB; ++j) {
            LAS unsigned char* base = lds + (ci * SCB + j) * 8192;
            v4u mf[8]; f32x4 acc[4];
#pragma unroll
            for (int q = 0; q < 8; ++q) mf[q] = *(const LAS v4u*)(base + (q * 64 + lane) * 16);
#pragma unroll
            for (int m = 0; m < 4; ++m) acc[m] = S[m] * ec[j] + Bc[j][m];
            v4u sb[2];
#pragma unroll
            for (int s2 = 0; s2 < 2; ++s2) { sb[s2][0] = pg8::cvt_pk_bf16(S[2 * s2][0], S[2 * s2][1]); sb[s2][1] = pg8::cvt_pk_bf16(S[2 * s2][2], S[2 * s2][3]);
                sb[s2][2] = pg8::cvt_pk_bf16(S[2 * s2 + 1][0], S[2 * s2 + 1][1]); sb[s2][3] = pg8::cvt_pk_bf16(S[2 * s2 + 1][2], S[2 * s2 + 1][3]); }
            const size_t slot = (size_t)chain * NCHUNK + chain_chunk(d, b * SCB + j);
#pragma unroll
            for (int s2 = 0; s2 < 2; ++s2) *(v4u*)(GST + slot * 4096 + ((slice * 2 + s2) * 64 + lane) * 8) = sb[s2];
#pragma unroll
            for (int s2 = 0; s2 < 2; ++s2)
#pragma unroll
                for (int mo = 0; mo < 4; ++mo) acc[mo] = __builtin_amdgcn_mfma_f32_16x16x32_bf16(__builtin_bit_cast(bf16x8, mf[mo * 2 + s2]), __builtin_bit_cast(bf16x8, sb[s2]), acc[mo], 0, 0, 0);
#pragma unroll
            for (int m = 0; m < 4; ++m) S[m] = acc[m];
        }
        __syncthreads();
        SC_COMMIT();
        __syncthreads();
    }
#undef SC_ISSUE
#undef SC_COMMIT
}
__device__ __forceinline__ void ph_scan(const Frame& F) {
    if (F.bid < 8) gdn_scan(F);
    else if (F.bid < 40) gla_scan(F, (F.bid - 8) * NTHR + F.tid);
}

template <int NT>
__device__ __forceinline__ void final_unit(const Frame& F, const ArgView& A, int l, int n, int h, int ti) {
    const int lane = F.lane, l31 = lane & 31, hh = lane >> 5, r0 = n * CH;
    constexpr bool GDN = (NT == 2); constexpr int NV = 32 * NT;
    f32x16 acc[NT];
#pragma unroll
    for (int t = 0; t < NT; ++t)
#pragma unroll
        for (int i = 0; i < 16; ++i) acc[t][i] = 0.f;
#pragma unroll 1
    for (int d = 0; d < 2; ++d) {
        const bf16* Aq; const v2u* Gl = nullptr; const bf16* Gs = nullptr; const bf16* Ol; int ols;
        if (GDN) { Aq = (const bf16*)(F.ws + WS_GQP) + gdn_slot(d, h, n); Gs = (const bf16*)(F.ws + WS_GST) + gdn_slot(d, h, n); Ol = (const bf16*)(F.ws + WS_GOP) + gdn_slot(d, h, n); ols = 64; }
        else { Aq = (const bf16*)(F.ws + WS_GQB) + gla_slot(d, h, n) * 4096; Gl = (const v2u*)(F.ws + WS_GLS) + gla_slot(d, h, n) * 2048;
               Ol = (const bf16*)(F.ws + WS_OL) + (size_t)d * NTOK * 512 + (size_t)r0 * 512 + h * 128; ols = 512; }
#pragma unroll
        for (int t = 0; t < NT; ++t)
#pragma unroll
            for (int r = 0; r < 16; ++r) acc[t][r] += bf2f(Ol[(size_t)(32 * ti + ACC_ROW(r, hh)) * ols + 32 * t + l31]);
        v4u av[2], bv[2][NT];
#define FIN_LOAD(buf, s) do { av[buf] = *(const v4u*)(Aq + (32 * ti + l31) * 64 + 16 * (s) + 8 * hh); \
        _Pragma("unroll") for (int t_ = 0; t_ < NT; ++t_) { \
            if (GDN) bv[buf][t_] = *(const v4u*)(Gs + ((((2 * t_ + (l31 >> 4)) * 2 + ((s) >> 1)) * 64 + (2 * ((s) & 1) + hh) * 16 + (l31 & 15)) * 8)); \
            else { const v2u b0_ = Gl[(4 * (s) + 2 * hh) * 128 + 32 * t_ + l31], b1_ = Gl[(4 * (s) + 2 * hh + 1) * 128 + 32 * t_ + l31]; \
                   bv[buf][t_][0] = b0_[0]; bv[buf][t_][1] = b0_[1]; bv[buf][t_][2] = b1_[0]; bv[buf][t_][3] = b1_[1]; } } } while (0)
        FIN_LOAD(0, 0);
#pragma unroll
        for (int s = 0; s < 4; ++s) {
            if (s < 3) FIN_LOAD((s + 1) & 1, s + 1);
            const v4u af = av[s & 1];
#pragma unroll
            for (int t = 0; t < NT; ++t) {
                const v4u bf = bv[s & 1][t];
                acc[t] = __builtin_amdgcn_mfma_f32_32x32x16_bf16(__builtin_bit_cast(bf16x8, af), __builtin_bit_cast(bf16x8, bf), acc[t], 0, 0, 0); }
            __builtin_amdgcn_sched_barrier(0);
        }
#undef FIN_LOAD
    }
    const bf16* P = (const bf16*)(F.ws + WS_P); bf16* mix = (bf16*)(F.ws + WS_MIX);
    const float* gain = A.in[GDN ? I_GONORM : I_LONORM] + l * NV; const int gcol = (GDN ? C_GGATE + h * 64 : C_LR + h * 128), mcol = (GDN ? h * 64 : 1024 + h * 128);
    float gn[NT];
#pragma unroll
    for (int t = 0; t < NT; ++t) gn[t] = gain[32 * t + l31];
#pragma unroll
    for (int r = 0; r < 16; ++r) {
        float ss = 0.f;
#pragma unroll
        for (int t = 0; t < NT; ++t) ss += acc[t][r] * acc[t][r];
        ss += __shfl_xor(ss, 1); ss += __shfl_xor(ss, 2); ss += __shfl_xor(ss, 4); ss += __shfl_xor(ss, 8); ss += __shfl_xor(ss, 16);
        const float rs = 1.0f / sqrtf(ss * (1.f / NV) + NEPS);
        const size_t row = (size_t)(r0 + 32 * ti + ACC_ROW(r, hh));
#pragma unroll
        for (int t = 0; t < NT; ++t) { const float g = bf2f(P[row * PWP + gcol + 32 * t + l31]);
            mix[row * 2048 + mcol + 32 * t + l31] = (bf16)f2bf(acc[t][r] * rs * gn[t] * siluf(g)); }
    }
}
__device__ __forceinline__ void ph_final(const Frame& F, const ArgView& A, int l, int chunk_lo) {
    const int gw = F.bid * NWAVES + F.wave, NGW = F.G * NWAVES, nun = (NCHUNK - chunk_lo) * 24;
#pragma unroll 1
    for (int unit = gw; unit < nun; unit += NGW) { const int n = chunk_lo + unit / 24, u = unit % 24;
        if (u < 16) final_unit<2>(F, A, l, n, u >> 1, u & 1);
        else final_unit<4>(F, A, l, n, (u - 16) >> 1, u & 1); }
}

constexpr int PH_PER_LAYER = 15, N_PHASES = 1 + 2 * PH_PER_LAYER;
#ifndef MOEDN_ALIGN
#define MOEDN_ALIGN true
#endif
#ifndef MOEDN_SP2
#define MOEDN_SP2 true
#endif
#ifndef REPEAT_MODE
#define REPEAT_MODE 1
#endif
#ifndef MK_SINGLE
#define MK_SINGLE 0
#endif
template <int KIND> __global__ void __launch_bounds__(NTHR, 2) fwd(Args args) {
    extern __shared__ __attribute__((aligned(16))) unsigned char lds_raw[];
    Frame F; ArgView AV; AV.in.p = (CArgsP)__builtin_amdgcn_kernarg_segment_ptr();
    F.lds = (LAS unsigned char*)lds_raw; F.ws = args.ws; F.ctl = (unsigned*)(args.ws + WS_CTL); F.out = args.out;
    F.tid = threadIdx.x; F.lane = F.tid & 63; F.wave = __builtin_amdgcn_readfirstlane(F.tid >> 6); F.G = gridDim.x; F.bid = blockIdx.x;
    for (int u = F.tid; u < (LDS_BYTES - LDSCTL_OFF) / 4; u += NTHR) ((LAS unsigned*)(F.lds + LDSCTL_OFF))[u] = 0u;
    __syncthreads();
    const int lo = args.ph_lo, hi = args.ph_hi;
#ifdef ACQ_START
    __builtin_amdgcn_fence(__ATOMIC_ACQUIRE, "agent"); asm volatile("s_waitcnt vmcnt(0)" ::: "memory");
#endif
    XcdBarrier bar; bar.bar = F.ctl + CW_BAR; bar.x = 0; bar.st = nullptr;
    if (KIND < 0 || hi - lo > 1) bar = xcd_barrier_post(F.ctl + CW_BAR, (volatile LAS unsigned*)(F.lds + MISC_OFF) + 8);
#define EN(j) (KIND < 0 || (j) == KIND)
#define IN(k) (KIND < 0 || (lo <= (k) && (k) < hi))
#define SEAM(k) do { if (KIND < 0 ? ((k) + 1 < N_PHASES) : (IN(k) && IN((k) + 1))) xcd_barrier(bar); } while (0)
#define FRESH() do { int l_; asm volatile("v_mbcnt_lo_u32_b32 %0, -1, 0\n\tv_mbcnt_hi_u32_b32 %0, -1, %0" : "=v"(l_)); F.lane = l_; F.tid = F.wave * 64 + l_; { CArgsP ka_ = (CArgsP)__builtin_amdgcn_kernarg_segment_ptr(); asm volatile("" : "+s"(ka_)); AV.in.p = ka_; } { unsigned char* w_ = args.ws; asm volatile("" : "+s"(w_)); F.ws = w_; F.ctl = (unsigned*)w_; float* o_ = args.out; asm volatile("" : "+s"(o_)); F.out = o_; } } while (0)

    if (EN(100) && IN(0)) { FRESH(); ph_prologue(F, AV); }
    SEAM(0);
    { constexpr int l = 0;
    {
        const int b = 1 + PH_PER_LAYER * l;
#define XLAT (l == 0 ? AV.in[I_X] : (const float*)F.out)
#define XCTX (l == 0 ? AV.in[I_CTX] : (const float*)(F.ws + WS_XCTX))
        const int out_lo = l == 0 ? 0 : NCTX;
        if (EN(0) && IN(b + 0)) { FRESH(); ph_convert(F, AV, l); }
        SEAM(b + 0);
        if (EN(1) && IN(b + 1)) { FRESH(); ph_norm<0>(F, AV, l, XLAT, XCTX, 0); }
        SEAM(b + 1);
        if (EN(2) && IN(b + 2)) { FRESH();
            pg8::Gemm g{(const bf16*)(F.ws + WS_HBUF), (const bf16*)(F.ws + WS_WIN), NTOK, PWP, DM}; pg8::StaticOrder S; S.init(NTOK, PWP, DM, F.G, F.bid);
            pg8::EpiBf16 E{(bf16*)(F.ws + WS_P), PWP};
            pg8::gemm_phase<pg8::EpiBf16, pg8::StaticOrder, true, true>(F.lds, g, S, E, F.tid);
        }
        SEAM(b + 2);
        if (EN(3) && IN(b + 3)) { FRESH(); ph_prep(F, AV, l); }
        SEAM(b + 3);
        if (EN(4) && IN(b + 4)) { const int rp_ = KIND < 0 ? 0 : args.rep; FRESH(); if (rp_ != 4) ph_gdn_a(F, l, rp_ == 3); FRESH(); if (rp_ < 2 || rp_ == 4) ph_gla_a(F, l); }
        SEAM(b + 4);
        if (EN(5) && IN(b + 5)) { FRESH(); if (KIND < 0 || args.rep == 0) ph_scan(F); FRESH(); ph_mix(F, AV, l); }
        SEAM(b + 5);
        if (EN(6) && IN(b + 6)) { FRESH(); ph_final(F, AV, l, out_lo / CH); }
        SEAM(b + 6);
        if (EN(7) && IN(b + 7)) { FRESH();
            const int M = NTOK - out_lo;
            pg8::Gemm g{(const bf16*)(F.ws + WS_MIX) + (size_t)out_lo * DM, (const bf16*)(F.ws + WS_WOUT), M, DM, DM}; pg8::StaticOrder S; S.init(M, DM, DM, F.G, F.bid);
            pg8::EpiResid E{XLAT, F.out, XCTX, (float*)(F.ws + WS_XCTX), modv_ptr(F, l, 0) + 2 * DM, modv_ptr(F, l, 1) + 2 * DM, NCTX, out_lo};
            pg8::gemm_phase<pg8::EpiResid, pg8::StaticOrder, true, true>(F.lds, g, S, E, F.tid);
        }
        SEAM(b + 7);
        if (EN(8) && IN(b + 8)) { FRESH(); ph_norm<1>(F, AV, l, F.out, (const float*)(F.ws + WS_XCTX), out_lo);
#ifdef ZERO_MOE
            { unsigned zu_ = 0u; asm volatile("" : "+v"(zu_)); v4u* z = (v4u*)(F.ws + WS_AMOE); const size_t n = ((size_t)MAXSLOT * 2048 * 2 + (size_t)MAXSLOT * 512 * 2) / 16;
              for (size_t i = (size_t)F.bid * NTHR + F.tid; i < n; i += (size_t)F.G * NTHR) z[i] = (v4u){zu_, zu_, zu_, zu_}; }
#endif
        }
        SEAM(b + 8);
        if (EN(9) && IN(b + 9)) { FRESH();
            const int M = NTOK - out_lo;
            pg8::Gemm g{(const bf16*)(F.ws + WS_HBUF) + (size_t)out_lo * DM, (const bf16*)(F.ws + WS_WR), M, 256, DM}; pg8::StaticOrder S; S.init(M, 256, DM, F.G, F.bid);
            pg8::EpiRouter E{AV.in[I_RGB] + l * 4, AV.in[I_REB] + l * 32, (int*)(F.ws + WS_TOKE), (float*)(F.ws + WS_TOKW), F.ctl + CW_CNT + 64 * l, out_lo};
            pg8::gemm_phase<pg8::EpiRouter, pg8::StaticOrder, false, true>(F.lds, g, S, E, F.tid);
        }
        SEAM(b + 9);
        if (EN(10) && IN(b + 10)) { FRESH(); ph_assign(F, l, out_lo); }
        SEAM(b + 10);
        if (EN(11) && IN(b + 11)) { FRESH(); ph_route(F, l, out_lo); }
        SEAM(b + 11);
        if (EN(12) && IN(b + 12)) { FRESH();
            build_tile_table(F, l);
            const LAS int* tab = (const LAS int*)(F.lds + TILE_TAB_OFF);
            pg8::Gemm g{(const bf16*)(F.ws + WS_AMOE), (const bf16*)(F.ws + WS_WUP), MAXSLOT, 1024, DM}; GroupedOrder S; S.init(tab, 4, DM, 1024, F.G, F.bid);
            pg8::EpiSwiGLU E{(bf16*)(F.ws + WS_HMOE), 512};
            pg8::gemm_phase<pg8::EpiSwiGLU, GroupedOrder, true, true>(F.lds, g, S, E, F.tid);
        }
        SEAM(b + 12);
        if (EN(13) && IN(b + 13)) { FRESH();
            build_tile_table(F, l);
            const LAS int* tab = (const LAS int*)(F.lds + TILE_TAB_OFF);
#if defined(TEST_W2COPY)
            pg8::Gemm g{(const bf16*)(F.ws + WS_HMOE), (const bf16*)(F.ws + WS_PARK), MAXSLOT, DM, 512}; GroupedOrder S; S.init(tab, 8, 512, 0, F.G, F.bid);
#elif defined(TEST_K512D0)
            pg8::Gemm g{(const bf16*)(F.ws + WS_HMOE), (const bf16*)(F.ws + WS_WDN), MAXSLOT, DM, 512}; GroupedOrder S; S.init(tab, 8, 512, 0, F.G, F.bid);
#elif defined(TEST_K512W)
            pg8::Gemm g{(const bf16*)(F.ws + WS_HMOE), (const bf16*)(F.ws + WS_WOUT), MAXSLOT, DM, 512}; GroupedOrder S; S.init(tab, 8, 512, 0, F.G, F.bid);
#elif defined(TEST_K1024)
            pg8::Gemm g{(const bf16*)(F.ws + WS_AMOE), (const bf16*)(F.ws + WS_WDN), MAXSLOT, DM, 1024}; GroupedOrder S; S.init(tab, 4, 1024, 1024, F.G, F.bid);
#elif defined(TEST_K512A)
            pg8::Gemm g{(const bf16*)(F.ws + WS_AMOE), (const bf16*)(F.ws + WS_WDN), MAXSLOT, DM, 512}; GroupedOrder S; S.init(tab, 8, 512, DM, F.G, F.bid);
#elif defined(TEST_K2048)
            pg8::Gemm g{(const bf16*)(F.ws + WS_AMOE), (const bf16*)(F.ws + WS_WOUT), MAXSLOT, DM, DM}; GroupedOrder S; S.init(tab, 8, DM, 0, F.G, F.bid);
#else
            pg8::Gemm g{(const bf16*)(F.ws + WS_HMOE), (const bf16*)(F.ws + WS_WDN), MAXSLOT, DM, 512}; GroupedOrder S; S.init(tab, 8, 512, DM, F.G, F.bid);
#endif
            pg8::EpiBf16 E{(bf16*)(F.ws + WS_YMOE), DM};
#if defined(MOEDN_SGEMM)
            sgemm_bf16out(F, g.A, g.Bt, g.K, S, (bf16*)(F.ws + WS_YMOE), DM);
#elif defined(MOEDN_ONEUNIT)
#pragma unroll 1
            for (int i = 0; i * F.G + F.bid < S.nunits; ++i) { OneUnit<GroupedOrder> S1{S, i}; pg8::gemm_phase<pg8::EpiBf16, OneUnit<GroupedOrder>, false, true>(F.lds, g, S1, E, F.tid); }
#else
            pg8::gemm_phase<pg8::EpiBf16, GroupedOrder, MOEDN_ALIGN, MOEDN_SP2>(F.lds, g, S, E, F.tid);
#endif
        }
        SEAM(b + 13);
        if (EN(14) && IN(b + 14)) { FRESH(); ph_combine(F, l, out_lo); }
        SEAM(b + 14);
    }
    }
    { constexpr int l = 1;
    {
        const int b = 1 + PH_PER_LAYER * l;
#define XLAT (l == 0 ? AV.in[I_X] : (const float*)F.out)
#define XCTX (l == 0 ? AV.in[I_CTX] : (const float*)(F.ws + WS_XCTX))
        const int out_lo = l == 0 ? 0 : NCTX;
        if (EN(0) && IN(b + 0)) { FRESH(); ph_convert(F, AV, l); }
        SEAM(b + 0);
        if (EN(1) && IN(b + 1)) { FRESH(); ph_norm<0>(F, AV, l, XLAT, XCTX, 0); }
        SEAM(b + 1);
        if (EN(2) && IN(b + 2)) { FRESH();
            pg8::Gemm g{(const bf16*)(F.ws + WS_HBUF), (const bf16*)(F.ws + WS_WIN), NTOK, PWP, DM}; pg8::StaticOrder S; S.init(NTOK, PWP, DM, F.G, F.bid);
            pg8::EpiBf16 E{(bf16*)(F.ws + WS_P), PWP};
            pg8::gemm_phase<pg8::EpiBf16, pg8::StaticOrder, true, true>(F.lds, g, S, E, F.tid);
        }
        SEAM(b + 2);
        if (EN(3) && IN(b + 3)) { FRESH(); ph_prep(F, AV, l); }
        SEAM(b + 3);
        if (EN(4) && IN(b + 4)) { const int rp_ = KIND < 0 ? 0 : args.rep; FRESH(); if (rp_ != 4) ph_gdn_a(F, l, rp_ == 3); FRESH(); if (rp_ < 2 || rp_ == 4) ph_gla_a(F, l); }
        SEAM(b + 4);
        if (EN(5) && IN(b + 5)) { FRESH(); if (KIND < 0 || args.rep == 0) ph_scan(F); FRESH(); ph_mix(F, AV, l); }
        SEAM(b + 5);
        if (EN(6) && IN(b + 6)) { FRESH(); ph_final(F, AV, l, out_lo / CH); }
        SEAM(b + 6);
        if (EN(7) && IN(b + 7)) { FRESH();
            const int M = NTOK - out_lo;
            pg8::Gemm g{(const bf16*)(F.ws + WS_MIX) + (size_t)out_lo * DM, (const bf16*)(F.ws + WS_WOUT), M, DM, DM}; pg8::StaticOrder S; S.init(M, DM, DM, F.G, F.bid);
            pg8::EpiResid E{XLAT, F.out, XCTX, (float*)(F.ws + WS_XCTX), modv_ptr(F, l, 0) + 2 * DM, modv_ptr(F, l, 1) + 2 * DM, NCTX, out_lo};
            pg8::gemm_phase<pg8::EpiResid, pg8::StaticOrder, true, true>(F.lds, g, S, E, F.tid);
        }
        SEAM(b + 7);
        if (EN(8) && IN(b + 8)) { FRESH(); ph_norm<1>(F, AV, l, F.out, (const float*)(F.ws + WS_XCTX), out_lo);
#ifdef ZERO_MOE
            { unsigned zu_ = 0u; asm volatile("" : "+v"(zu_)); v4u* z = (v4u*)(F.ws + WS_AMOE); const size_t n = ((size_t)MAXSLOT * 2048 * 2 + (size_t)MAXSLOT * 512 * 2) / 16;
              for (size_t i = (size_t)F.bid * NTHR + F.tid; i < n; i += (size_t)F.G * NTHR) z[i] = (v4u){zu_, zu_, zu_, zu_}; }
#endif
        }
        SEAM(b + 8);
        if (EN(9) && IN(b + 9)) { FRESH();
            const int M = NTOK - out_lo;
            pg8::Gemm g{(const bf16*)(F.ws + WS_HBUF) + (size_t)out_lo * DM, (const bf16*)(F.ws + WS_WR), M, 256, DM}; pg8::StaticOrder S; S.init(M, 256, DM, F.G, F.bid);
            pg8::EpiRouter E{AV.in[I_RGB] + l * 4, AV.in[I_REB] + l * 32, (int*)(F.ws + WS_TOKE), (float*)(F.ws + WS_TOKW), F.ctl + CW_CNT + 64 * l, out_lo};
            pg8::gemm_phase<pg8::EpiRouter, pg8::StaticOrder, false, true>(F.lds, g, S, E, F.tid);
        }
        SEAM(b + 9);
        if (EN(10) && IN(b + 10)) { FRESH(); ph_assign(F, l, out_lo); }
        SEAM(b + 10);
        if (EN(11) && IN(b + 11)) { FRESH(); ph_route(F, l, out_lo); }
        SEAM(b + 11);
        if (EN(12) && IN(b + 12)) { FRESH();
            build_tile_table(F, l);
            const LAS int* tab = (const LAS int*)(F.lds + TILE_TAB_OFF);
            pg8::Gemm g{(const bf16*)(F.ws + WS_AMOE), (const bf16*)(F.ws + WS_WUP), MAXSLOT, 1024, DM}; GroupedOrder S; S.init(tab, 4, DM, 1024, F.G, F.bid);
            pg8::EpiSwiGLU E{(bf16*)(F.ws + WS_HMOE), 512};
            pg8::gemm_phase<pg8::EpiSwiGLU, GroupedOrder, true, true>(F.lds, g, S, E, F.tid);
        }
        SEAM(b + 12);
        if (EN(13) && IN(b + 13)) { FRESH();
            build_tile_table(F, l);
            const LAS int* tab = (const LAS int*)(F.lds + TILE_TAB_OFF);
#if defined(TEST_W2COPY)
            pg8::Gemm g{(const bf16*)(F.ws + WS_HMOE), (const bf16*)(F.ws + WS_PARK), MAXSLOT, DM, 512}; GroupedOrder S; S.init(tab, 8, 512, 0, F.G, F.bid);
#elif defined(TEST_K512D0)
            pg8::Gemm g{(const bf16*)(F.ws + WS_HMOE), (const bf16*)(F.ws + WS_WDN), MAXSLOT, DM, 512}; GroupedOrder S; S.init(tab, 8, 512, 0, F.G, F.bid);
#elif defined(TEST_K512W)
            pg8::Gemm g{(const bf16*)(F.ws + WS_HMOE), (const bf16*)(F.ws + WS_WOUT), MAXSLOT, DM, 512}; GroupedOrder S; S.init(tab, 8, 512, 0, F.G, F.bid);
#elif defined(TEST_K1024)
            pg8::Gemm g{(const bf16*)(F.ws + WS_AMOE), (const bf16*)(F.ws + WS_WDN), MAXSLOT, DM, 1024}; GroupedOrder S; S.init(tab, 4, 1024, 1024, F.G, F.bid);
#elif defined(TEST_K512A)
            pg8::Gemm g{(const bf16*)(F.ws + WS_AMOE), (const bf16*)(F.ws + WS_WDN), MAXSLOT, DM, 512}; GroupedOrder S; S.init(tab, 8, 512, DM, F.G, F.bid);
#elif defined(TEST_K2048)
            pg8::Gemm g{(const bf16*)(F.ws + WS_AMOE), (const bf16*)(F.ws + WS_WOUT), MAXSLOT, DM, DM}; GroupedOrder S; S.init(tab, 8, DM, 0, F.G, F.bid);
#else
            pg8::Gemm g{(const bf16*)(F.ws + WS_HMOE), (const bf16*)(F.ws + WS_WDN), MAXSLOT, DM, 512}; GroupedOrder S; S.init(tab, 8, 512, DM, F.G, F.bid);
#endif
            pg8::EpiBf16 E{(bf16*)(F.ws + WS_YMOE), DM};
#if defined(MOEDN_SGEMM)
            sgemm_bf16out(F, g.A, g.Bt, g.K, S, (bf16*)(F.ws + WS_YMOE), DM);
#elif defined(MOEDN_ONEUNIT)
#pragma unroll 1
            for (int i = 0; i * F.G + F.bid < S.nunits; ++i) { OneUnit<GroupedOrder> S1{S, i}; pg8::gemm_phase<pg8::EpiBf16, OneUnit<GroupedOrder>, false, true>(F.lds, g, S1, E, F.tid); }
#else
            pg8::gemm_phase<pg8::EpiBf16, GroupedOrder, MOEDN_ALIGN, MOEDN_SP2>(F.lds, g, S, E, F.tid);
#endif
        }
        SEAM(b + 13);
        if (EN(14) && IN(b + 14)) { FRESH(); ph_combine(F, l, out_lo); }
        SEAM(b + 14);
    }
    }

#undef IN
#undef SEAM
}

#ifndef CHK_SCALE
#define CHK_SCALE 1.0f
#endif
#if defined(CHK_REGION) || defined(TOUCH_WDN)
__global__ void chk_kernel(const unsigned short* p, size_t n, float* out) {
    const size_t t = (size_t)blockIdx.x * blockDim.x + threadIdx.x, T = (size_t)gridDim.x * blockDim.x; float s = 0.f;
    for (size_t i = t; i < n; i += T) s += __builtin_bit_cast(float, (unsigned)p[i] << 16);
    out[t] += s * CHK_SCALE;
}
#endif
template <int KIND> static void launch_kind(int grid, const Args& a, hipStream_t stream) {
    static bool attr = false;
    if (!attr) { (void)hipFuncSetAttribute((const void*)fwd<KIND>, hipFuncAttributeMaxDynamicSharedMemorySize, LDS_BYTES); attr = true; }
    hipLaunchKernelGGL(fwd<KIND>, dim3(grid), dim3(NTHR), LDS_BYTES, stream, a);
}
extern "C" void kernel_launch(void* const* d_in, const int* in_sizes, int n_in, void* d_out, int out_size, void* d_ws, size_t ws_size, hipStream_t stream) {
    static int grid = 0;
    if (grid == 0) {
        if (n_in != N_IN || out_size != SEQ * DM || ws_size < WS_END) { fprintf(stderr, "kernel_launch: unexpected shapes: n_in %d out %d ws %zu (need %zu)\n", n_in, out_size, ws_size, (size_t)WS_END); grid = -1; return; }
        int dev = 0, cus = 0;
        if (hipGetDevice(&dev) != hipSuccess || hipDeviceGetAttribute(&cus, hipDeviceAttributeMultiprocessorCount, dev) != hipSuccess) { grid = -1; return; }
        grid = cus;
    }
    if (grid < 0) return;
    (void)hipMemsetAsync((char*)d_ws + WS_CTL, 0, CTL_ZERO_BYTES, stream);
#ifdef MEMSET_WDN
    (void)hipMemsetAsync((char*)d_ws + WS_WDN, 0, 64 * MiB, stream);
#endif
    Args a{};
    for (int i = 0; i < N_IN; ++i) a.in[i] = (const float*)d_in[i];
    a.out = (float*)d_out; a.ws = (unsigned char*)d_ws;
#if MK_SINGLE
    a.ph_lo = 0; a.ph_hi = N_PHASES;
    launch_kind<-1>(grid, a, stream);
#else
#ifndef P_END
#define P_END N_PHASES
#endif
    for (int p = 0; p < P_END; ++p) { a.ph_lo = p; a.ph_hi = p + 1;
        const int k = p == 0 ? 100 : (p - 1) % PH_PER_LAYER;
#ifdef SKIP_MOE_GEMM
        if (k == 12 || k == 13) continue;
#endif
#ifdef TEST_H
        if (k == 13) continue;
#endif
#ifdef TOUCH_WDN
        if (k == 11) hipLaunchKernelGGL(chk_kernel, dim3(256), dim3(512), 0, stream, (const unsigned short*)((char*)d_ws + WS_WDN), (size_t)(64 * MiB) / 2, (float*)((char*)d_ws + WS_PARK));
#endif
#ifdef TEST_W2COPY
        if (k == 11) (void)hipMemcpyAsync((char*)d_ws + WS_PARK, (char*)d_ws + WS_WDN, 2 * MiB, hipMemcpyDeviceToDevice, stream);
#endif
#ifdef TWICE_MOEDN
        if (k == 11) launch_kind<11>(grid, a, stream);
#endif
#ifdef REPEAT_KIND
        if (k == REPEAT_KIND) { a.rep = REPEAT_MODE; for (int q = 0; q < REPEAT_N; ++q) launch_kind<REPEAT_KIND>(grid, a, stream); a.rep = 0; }
#endif
        switch (k) {
            case 100: launch_kind<100>(grid, a, stream); break;
            case 0: launch_kind<0>(grid, a, stream); break; case 1: launch_kind<1>(grid, a, stream); break; case 2: launch_kind<2>(grid, a, stream); break;
            case 3: launch_kind<3>(grid, a, stream); break; case 4: launch_kind<4>(grid, a, stream); break; case 5: launch_kind<5>(grid, a, stream); break;
            case 6: launch_kind<6>(grid, a, stream); break; case 7: launch_kind<7>(grid, a, stream); break; case 8: launch_kind<8>(grid, a, stream); break;
            case 9: launch_kind<9>(grid, a, stream); break; case 10: launch_kind<10>(grid, a, stream); break; case 11: launch_kind<11>(grid, a, stream); break; case 12: launch_kind<12>(grid, a, stream); break; case 13: launch_kind<13>(grid, a, stream); break; case 14: launch_kind<14>(grid, a, stream); break;
        } }
#endif
#ifdef CHK_REGION
    hipLaunchKernelGGL(chk_kernel, dim3(256), dim3(512), 0, stream, (const unsigned short*)((char*)d_ws + CHK_REGION), (size_t)CHK_BYTES / 2, (float*)d_out);
#endif
}
```

```cpp
#define MK_SINGLE 1
#include <hip/hip_runtime.h>
#include <cstdio>
#include <cstdint>

#ifndef GSCALE
#define GSCALE 1.0f
#endif
namespace pg8 {
#define PG8_LAS __attribute__((address_space(3)))
typedef unsigned short bf16_t;
typedef short bf16x8 __attribute__((ext_vector_type(8)));
typedef float f32x4 __attribute__((ext_vector_type(4)));
typedef unsigned u32x4 __attribute__((ext_vector_type(4)));
constexpr int BM = 256, BK = 64, HALF = 128, HTB = HALF * BK * 2  , STAGE_BYTES = 8 * HTB, NXCD = 8, WGM = 8;

__host__ __device__ __forceinline__ int lds_byte(int r, int c) { const int st = (r >> 4) * 2 + (c >> 5), rr = r & 15, cc = c & 31, ob = rr * 64 + cc * 2; return st * 1024 + (ob ^ (((ob >> 9) & 1) << 5)); }
__host__ __device__ __forceinline__ void stage_rc(int b, int& R, int& C) { const int st = b / 1024, sb = b % 1024, swz = sb ^ (((sb >> 9) & 1) << 5); R = (st >> 1) * 16 + swz / 64; C = (st & 1) * 32 + (swz % 64) / 2; }
__host__ __device__ __forceinline__ int perm32(int rho) { const int n = rho >> 4, i = rho & 15; return 8 * (i >> 2) + 4 * n + (i & 3); }

struct Unit { int pm, pn; size_t aoff, boff; };
struct Gemm { const bf16_t* A; const bf16_t* Bt; int M, N, K; };

struct StaticOrder {
    int nM, nN, nwg, G, c; size_t tstep;
    __host__ __device__ void init(int M, int N, int K, int G_, int c_) { nM = M / BM; nN = N / BM; nwg = nM * nN; G = G_; c = c_; tstep = (size_t)BM * K * 2; }
    __host__ __device__ bool next(int i, Unit& u) const {
        const long L = (long)i * G + c; if (L >= nwg) return false;
        int wgid = (int)L; { const int q = nwg / NXCD, r = nwg % NXCD, xcd = wgid % NXCD, off = wgid / NXCD; wgid = (xcd < r ? xcd * (q + 1) : r * (q + 1) + (xcd - r) * q) + off; }
        const int nig = WGM * nN, gid = wgid / nig, fm = gid * WGM, gsz = (nM - fm) < WGM ? (nM - fm) : WGM;
        u.pm = fm + ((wgid % nig) % gsz); u.pn = (wgid % nig) / gsz; u.aoff = (size_t)u.pm * tstep; u.boff = (size_t)u.pn * tstep; return true;
    }
    __device__ __forceinline__ void a_ready(const Unit&) const {}
    __device__ __forceinline__ void done(const Unit&) const {}
};

__device__ __forceinline__ unsigned cvt_pk_bf16(float lo, float hi) { unsigned r; asm volatile("v_cvt_pk_bf16_f32 %0, %1, %2" : "=v"(r) : "v"(lo), "v"(hi)); return r; }

struct EpiBf16 {
    static constexpr bool PERM = true, AFTER_DRAIN = false;
    bf16_t* O; int ldc;
    __device__ __forceinline__ void operator()(const f32x4 (&acc)[2][2][4][2], const Unit& u, int wr, int wc, int fr, int fq) const {
        const int row0 = u.pm * BM + wr * 64 + fr; const int col0 = u.pn * BM + wc * 32 + 8 * fq;
#pragma unroll
        for (int ai = 0; ai < 2; ++ai)
#pragma unroll
            for (int m = 0; m < 4; ++m) { bf16_t* rowp = O + (size_t)(row0 + ai * HALF + m * 16) * ldc + col0;
#pragma unroll
                for (int bj = 0; bj < 2; ++bj) { const f32x4 v0 = acc[ai][bj][m][0], v1 = acc[ai][bj][m][1];
                    u32x4 w; w.x = cvt_pk_bf16(v0[0], v0[1]); w.y = cvt_pk_bf16(v0[2], v0[3]); w.z = cvt_pk_bf16(v1[0], v1[1]); w.w = cvt_pk_bf16(v1[2], v1[3]);
                    *(u32x4*)(rowp + bj * HALF) = w; } }
    }
};
struct EpiSwiGLU {
    static constexpr bool PERM = true, AFTER_DRAIN = false;
    bf16_t* O; int ldc;
    __device__ __forceinline__ void operator()(const f32x4 (&acc)[2][2][4][2], const Unit& u, int wr, int wc, int fr, int fq) const {
        const int row0 = u.pm * BM + wr * 64 + fr; const int col0 = u.pn * HALF + wc * 32 + 8 * fq;
#pragma unroll
        for (int ai = 0; ai < 2; ++ai)
#pragma unroll
            for (int m = 0; m < 4; ++m) { bf16_t* rowp = O + (size_t)(row0 + ai * HALF + m * 16) * ldc + col0;
                float r[8];
#pragma unroll
                for (int n = 0; n < 2; ++n)
#pragma unroll
                    for (int j = 0; j < 4; ++j) { const float g = acc[ai][0][m][n][j], up = acc[ai][1][m][n][j]; r[n * 4 + j] = g * __builtin_amdgcn_rcpf(1.0f + __expf(-g)) * up; }
                u32x4 w; w.x = cvt_pk_bf16(r[0], r[1]); w.y = cvt_pk_bf16(r[2], r[3]); w.z = cvt_pk_bf16(r[4], r[5]); w.w = cvt_pk_bf16(r[6], r[7]);
                *(u32x4*)rowp = w; }
    }
};
struct EpiRouter {
    static constexpr bool PERM = false, AFTER_DRAIN = true;
    const float* bias_g; const float* bias_e; int* toke; float* tokw; unsigned* cnt; int row_base;
    __device__ __forceinline__ void fused(const f32x4 (&acc)[2][2][4][2], const Unit& u, int wr, int wc, int fr, int fq, PG8_LAS unsigned char* lds, int wid, int lane) const {
        PG8_LAS float* T = (PG8_LAS float*)lds;
        if (wc == 0 || (wc == 1 && fq == 0)) {
#pragma unroll
            for (int ai = 0; ai < 2; ++ai)
#pragma unroll
                for (int m = 0; m < 4; ++m) { const int row = ai * HALF + wr * 64 + m * 16 + fr;
#pragma unroll
                    for (int n = 0; n < 2; ++n) { if (wc == 1 && n == 1) continue; const int c0 = 32 * wc + 16 * n + 4 * fq;
#pragma unroll
                        for (int j = 0; j < 4; ++j) T[row * 37 + c0 + j] = acc[ai][0][m][n][j]; } }
        }
        asm volatile("s_waitcnt lgkmcnt(0)" ::: "memory"); __builtin_amdgcn_s_barrier(); asm volatile("" ::: "memory");
        const int row = wid * 64 + lane;
        if (row < 256) {
            float lg[4], e8[8];
#pragma unroll
            for (int q = 0; q < 4; ++q) lg[q] = T[row * 37 + q] + bias_g[q];
            int gi = 0; float gm = lg[0];
#pragma unroll
            for (int q = 1; q < 4; ++q) if (lg[q] > gm) { gm = lg[q]; gi = q; }
            float gs = 0.f;
#pragma unroll
            for (int q = 0; q < 4; ++q) gs += __expf(lg[q] - gm);
            const float gp = 1.0f / gs;
#pragma unroll
            for (int q = 0; q < 8; ++q) e8[q] = T[row * 37 + 4 + gi * 8 + q] + bias_e[gi * 8 + q];
            int i1 = 0; float m1 = e8[0];
#pragma unroll
            for (int q = 1; q < 8; ++q) if (e8[q] > m1) { m1 = e8[q]; i1 = q; }
            int i2 = -1; float m2 = -3.0e38f;
#pragma unroll
            for (int q = 0; q < 8; ++q) if (q != i1 && e8[q] > m2) { m2 = e8[q]; i2 = q; }
            const float a2 = __expf(m2 - m1), w1 = gp / (1.0f + a2), w2 = gp * a2 / (1.0f + a2);
            const int t = row_base + u.pm * BM + row, e1 = gi * 8 + i1, e2 = gi * 8 + i2;
            toke[t * 2] = e1; toke[t * 2 + 1] = e2; tokw[t * 2] = w1; tokw[t * 2 + 1] = w2;
            atomicAdd(cnt + e1, 1u); atomicAdd(cnt + e2, 1u);
        }
    }
};
struct EpiResid {
    static constexpr bool PERM = false, AFTER_DRAIN = false;
    const float* src_lat; float* dst_lat; const float* src_ctx; float* dst_ctx; const float* gate_lat; const float* gate_ctx; int nctx; int row_base;
    __device__ __forceinline__ void operator()(const f32x4 (&acc)[2][2][4][2], const Unit& u, int wr, int wc, int fr, int fq) const {
        const int row0 = row_base + u.pm * BM + wr * 64 + fr, col0 = u.pn * BM + wc * 32 + 4 * fq;
        const bool isctx = (row_base + u.pm * BM) < nctx;
        const float* gate = isctx ? gate_ctx : gate_lat;
        f32x4 gv[2][2];
#pragma unroll
        for (int bj = 0; bj < 2; ++bj)
#pragma unroll
            for (int n = 0; n < 2; ++n) gv[bj][n] = *(const f32x4*)(gate + col0 + bj * HALF + n * 16);
#pragma unroll
        for (int ai = 0; ai < 2; ++ai)
#pragma unroll
            for (int m = 0; m < 4; ++m) { const int r = row0 + ai * HALF + m * 16;
                const float* sp = isctx ? src_ctx + (size_t)r * 2048 : src_lat + (size_t)(r - nctx) * 2048;
                float* dp = isctx ? dst_ctx + (size_t)r * 2048 : dst_lat + (size_t)(r - nctx) * 2048;
#pragma unroll
                for (int bj = 0; bj < 2; ++bj)
#pragma unroll
                    for (int n = 0; n < 2; ++n) { const int c = col0 + bj * HALF + n * 16; const f32x4 s = *(const f32x4*)(sp + c); *(f32x4*)(dp + c) = s + gv[bj][n] * acc[ai][bj][m][n] * GSCALE; } }
    }
};
template <class Epi, class Sched, bool ALIGN_EPI = false, bool SP2 = false>
__device__ __forceinline__ void gemm_phase(PG8_LAS unsigned char* lds, const Gemm g, const Sched& S, const Epi& E, const int tid) {
    const int wid = __builtin_amdgcn_readfirstlane(tid >> 6), lane = tid & 63, wr = wid >> 2, wc = wid & 3, fr = lane & 15, fq = lane >> 4;
    const int K = g.K, nt = K / BK;
    unsigned voffA[2], voffB[2];
#pragma unroll
    for (int i = 0; i < 2; ++i) { int R, C; stage_rc(tid * 16 + i * 8192, R, C); const int Rb = Epi::PERM ? ((R & ~31) + perm32(R & 31)) : R;
        voffA[i] = (unsigned)(R * K + C) * 2u; voffB[i] = (unsigned)(Rb * K + C) * 2u; }
    const size_t kstep = (size_t)(BK * 2);
    const size_t hstep = (size_t)HALF * K * 2;
    const size_t tstep = 2 * hstep;
    const unsigned ldsw = (unsigned)wid * 1024u;
    const int aoff = lds_byte(wr * 64 + fr, fq * 8), boff = lds_byte(wc * 32 + fr, fq * 8);
#define PG8_SA(b, h) (((b) * 2 + (h)) * HTB)
#define PG8_SB(b, h) ((4 + (b) * 2 + (h)) * HTB)
#define PG8_STAGE(bufoff, gbase, voff) do { _Pragma("unroll") for (int _i = 0; _i < 2; ++_i) \
        __builtin_amdgcn_global_load_lds((const unsigned*)((const char*)(gbase) + (voff)[_i]), (PG8_LAS unsigned*)(lds + (bufoff) + ldsw + _i * 8192), 16, 0, 0); } while (0)
#define PG8_LDA(dst, b, h) do { _Pragma("unroll") for (int m = 0; m < 4; ++m) _Pragma("unroll") for (int k = 0; k < 2; ++k) dst[m][k] = *(const PG8_LAS bf16x8*)(lds + PG8_SA(b, h) + aoff + m * 2048 + k * 1024); } while (0)
#define PG8_LDB(dst, b, h) do { _Pragma("unroll") for (int n = 0; n < 2; ++n) _Pragma("unroll") for (int k = 0; k < 2; ++k) dst[n][k] = *(const PG8_LAS bf16x8*)(lds + PG8_SB(b, h) + boff + n * 2048 + k * 1024); } while (0)
#define PG8_MMA(ai, bj, At, Bt) do { __builtin_amdgcn_s_setprio(1); _Pragma("unroll") for (int m = 0; m < 4; ++m) _Pragma("unroll") for (int n = 0; n < 2; ++n) _Pragma("unroll") for (int k = 0; k < 2; ++k) \
        acc[ai][bj][m][n] = __builtin_amdgcn_mfma_f32_16x16x32_bf16(Bt[n][k], At[m][k], acc[ai][bj][m][n], 0, 0, 0); __builtin_amdgcn_s_setprio(0); } while (0)
#define PG8_WAIT_V(n) asm volatile("s_waitcnt vmcnt(" #n ")" ::: "memory")
#define PG8_WAIT_L(n) asm volatile("s_waitcnt lgkmcnt(" #n ")" ::: "memory")
#define PG8_BAR __builtin_amdgcn_s_barrier()
#define PG8_SCHED __builtin_amdgcn_sched_barrier(0)
    Unit cur, nxt; int ui = 0;
    if (!S.next(0, cur)) return;
    f32x4 acc[2][2][4][2];
    float zz_ = 0.f; asm volatile("" : "+v"(zz_));
#pragma unroll
    for (int a = 0; a < 2; ++a)
#pragma unroll
        for (int b = 0; b < 2; ++b)
#pragma unroll
            for (int m = 0; m < 4; ++m)
#pragma unroll
                for (int n = 0; n < 2; ++n) acc[a][b][m][n] = (f32x4){zz_, zz_, zz_, zz_};
    bf16x8 At[4][2], B0[2][2], B1[2][2];
    const char* cA = (const char*)g.A + cur.aoff; const char* cB = (const char*)g.Bt + cur.boff;
    S.a_ready(cur);
    if constexpr (SP2) {
        PG8_STAGE(PG8_SB(0, 0), cB, voffB); PG8_STAGE(PG8_SB(0, 1), cB + hstep, voffB); PG8_STAGE(PG8_SA(0, 0), cA, voffA); PG8_STAGE(PG8_SA(0, 1), cA + hstep, voffA);
        if (wr == 1) PG8_BAR;
        PG8_WAIT_V(2); PG8_BAR;
        PG8_STAGE(PG8_SB(1, 0), cB + kstep, voffB); PG8_STAGE(PG8_SA(1, 0), cA + kstep, voffA); PG8_STAGE(PG8_SB(1, 1), cB + hstep + kstep, voffB);
        PG8_WAIT_V(6); PG8_BAR;
    } else {
        PG8_STAGE(PG8_SB(0, 0), cB, voffB); PG8_STAGE(PG8_SA(0, 0), cA, voffA); PG8_STAGE(PG8_SB(0, 1), cB + hstep, voffB); PG8_STAGE(PG8_SA(0, 1), cA + hstep, voffA);
        if (wr == 1) PG8_BAR;
        PG8_WAIT_V(4); PG8_BAR;
        PG8_STAGE(PG8_SB(1, 0), cB + kstep, voffB); PG8_STAGE(PG8_SA(1, 0), cA + kstep, voffA); PG8_STAGE(PG8_SB(1, 1), cB + hstep + kstep, voffB);
        PG8_WAIT_V(6); PG8_BAR;
    }
    for (;;) {
        const bool has_next = S.next(ui + 1, nxt);
        const char* nA = has_next ? (const char*)g.A + nxt.aoff : cA; const char* nB = has_next ? (const char*)g.Bt + nxt.boff : cB;
        for (int t = 0; t < nt; t += 2) {
            const bool last = (t == nt - 2);
            const char* a1 = cA + (size_t)(t + 1) * kstep;
            const char* a2 = last ? nA : cA + (size_t)(t + 2) * kstep; const char* b2 = last ? nB : cB + (size_t)(t + 2) * kstep;
            const char* a3 = a2 + kstep; const char* b3 = b2 + kstep;
            if (last && has_next) S.a_ready(nxt);
            if constexpr (SP2) {
            PG8_LDB(B0, 0, 0); PG8_LDB(B1, 0, 1); PG8_SCHED; PG8_LDA(At, 0, 0); PG8_STAGE(PG8_SA(1, 1), a1 + hstep, voffA);
            PG8_WAIT_V(8); PG8_WAIT_L(0); PG8_BAR; PG8_MMA(0, 0, At, B0); PG8_MMA(0, 1, At, B1); PG8_BAR; PG8_SCHED;
            PG8_LDA(At, 0, 1); PG8_STAGE(PG8_SB(0, 0), b2, voffB); PG8_STAGE(PG8_SB(0, 1), b2 + hstep, voffB); PG8_STAGE(PG8_SA(0, 0), a2, voffA);
            PG8_WAIT_V(8); PG8_WAIT_L(0); PG8_BAR; PG8_MMA(1, 0, At, B0); PG8_MMA(1, 1, At, B1); PG8_BAR; PG8_SCHED;
            PG8_LDB(B0, 1, 0); PG8_LDB(B1, 1, 1); PG8_SCHED; PG8_LDA(At, 1, 0); PG8_STAGE(PG8_SA(0, 1), a2 + hstep, voffA);
            PG8_WAIT_V(8); PG8_WAIT_L(0); PG8_BAR; PG8_MMA(0, 0, At, B0); PG8_MMA(0, 1, At, B1); PG8_BAR; PG8_SCHED;
            PG8_LDA(At, 1, 1); PG8_STAGE(PG8_SB(1, 0), b3, voffB); PG8_STAGE(PG8_SB(1, 1), b3 + hstep, voffB); PG8_STAGE(PG8_SA(1, 0), a3, voffA);
            PG8_WAIT_V(8); PG8_WAIT_L(0); PG8_BAR; PG8_MMA(1, 0, At, B0); PG8_MMA(1, 1, At, B1); PG8_BAR; PG8_SCHED;
            } else {
            PG8_LDB(B0, 0, 0); PG8_SCHED; PG8_LDA(At, 0, 0); PG8_STAGE(PG8_SA(1, 1), a1 + hstep, voffA);
            PG8_WAIT_L(8); PG8_BAR; PG8_WAIT_L(0); PG8_MMA(0, 0, At, B0); PG8_BAR; PG8_SCHED;
            PG8_LDB(B1, 0, 1); PG8_STAGE(PG8_SB(0, 0), b2, voffB);
            PG8_BAR; PG8_WAIT_L(0); PG8_MMA(0, 1, At, B1); PG8_BAR;
            PG8_LDA(At, 0, 1); PG8_STAGE(PG8_SA(0, 0), a2, voffA);
            PG8_BAR; PG8_WAIT_L(0); PG8_MMA(1, 0, At, B0); PG8_BAR; PG8_SCHED;
            PG8_STAGE(PG8_SB(0, 1), b2 + hstep, voffB);
            PG8_WAIT_V(6); PG8_BAR; PG8_MMA(1, 1, At, B1); PG8_BAR;
            PG8_LDB(B0, 1, 0); PG8_SCHED; PG8_LDA(At, 1, 0); PG8_STAGE(PG8_SA(0, 1), a2 + hstep, voffA);
            PG8_WAIT_L(8); PG8_BAR; PG8_WAIT_L(0); PG8_MMA(0, 0, At, B0); PG8_BAR; PG8_SCHED;
            PG8_LDB(B1, 1, 1); PG8_STAGE(PG8_SB(1, 0), b3, voffB);
            PG8_BAR; PG8_WAIT_L(0); PG8_MMA(0, 1, At, B1); PG8_BAR;
            PG8_LDA(At, 1, 1); PG8_STAGE(PG8_SA(1, 0), a3, voffA);
            PG8_BAR; PG8_WAIT_L(0); PG8_MMA(1, 0, At, B0); PG8_BAR; PG8_SCHED;
            PG8_STAGE(PG8_SB(1, 1), b3 + hstep, voffB);
            PG8_WAIT_V(6); PG8_BAR; PG8_MMA(1, 1, At, B1); PG8_BAR;
            }
        }
        if constexpr (ALIGN_EPI) { if (wr == 0) PG8_BAR; }
        if constexpr (!Epi::AFTER_DRAIN) { E(acc, cur, wr, wc, fr, fq); S.done(cur); }
        if (!has_next) break;
#pragma unroll
        for (int a = 0; a < 2; ++a)
#pragma unroll
            for (int b = 0; b < 2; ++b)
#pragma unroll
                for (int m = 0; m < 4; ++m)
#pragma unroll
                    for (int n = 0; n < 2; ++n) acc[a][b][m][n] = (f32x4){zz_, zz_, zz_, zz_};
        cur = nxt; cA = nA; cB = nB; ++ui;
        if constexpr (ALIGN_EPI) { if (wr == 1) PG8_BAR; }
    }
    PG8_WAIT_V(0);
    if constexpr (!ALIGN_EPI) { if (wr == 0) PG8_BAR; }
    PG8_BAR;
    if constexpr (Epi::AFTER_DRAIN) { E.fused(acc, cur, wr, wc, fr, fq, lds, wid, lane); S.done(cur); }
#undef PG8_SA
#undef PG8_SB
#undef PG8_STAGE
#undef PG8_LDA
#undef PG8_LDB
#undef PG8_MMA
#undef PG8_WAIT_V
#undef PG8_WAIT_L
#undef PG8_BAR
#undef PG8_SCHED
}
}


constexpr int NWAVES = 8, NTHR = 512;
constexpr int DM = 2048, SEQ = 16384, NCTX = 256, NTOK = SEQ + NCTX, PW = 6720, PWP = 6912, NEXP = 32;
constexpr int C_GQKV = 0, C_GGATE = 1536, C_GBETA = 2048, C_GALPHA = 2064, C_SCB = 2080, C_SCC = 2592, C_SCX = 3104, C_LQ = 3616, C_LK = 3872, C_LV = 4128, C_LR = 4640,
              C_LLR = 5152, C_DQ = 5184, C_DK = 5696, C_DV = 6208;
constexpr int MAXSLOT = 41472;
constexpr float NEPS = 1e-6f;
enum { I_X = 0, I_C, I_CTX, I_CCTX, I_WMOD, I_BMOD, I_NORM1, I_NORM2, I_WIN, I_WOUT, I_GCONV, I_GALOG, I_GDT, I_GONORM, I_SCCONV, I_LGUP, I_LGBIAS, I_LONORM,
       I_DQN, I_DKN, I_DLAM, I_DON, I_RG, I_RGB, I_RE, I_REB, I_W1, I_W3, I_W2, N_IN };

constexpr size_t MiB = 1u << 20;
constexpr size_t WS_CTL = 0, CTL_ZERO_BYTES = 1 * MiB;
constexpr int CW_BAR = 4096;
constexpr int CW_CNT = 8192, CW_CUR = 8192 + 128;
constexpr size_t CTL_MODV = 256 * 1024;
constexpr size_t WS_SMALL = 1 * MiB;
constexpr size_t SM_ROPER = 0, SM_ROPEC = 32768, SM_LAM = 32768 + 8192;
constexpr size_t WS_MODP = 930 * MiB;
constexpr size_t WS_XCTX = 2 * MiB;
constexpr size_t WS_TOKE = 4 * MiB, WS_TOKW = WS_TOKE + 160 * 1024, WS_TOKS = WS_TOKW + 160 * 1024;
constexpr size_t WS_GBETA = 5 * MiB, WS_GDEC = WS_GBETA + 1280 * 1024;
constexpr size_t WS_WIN = 8 * MiB, WS_WOUT = 35 * MiB, WS_WUP = 43 * MiB, WS_WDN = 171 * MiB;
constexpr size_t WS_HBUF = 235 * MiB, WS_P = 300 * MiB, WS_MIX = 520 * MiB;
constexpr size_t WS_QR = 585 * MiB, WS_KR = 602 * MiB, WS_VT = 619 * MiB;
constexpr size_t WS_GQ = 636 * MiB, WS_GK = 669 * MiB, WS_GV = 702 * MiB, WS_LOGA = 735 * MiB;
constexpr size_t WS_OGDN = 768 * MiB, WS_OGLA = 833 * MiB, WS_PARK = 898 * MiB;
constexpr size_t WS_GQP = WS_OGDN, WS_GOP = WS_OGLA; constexpr size_t WS_GST = WS_GQP + 65 * MiB / 2; constexpr size_t WS_GLS = WS_GOP + 65 * MiB / 2;
constexpr size_t WS_GA = 936 * MiB, WS_GB = 1001 * MiB, WS_OL = 1066 * MiB;
constexpr size_t WS_DS = WS_HBUF;
constexpr size_t WS_GQB = 1131 * MiB, WS_ACH = 1164 * MiB, WS_EGL = 1164 * MiB + 640 * 1024, WS_WR = 1165 * MiB  , WS_END = 1166 * MiB;
constexpr size_t WS_AMOE = WS_P, WS_HMOE = WS_P + 162 * MiB;
static_assert(WS_HMOE + (size_t)MAXSLOT * 512 * 2 <= WS_MIX, "moe overlay");
#ifdef Y_SEPARATE
constexpr size_t WS_YMOE = WS_MIX;
#else
constexpr size_t WS_YMOE = WS_AMOE;
#endif

constexpr int RING_BYTES = 131072, LDSCTL_OFF = RING_BYTES, MISC_OFF = LDSCTL_OFF + 320, TILE_TAB_OFF = LDSCTL_OFF + 1024, LDS_BYTES = 147456;

#define GAS __attribute__((address_space(1)))
#define LAS __attribute__((address_space(3)))
typedef unsigned short bf16;
typedef unsigned v4u __attribute__((ext_vector_type(4)));
typedef float f32x4 __attribute__((ext_vector_type(4)));
typedef float f32x16 __attribute__((ext_vector_type(16)));
typedef short bf16x8 __attribute__((ext_vector_type(8)));
#define LDS_WAIT() asm volatile("s_waitcnt lgkmcnt(0)" ::: "memory")
#define VM_WAIT() asm volatile("s_waitcnt vmcnt(0)" ::: "memory")
__device__ __forceinline__ unsigned f2bf(float f) { unsigned u = __builtin_bit_cast(unsigned, f); return (u + 0x7fffu + ((u >> 16) & 1u)) >> 16; }
__device__ __forceinline__ unsigned pk2(float lo, float hi) { return f2bf(lo) | (f2bf(hi) << 16); }
__device__ __forceinline__ float bf2f(unsigned short b) { return __builtin_bit_cast(float, (unsigned)b << 16); }
__device__ __forceinline__ void unpack8(const v4u v, float (&f)[8]) {
#pragma unroll
    for (int i = 0; i < 4; ++i) { f[2 * i] = __builtin_bit_cast(float, v[i] << 16); f[2 * i + 1] = __builtin_bit_cast(float, v[i] & 0xffff0000u); }
}
__device__ __forceinline__ void load8(const bf16* p, float (&f)[8]) { unpack8(*(const v4u*)p, f); }
__device__ __forceinline__ v4u pack8(const float (&f)[8]) { v4u w; w.x = pk2(f[0], f[1]); w.y = pk2(f[2], f[3]); w.z = pk2(f[4], f[5]); w.w = pk2(f[6], f[7]); return w; }
__device__ __forceinline__ float siluf(float x) { return x / (1.0f + __expf(-x)); }
__device__ __forceinline__ float sigmoidf_(float x) { return 1.0f / (1.0f + __expf(-x)); }
__device__ __forceinline__ float softplusf_(float x) { return fmaxf(x, 0.f) + __logf(1.0f + __expf(-fabsf(x))); }
__device__ __forceinline__ float wave_sum(float v) {
#pragma unroll
    for (int o = 1; o < 64; o <<= 1) v += __shfl_xor(v, o);
    return v;
}

#define XB_TMO      128
#define XB_XCNT(j)  (256  + 64 * (j))
#define XB_XSUB(j)  (1280 + 64 * (j))
#define XB_XGEN(j)  (2304 + 64 * (j))
#define XB_TOP      3328
#define XB_TOPGEN   3392
#define XCD_BAR_WORDS 3456
#define XB_SPIN_CAP (1u << 18)
__device__ __forceinline__ unsigned xb_ld(unsigned* p)              { return __hip_atomic_load(p, __ATOMIC_RELAXED, __HIP_MEMORY_SCOPE_AGENT); }
__device__ __forceinline__ unsigned xb_add(unsigned* p, unsigned v) { return __hip_atomic_fetch_add(p, v, __ATOMIC_RELAXED, __HIP_MEMORY_SCOPE_AGENT); }
__device__ __forceinline__ unsigned xb_xcc_id() { return (unsigned)__builtin_amdgcn_s_getreg((3 << 11) | 20) & 0xFu; }
#define XB_SPIN(cond, bar) do { unsigned _sp = 0; while (cond) { __builtin_amdgcn_s_sleep(1); \
    if ((++_sp & 255u) == 0u) { if (xb_ld(&(bar)[XB_TMO])) break; if (_sp > XB_SPIN_CAP) { atomicAdd(&(bar)[XB_TMO], 1u); break; } } } } while (0)
struct XcdBarrier { unsigned* bar; unsigned x; volatile LAS unsigned* st; };
__device__ __forceinline__ XcdBarrier xcd_barrier_post(unsigned* bar, volatile LAS unsigned* st) {
    XcdBarrier b; b.bar = bar; b.x = xb_xcc_id(); b.st = st;
    if (threadIdx.x == 0) (void)xb_add(&bar[XB_XCNT(b.x)], 1u);
    return b;
}
__device__ __forceinline__ unsigned long long xcd_barrier_complete(unsigned* bar, unsigned x) {
    const unsigned G = gridDim.x * gridDim.y * gridDim.z;
    unsigned sum, cnt, mine, sp = 0u;
    for (;;) {
        sum = 0u; cnt = 0u; mine = 0u;
#pragma unroll
        for (unsigned j = 0; j < 16; ++j) { const unsigned c = xb_ld(&bar[XB_XCNT(j)]); sum += c; cnt += (c > 0u) ? 1u : 0u; mine = (j == x) ? c : mine; }
        if (sum == G) break;
        __builtin_amdgcn_s_sleep(1);
        if ((++sp & 255u) == 0u) { if (xb_ld(&bar[XB_TMO])) break; if (sp > XB_SPIN_CAP) { atomicAdd(&bar[XB_TMO], 1u); break; } }
    }
    const unsigned nloc = mine > 0u ? mine : 1u, nx = cnt > 0u ? cnt : 1u;
    return ((unsigned long long)nx << 32) | nloc;
}
__device__ __forceinline__ void xcd_barrier(const XcdBarrier& b) {
    asm volatile("s_waitcnt vmcnt(0)" ::: "memory");
    __syncthreads();
    if (threadIdx.x == 0) {
        unsigned* bar = b.bar;
        __builtin_amdgcn_s_waitcnt(0);
        unsigned nloc = b.st[0], nx = b.st[1];
        if (nloc == 0u) { const unsigned long long r_ = xcd_barrier_complete(bar, b.x); nloc = (unsigned)r_; nx = (unsigned)(r_ >> 32); b.st[0] = nloc; b.st[1] = nx; }
        const unsigned old = xb_add(&bar[XB_XSUB(b.x)], 1u);
        const unsigned gen = old / nloc;
        if (old + 1u == (gen + 1u) * nloc) {
            __builtin_amdgcn_fence(__ATOMIC_RELEASE, "agent");
            asm volatile("s_waitcnt vmcnt(0)" ::: "memory");
            const unsigned og = xb_add(&bar[XB_TOP], 1u);
            const unsigned tg = og / nx;
            if (og + 1u == (tg + 1u) * nx) xb_add(&bar[XB_TOPGEN], 1u);
            else XB_SPIN(xb_ld(&bar[XB_TOPGEN]) == tg, bar);
            __builtin_amdgcn_fence(__ATOMIC_ACQUIRE, "agent");
            xb_add(&bar[XB_XGEN(b.x)], 1u);
            asm volatile("s_waitcnt vmcnt(0)" ::: "memory");
        } else {
            XB_SPIN(xb_ld(&bar[XB_XGEN(b.x)]) == gen, bar);
            __builtin_amdgcn_fence(__ATOMIC_ACQUIRE, "agent");
            asm volatile("s_waitcnt vmcnt(0)" ::: "memory");
        }
    }
    __syncthreads();
}

struct Args { const float* in[N_IN]; float* out; unsigned char* ws; int ph_lo, ph_hi, rep, pad; };
typedef const __attribute__((address_space(4))) Args* CArgsP;
struct InProxy { CArgsP p; __device__ __forceinline__ const float* operator[](int i) const { return p->in[i]; } };
struct ArgView { InProxy in; };
struct Frame {
    LAS unsigned char* lds;
    unsigned char* ws; unsigned* ctl;
    float* out;
    int tid, lane, wave, G, bid;
};
__device__ __forceinline__ float* modv_ptr(const Frame& F, int l, int which  ) { return (float*)(F.ws + WS_CTL + CTL_MODV) + (size_t)(l * 2 + which) * 12288; }

__device__ __forceinline__ void ph_prologue(const Frame& F, const ArgView& A) {
    const float* cvec = A.in[I_C]; const float* cctx = A.in[I_CCTX];
    for (int item = F.bid; item < 768; item += F.G) {
        const int l = item / 384, rem = item % 384, cc = rem / 32, ks = rem % 32, col = cc * 1024 + F.tid * 2;
        const float* W = A.in[I_WMOD] + (size_t)l * 2048 * 12288;
        float a0 = 0.f, a1 = 0.f, b0 = 0.f, b1 = 0.f;
#pragma unroll 16
        for (int i = ks * 64; i < ks * 64 + 64; ++i) {
            const float sl = siluf(cvec[i]), sx = siluf(cctx[i]);
            const float2 w = *(const float2*)(W + (size_t)i * 12288 + col);
            a0 += sl * w.x; a1 += sl * w.y; b0 += sx * w.x; b1 += sx * w.y;
        }
        float* pl = (float*)(F.ws + WS_MODP) + ((size_t)((l * 32 + ks) * 2 + 0)) * 12288 + col; float* pc = pl + 12288;
        *(float2*)pl = make_float2(a0, a1); *(float2*)pc = make_float2(b0, b1);
    }
    float* small = (float*)(F.ws + WS_SMALL);
    for (int i = F.bid * NTHR + F.tid; i < 320 * 16; i += F.G * NTHR) {
        const int pos = i / 16, fi = i % 16; const float inv = powf(10000.f, -(float)fi / 16.f);
        const float ang = (float)(pos < 256 ? pos : pos - 256) * inv;
        float* dst = pos < 256 ? small + SM_ROPER / 4 + (pos * 16 + fi) * 2 : small + SM_ROPEC / 4 + ((pos - 256) * 16 + fi) * 2;
        dst[0] = cosf(ang); dst[1] = sinf(ang);
    }
    if (F.bid == 0 && F.wave == 0) {
#pragma unroll
        for (int l = 0; l < 2; ++l) {
            const float* lp = A.in[I_DLAM] + l * 256;
            const float s1 = wave_sum(lp[F.lane] * lp[64 + F.lane]), s2 = wave_sum(lp[128 + F.lane] * lp[192 + F.lane]);
            const float lam_init = 0.8f - 0.6f * expf(-0.3f * (float)l);
            if (F.lane == 0) small[SM_LAM / 4 + l] = expf(s1) - expf(s2) + lam_init;
        }
    }
}

__device__ __forceinline__ void transpose_item(const float* W, int K, int N, bf16* WT, int k0, int n0, int drow0, LAS float* scr, int lane) {
#pragma unroll 8
    for (int i = 0; i < 32; ++i) { const int kk = 2 * i + (lane >> 5); scr[kk * 33 + (lane & 31)] = W[(size_t)(k0 + kk) * N + n0 + (lane & 31)]; }
    LDS_WAIT(); asm volatile("" ::: "memory");
    const int c = lane & 7;
#pragma unroll
    for (int j = 0; j < 4; ++j) { const int n = (lane >> 3) + 8 * j; const LAS float* s = scr + (8 * c) * 33 + n;
        v4u o; o.x = pk2(s[0 * 33], s[1 * 33]); o.y = pk2(s[2 * 33], s[3 * 33]); o.z = pk2(s[4 * 33], s[5 * 33]); o.w = pk2(s[6 * 33], s[7 * 33]);
        *(v4u*)(WT + (size_t)(drow0 + n) * K + k0 + 8 * c) = o; }
    LDS_WAIT(); asm volatile("" ::: "memory");
}
__device__ __forceinline__ void ph_convert(const Frame& F, const ArgView& A, int l) {
    LAS float* scr = (LAS float*)(F.lds + F.wave * 16384);
    const int gw = F.bid * NWAVES + F.wave, NGW = F.G * NWAVES;
    constexpr int I_IN = 32 * 210, I_OUT = 32 * 64, I_E13 = 32 * 16, I_E2 = 8 * 64;
    constexpr int NITEMS = I_IN + I_OUT + NEXP * (2 * I_E13 + I_E2);
    bf16* win = (bf16*)(F.ws + WS_WIN); bf16* wout = (bf16*)(F.ws + WS_WOUT); bf16* wup = (bf16*)(F.ws + WS_WUP); bf16* wdn = (bf16*)(F.ws + WS_WDN);
    for (int it = gw; it < NITEMS; it += NGW) {
        int r = it;
        if (r < I_IN) { const int kb = r / 210, nb = r % 210; transpose_item(A.in[I_WIN] + (size_t)l * 2048 * PW, 2048, PW, win, 64 * kb, 32 * nb, 32 * nb, scr, F.lane); continue; } r -= I_IN;
        if (r < I_OUT) { const int kb = r / 64, nb = r % 64; transpose_item(A.in[I_WOUT] + (size_t)l * 2048 * 2048, 2048, 2048, wout, 64 * kb, 32 * nb, 32 * nb, scr, F.lane); continue; } r -= I_OUT;
        const int e = r / (2 * I_E13 + I_E2); r %= (2 * I_E13 + I_E2);
        if (r < 2 * I_E13) { const int w3 = r / I_E13, q = r % I_E13, kb = q / 16, nb = q % 16, n0 = 32 * nb;
            const float* W = (w3 ? A.in[I_W3] : A.in[I_W1]) + ((size_t)l * NEXP + e) * 2048 * 512;
            transpose_item(W, 2048, 512, wup + (size_t)e * 1024 * 2048, 64 * kb, n0, (n0 / 128) * 256 + (n0 % 128) + (w3 ? 128 : 0), scr, F.lane); continue; }
        r -= 2 * I_E13;
        { const int kb = r / 64, nb = r % 64; const float* W = A.in[I_W2] + ((size_t)l * NEXP + e) * 512 * 2048;
          transpose_item(W, 512, 2048, wdn + (size_t)e * 2048 * 512, 64 * kb, 32 * nb, 32 * nb, scr, F.lane); }
    }
    if (l == 0) {
        for (int i = F.bid * NTHR + F.tid; i < 2 * 2 * 12288; i += F.G * NTHR) { const int ll = i / (2 * 12288), which = (i / 12288) & 1, col = i % 12288;
            float sacc = A.in[I_BMOD][ll * 12288 + col];
            for (int ks = 0; ks < 32; ++ks) sacc += ((const float*)(F.ws + WS_MODP))[((size_t)((ll * 32 + ks) * 2 + which)) * 12288 + col];
            modv_ptr(F, ll, which)[col] = sacc; }
    }
    {
        bf16* wr = (bf16*)(F.ws + WS_WR); const float* rg = A.in[I_RG] + (size_t)l * 2048 * 4; const float* re = A.in[I_RE] + (size_t)l * 2048 * 32;
        for (int i = F.bid * NTHR + F.tid; i < 256 * 2048; i += F.G * NTHR) { const int n = i >> 11, k = i & 2047;
            const float v = n < 4 ? rg[k * 4 + n] : (n < 36 ? re[k * 32 + (n - 4)] : 0.f); wr[i] = (bf16)f2bf(v); }
    }
    unsigned zu_ = 0u; asm volatile("" : "+v"(zu_));
    v4u* z = (v4u*)(win + (size_t)PW * 2048);
    for (int i = F.bid * NTHR + F.tid; i < (PWP - PW) * 2048 / 8; i += F.G * NTHR) z[i] = (v4u){zu_, zu_, zu_, zu_};
}

template <int WHICH>
__device__ __forceinline__ void ph_norm(const Frame& F, const ArgView& A, int l, const float* xlat, const float* xctx, int row_lo) {
    const int gw = F.bid * NWAVES + F.wave, NGW = F.G * NWAVES;
    const float* gain = A.in[WHICH == 0 ? I_NORM1 : I_NORM2] + l * 2048;
    bf16* hb = (bf16*)(F.ws + WS_HBUF);
    unsigned* cnt = F.ctl + CW_CNT + 64 * l;
    int* toke = (int*)(F.ws + WS_TOKE); float* tokw = (float*)(F.ws + WS_TOKW);
    const float* rg = A.in[I_RG] + (size_t)l * 2048 * 4; const float* re = A.in[I_RE] + (size_t)l * 2048 * 32;
    for (int r = row_lo + gw; r < NTOK; r += NGW) {
        const bool isctx = r < NCTX;
        const float* xr = isctx ? xctx + (size_t)r * 2048 : xlat + (size_t)(r - NCTX) * 2048;
        const float* mod = modv_ptr(F, l, isctx ? 1 : 0);
        const float* shift = mod + (WHICH == 0 ? 0 : 3) * 2048; const float* scale = mod + (WHICH == 0 ? 1 : 4) * 2048;
        f32x4 v[8]; float ss = 0.f;
#pragma unroll
        for (int j = 0; j < 8; ++j) { v[j] = *(const f32x4*)(xr + 4 * F.lane + 256 * j); ss += (v[j].x * v[j].x + v[j].y * v[j].y) + (v[j].z * v[j].z + v[j].w * v[j].w); }
        const float rs = 1.0f / sqrtf(wave_sum(ss) * (1.f / 2048.f) + NEPS);
#pragma unroll
        for (int j = 0; j < 8; ++j) { const int c = 4 * F.lane + 256 * j;
            const f32x4 g = *(const f32x4*)(gain + c), sh = *(const f32x4*)(shift + c), sc = *(const f32x4*)(scale + c);
            v[j] = (v[j] * rs * g) * (sc + 1.0f) + sh;
            uint2 o; o.x = pk2(v[j].x, v[j].y); o.y = pk2(v[j].z, v[j].w);
            *(uint2*)(hb + (size_t)r * 2048 + c) = o; }
    }
}

__device__ __forceinline__ void ph_prep(const Frame& F, const ArgView& A, int l) {
    const int gw = F.bid * NWAVES + F.wave, NGW = F.G * NWAVES, lane = F.lane;
    const bf16* P = (const bf16*)(F.ws + WS_P);
    bf16* mix = (bf16*)(F.ws + WS_MIX);
    float* GQ = (float*)(F.ws + WS_GQ); float* GK = (float*)(F.ws + WS_GK); float* GV = (float*)(F.ws + WS_GV);
    float* GBETA = (float*)(F.ws + WS_GBETA); float* GDEC = (float*)(F.ws + WS_GDEC); float* LOGA = (float*)(F.ws + WS_LOGA);
    bf16* QR = (bf16*)(F.ws + WS_QR); bf16* KR = (bf16*)(F.ws + WS_KR);
    const float* small = (const float*)(F.ws + WS_SMALL);
    const float* scw = A.in[I_SCCONV] + l * 3 * 512; const float* gcw = A.in[I_GCONV] + l * 3 * 1536;
    const float* gup = A.in[I_LGUP] + l * 2 * 16 * 256; const float* gbias = A.in[I_LGBIAS] + l * 512;
    for (int r = gw; r < NTOK; r += NGW) {
        const bf16* pr = P + (size_t)r * PWP;
        const int seg_lo = r < NCTX ? 0 : NCTX, seg_hi = r < NCTX ? NCTX : NTOK;
        const bool hp = r > seg_lo, hn = r + 1 < seg_hi;
        const bf16* pm = hp ? pr - PWP : pr; const bf16* pn = hn ? pr + PWP : pr;
        { const int col = 8 * lane; float c0[8], x0[8], cm[8], xm[8], cn[8], xn[8], b[8], w0[8], w1[8], w2[8], y[8];
          load8(pr + C_SCC + col, c0); load8(pr + C_SCX + col, x0); load8(pr + C_SCB + col, b);
          load8(pm + C_SCC + col, cm); load8(pm + C_SCX + col, xm); load8(pn + C_SCC + col, cn); load8(pn + C_SCX + col, xn);
#pragma unroll
          for (int j = 0; j < 8; ++j) { w0[j] = scw[col + j]; w1[j] = scw[512 + col + j]; w2[j] = scw[1024 + col + j]; }
#pragma unroll
          for (int j = 0; j < 8; ++j) { const float um = hp ? cm[j] * xm[j] : 0.f, un = hn ? cn[j] * xn[j] : 0.f; y[j] = b[j] * (w0[j] * um + w1[j] * (c0[j] * x0[j]) + w2[j] * un); }
          *(v4u*)(mix + (size_t)r * 2048 + 512 + col) = pack8(y); }
    }
    asm volatile("" ::: "memory");
    for (int r = gw; r < NTOK; r += NGW) {
        const bf16* pr = P + (size_t)r * PWP;
        const int seg_lo = r < NCTX ? 0 : NCTX, seg_hi = r < NCTX ? NCTX : NTOK;
        const bool hp = r > seg_lo, hn = r + 1 < seg_hi;
        const bf16* pm = hp ? pr - PWP : pr; const bf16* pn = hn ? pr + PWP : pr;
#pragma unroll 1
        for (int part = 0; part < 3; ++part) { __builtin_amdgcn_sched_barrier(0); const int col = part * 512 + 8 * lane; float x0[8], xm[8], xn[8], y[8];
          load8(pr + C_GQKV + col, x0); load8(pm + C_GQKV + col, xm); load8(pn + C_GQKV + col, xn);
          float ss = 0.f;
#pragma unroll
          for (int j = 0; j < 8; ++j) { const float a = gcw[col + j] * (hp ? xm[j] : 0.f) + gcw[1536 + col + j] * x0[j] + gcw[3072 + col + j] * (hn ? xn[j] : 0.f); y[j] = siluf(a); ss += y[j] * y[j]; }
          if (part < 2) { ss += __shfl_xor(ss, 1); ss += __shfl_xor(ss, 2); ss += __shfl_xor(ss, 4); const float rs = 1.0f / sqrtf(ss + NEPS);
#pragma unroll
            for (int j = 0; j < 8; ++j) y[j] *= rs; }
          float* dst = (part == 0 ? GQ : part == 1 ? GK : GV) + (size_t)r * 512 + 8 * lane;
          *(f32x4*)dst = (f32x4){y[0], y[1], y[2], y[3]}; *(f32x4*)(dst + 4) = (f32x4){y[4], y[5], y[6], y[7]}; }
        if (lane < 16) { const float be = sigmoidf_(bf2f(pr[C_GBETA + lane])), al = bf2f(pr[C_GALPHA + lane]);
          const float g = -expf(A.in[I_GALOG][l * 16 + lane]) * softplusf_(al + A.in[I_GDT][l * 16 + lane]);
          GBETA[r * 16 + lane] = be; GDEC[r * 16 + lane] = g; }
    }
    asm volatile("" ::: "memory");
    for (int r = gw; r < NTOK; r += NGW) {
        const bf16* pr = P + (size_t)r * PWP;
        const int seg_lo = r < NCTX ? 0 : NCTX, seg_hi = r < NCTX ? NCTX : NTOK;
        const bool hp = r > seg_lo, hn = r + 1 < seg_hi;
        const bf16* pm = hp ? pr - PWP : pr; const bf16* pn = hn ? pr + PWP : pr;
        { const int dir = lane >> 5, c = (8 * lane) & 255; float lr[16];
          { float t0[8], t1[8]; load8(pr + C_LLR + dir * 16, t0); load8(pr + C_LLR + dir * 16 + 8, t1);
#pragma unroll
            for (int j = 0; j < 8; ++j) { lr[j] = t0[j]; lr[8 + j] = t1[j]; } }
          float z[8];
#pragma unroll
          for (int j = 0; j < 8; ++j) z[j] = gbias[dir * 256 + c + j];
#pragma unroll
          for (int q = 0; q < 16; ++q) { const float* gp = gup + (dir * 16 + q) * 256 + c; const f32x4 g0 = *(const f32x4*)gp, g1 = *(const f32x4*)(gp + 4);
            z[0] += lr[q] * g0.x; z[1] += lr[q] * g0.y; z[2] += lr[q] * g0.z; z[3] += lr[q] * g0.w; z[4] += lr[q] * g1.x; z[5] += lr[q] * g1.y; z[6] += lr[q] * g1.z; z[7] += lr[q] * g1.w; }
#pragma unroll
          for (int j = 0; j < 8; ++j) z[j] = -(softplusf_(-z[j])) * (1.0f / 16.0f);
          float* dst = LOGA + (size_t)r * 512 + 8 * lane;
          *(f32x4*)dst = (f32x4){z[0], z[1], z[2], z[3]}; *(f32x4*)(dst + 4) = (f32x4){z[4], z[5], z[6], z[7]}; }
    }
    asm volatile("" ::: "memory");
    for (int r = gw; r < NTOK; r += NGW) {
        const bf16* pr = P + (size_t)r * PWP;
        const int seg_lo = r < NCTX ? 0 : NCTX, seg_hi = r < NCTX ? NCTX : NTOK;
        const bool hp = r > seg_lo, hn = r + 1 < seg_hi;
        const bf16* pm = hp ? pr - PWP : pr; const bf16* pn = hn ? pr + PWP : pr;
#pragma unroll 1
        for (int which = 0; which < 2; ++which) { __builtin_amdgcn_sched_barrier(0); float x[8]; load8(pr + (which == 0 ? C_DQ : C_DK) + 8 * lane, x);
          float ss = 0.f;
#pragma unroll
          for (int j = 0; j < 8; ++j) ss += x[j] * x[j];
          ss += __shfl_xor(ss, 1); ss += __shfl_xor(ss, 2); ss += __shfl_xor(ss, 4);
          const float rs = 1.0f / sqrtf(ss * (1.f / 64.f) + NEPS); const int sub = lane & 7;
          const float* gn = A.in[which == 0 ? I_DQN : I_DKN] + l * 64 + 8 * sub;
#pragma unroll
          for (int j = 0; j < 8; ++j) x[j] = x[j] * rs * gn[j];
          if (r >= NCTX) { const int pos = r - NCTX, prow = pos >> 6, pcol = pos & 63, quarter = sub >> 1;
            const float* tab = quarter < 2 ? small + SM_ROPER / 4 + (prow * 16 + 8 * (sub & 1)) * 2 : small + SM_ROPEC / 4 + (pcol * 16 + 8 * (sub & 1)) * 2;
#pragma unroll
            for (int j = 0; j < 8; ++j) { const float partner = __shfl_xor(x[j], 2); const float cs = tab[2 * j], sn = tab[2 * j + 1];
              x[j] = (quarter & 1) ? x[j] * cs + partner * sn : x[j] * cs - partner * sn; } }
          if (which == 0) {
#pragma unroll
            for (int j = 0; j < 8; ++j) x[j] *= 0.18033688011112042f; }
          const int h = lane >> 4;
          *(v4u*)((which == 0 ? QR : KR) + ((size_t)h * NTOK + r) * 128 + 8 * (lane & 15)) = pack8(x); }
    }
    bf16* VT = (bf16*)(F.ws + WS_VT);
    LAS bf16* tl = (LAS bf16*)F.lds;
    for (int it = F.bid; it < 4 * (NTOK / 64); it += F.G) {
        const int h = it / (NTOK / 64), key0 = (it % (NTOK / 64)) * 64;
#pragma unroll
        for (int i = 0; i < 2; ++i) { const int id = F.tid + 512 * i, key = id >> 4, dvc = id & 15;
            const v4u v = *(const v4u*)(P + (size_t)(key0 + key) * PWP + C_DV + h * 128 + 8 * dvc);
            const int k16 = key & 15, pos = (key & ~15) | ((k16 >= 4 && k16 < 8) ? k16 + 4 : (k16 >= 8 && k16 < 12) ? k16 - 4 : k16);
#pragma unroll
            for (int j = 0; j < 4; ++j) { tl[(8 * dvc + 2 * j) * 72 + pos] = (bf16)(v[j] & 0xffffu); tl[(8 * dvc + 2 * j + 1) * 72 + pos] = (bf16)(v[j] >> 16); } }
        __syncthreads();
#pragma unroll
        for (int i = 0; i < 2; ++i) { const int id = F.tid + 512 * i, dv = id >> 3, ch = id & 7;
            const v4u v = *(const LAS v4u*)(tl + dv * 72 + 8 * ch);
            *(v4u*)(VT + ((size_t)h * 128 + dv) * NTOK + key0 + 8 * ch) = v; }
        __syncthreads();
    }
}

__device__ __forceinline__ float rdl(float v, int i) { return __builtin_bit_cast(float, __builtin_amdgcn_readlane(__builtin_bit_cast(int, v), i)); }
__device__ __forceinline__ void gdn_seq_chain(const Frame& F, int h, int d) {
    const float* GQ = (const float*)(F.ws + WS_GQ); const float* GK = (const float*)(F.ws + WS_GK); const float* GV = (const float*)(F.ws + WS_GV);
    const float* GBETA = (const float*)(F.ws + WS_GBETA); const float* GDEC = (const float*)(F.ws + WS_GDEC);
    float* OG = (float*)(F.ws + WS_OGDN) + (size_t)d * NTOK * 512;
    const int lane = F.lane;
    float S[64];
#pragma unroll
    for (int i = 0; i < 64; ++i) S[i] = 0.f;
    auto rowof = [&](int step) { return d == 0 ? step : (step < NCTX ? NCTX - 1 - step : NTOK - 1 - (step - NCTX)); };
    int r = rowof(0);
    float nk = GK[(size_t)r * 512 + h * 64 + lane], nq = GQ[(size_t)r * 512 + h * 64 + lane], nv = GV[(size_t)r * 512 + h * 64 + lane], ng = GDEC[r * 16 + d * 8 + h], nb = GBETA[r * 16 + d * 8 + h];
    for (int step = 0; step < NTOK; ++step) {
        const float kk = nk, qq = nq, vv = nv, g = ng, b = nb; const int rc = r;
        if (step + 1 < NTOK) { r = rowof(step + 1);
            nk = GK[(size_t)r * 512 + h * 64 + lane]; nq = GQ[(size_t)r * 512 + h * 64 + lane]; nv = GV[(size_t)r * 512 + h * 64 + lane]; ng = GDEC[r * 16 + d * 8 + h]; nb = GBETA[r * 16 + d * 8 + h]; }
        const float eg = __expf(g);
        float ks = 0.f;
#pragma unroll
        for (int i = 0; i < 64; ++i) ks += rdl(kk, i) * S[i];
        const float vn = b * (vv - eg * ks);
        float o = 0.f;
#pragma unroll
        for (int i = 0; i < 64; ++i) { S[i] = eg * S[i] + rdl(kk, i) * vn; o += rdl(qq, i) * S[i]; }
        OG[(size_t)rc * 512 + h * 64 + lane] = o * 0.125f;
    }
}
__device__ __forceinline__ void gla_seq_chain(const Frame& F, int h, int d, int half) {
    const bf16* P = (const bf16*)(F.ws + WS_P); const float* LOGA = (const float*)(F.ws + WS_LOGA);
    float* OL = (float*)(F.ws + WS_OGLA) + (size_t)d * NTOK * 512;
    const int lane = F.lane;
    float S[64];
#pragma unroll
    for (int i = 0; i < 64; ++i) S[i] = 0.f;
    auto rowof = [&](int step) { return d == 0 ? step : (step < NCTX ? NCTX - 1 - step : NTOK - 1 - (step - NCTX)); };
    int r = rowof(0);
    float na = LOGA[(size_t)r * 512 + d * 256 + h * 64 + lane]; unsigned short nk = P[(size_t)r * PWP + C_LK + h * 64 + lane], nq = P[(size_t)r * PWP + C_LQ + h * 64 + lane], nv = P[(size_t)r * PWP + C_LV + h * 128 + half * 64 + lane];
    for (int step = 0; step < NTOK; ++step) {
        const float a = __expf(na), kk = bf2f(nk), qq = bf2f(nq) * 0.125f, vv = bf2f(nv); const int rc = r;
        if (step + 1 < NTOK) { r = rowof(step + 1);
            na = LOGA[(size_t)r * 512 + d * 256 + h * 64 + lane]; nk = P[(size_t)r * PWP + C_LK + h * 64 + lane]; nq = P[(size_t)r * PWP + C_LQ + h * 64 + lane]; nv = P[(size_t)r * PWP + C_LV + h * 128 + half * 64 + lane]; }
        float o = 0.f;
#pragma unroll
        for (int i = 0; i < 64; ++i) { S[i] = rdl(a, i) * S[i] + rdl(kk, i) * vv; o += rdl(qq, i) * S[i]; }
        OL[(size_t)rc * 512 + h * 128 + half * 64 + lane] = o;
    }
}

constexpr int ATT_BUF = 24576;
__device__ __forceinline__ int att_swz(int row) { return ((row >> 1) & 1) | (((row >> 3) & 1) << 1) | (((row >> 4) & 1) << 2); }
__device__ __forceinline__ int fresh_lane() { int l_; asm volatile("v_mbcnt_lo_u32_b32 %0, -1, 0\n\tv_mbcnt_hi_u32_b32 %0, -1, %0" : "=v"(l_)); return l_; }
__device__ __forceinline__ void attn_unit(const Frame& F, const ArgView& A, int l, int h, int qrow0, int ntiles) {
    const bf16* QRh = (const bf16*)(F.ws + WS_QR) + (size_t)h * NTOK * 128; const bf16* KRh = (const bf16*)(F.ws + WS_KR) + (size_t)h * NTOK * 128;
    const bf16* VTh = (const bf16*)(F.ws + WS_VT) + (size_t)h * 128 * NTOK;
    const int w = F.wave;
    LAS unsigned char* lds = F.lds;
#pragma unroll 1
    for (int c = 0; c < 2; ++c) {
        bf16x8 qf[4]; int foff[4];
        { const int ln = fresh_lane(), l31 = ln & 31, hh = ln >> 5; const unsigned qoff = (unsigned)((qrow0 + 32 * w + l31) * 128 + 8 * hh) + 64u * c;
#pragma unroll
          for (int ks = 0; ks < 4; ++ks) { qf[ks] = *(const bf16x8*)(QRh + (qoff + 16u * ks)); foff[ks] = l31 * 128 + (((2 * ks + hh) ^ att_swz(l31)) << 4); } }
        f32x16 O[4];
        float zf_ = 0.f; asm volatile("" : "+v"(zf_));
#pragma unroll
        for (int mv = 0; mv < 4; ++mv)
#pragma unroll
            for (int i = 0; i < 16; ++i) O[mv][i] = zf_;
        float lsum = zf_;
        __syncthreads();
        { const int tl = w * 64 + fresh_lane(), kr = tl >> 3, kl = (tl & 7) ^ att_swz(kr);
          const unsigned kx = (unsigned)(kr * 128 + 8 * kl) + 64u * c, vx = (unsigned)(kr * NTOK + 8 * kl);
          const v4u k0 = *(const v4u*)(KRh + kx), v0 = *(const v4u*)(VTh + vx), v1 = *(const v4u*)(VTh + (vx + 64u * NTOK));
          *(LAS v4u*)(lds + tl * 16) = k0; *(LAS v4u*)(lds + 8192 + tl * 16) = v0; *(LAS v4u*)(lds + 16384 + tl * 16) = v1; }
        __syncthreads();
        bf16x8 pfp[2];
#pragma unroll
        for (int s = 0; s < 2; ++s) pfp[s] = __builtin_bit_cast(bf16x8, (v4u){0u, 0u, 0u, 0u});
        int vprev = 8192;
        int cur = 0;
#pragma unroll 1
        for (int t = 0; t < ntiles; ++t) {
            const int nxt = cur == 2 * ATT_BUF ? 0 : cur + ATT_BUF;
            v4u sk, sv0, sv1;
            {
                const int tn = t + 1 < ntiles ? t + 1 : t; const int tl = w * 64 + fresh_lane(), kr = tl >> 3, kl = (tl & 7) ^ att_swz(kr);
                const unsigned kx = (unsigned)(kr * 128 + 8 * kl) + 64u * c + (unsigned)tn * 8192u, vx = (unsigned)(kr * NTOK + 8 * kl) + (unsigned)tn * 64u;
                sk = *(const v4u*)(KRh + kx); sv0 = *(const v4u*)(VTh + vx); sv1 = *(const v4u*)(VTh + (vx + 64u * NTOK)); }
#pragma unroll
            for (int mt = 0; mt < 2; ++mt) {
                f32x16 S;
#pragma unroll
                for (int i = 0; i < 16; ++i) S[i] = 0.f;
#pragma unroll
                for (int ks = 0; ks < 4; ++ks) {
                    const bf16x8 kf = *(const LAS bf16x8*)(lds + cur + mt * 4096 + foff[ks]);
                    S = __builtin_amdgcn_mfma_f32_32x32x16_bf16(kf, qf[ks], S, 0, 0, 0);
                }
#pragma unroll
                for (int sp = 0; sp < 2; ++sp)
#pragma unroll
                    for (int mv = 0; mv < 4; ++mv) {
                        const bf16x8 vf = *(const LAS bf16x8*)(lds + vprev + mv * 4096 + foff[2 * (1 - mt) + sp]);
                        O[mv] = __builtin_amdgcn_mfma_f32_32x32x16_bf16(vf, pfp[sp], O[mv], 0, 0, 0);
                    }
                __builtin_amdgcn_sched_barrier(0);
#pragma unroll
                for (int s = 0; s < 2; ++s) {
                    unsigned w0[4];
#pragma unroll
                    for (int j = 0; j < 4; ++j) {
                        const float a0 = __builtin_amdgcn_exp2f(S[8 * s + 2 * j]), a1 = __builtin_amdgcn_exp2f(S[8 * s + 2 * j + 1]);
                        lsum += a0 + a1;
                        w0[j] = pg8::cvt_pk_bf16(a0, a1);
                    }
                    pfp[s] = __builtin_bit_cast(bf16x8, (v4u){w0[0], w0[1], w0[2], w0[3]});
                }
                vprev = cur + 8192;
                __builtin_amdgcn_sched_barrier(0);
            }
            { const int tl = w * 64 + fresh_lane();
                *(LAS v4u*)(lds + nxt + tl * 16) = sk; *(LAS v4u*)(lds + nxt + 8192 + tl * 16) = sv0; *(LAS v4u*)(lds + nxt + 16384 + tl * 16) = sv1; }
            __syncthreads();
            cur = nxt;
        }
#pragma unroll
        for (int sp = 0; sp < 2; ++sp)
#pragma unroll
            for (int mv = 0; mv < 4; ++mv) {
                const bf16x8 vf = *(const LAS bf16x8*)(lds + vprev + mv * 4096 + foff[2 + sp]);
                O[mv] = __builtin_amdgcn_mfma_f32_32x32x16_bf16(vf, pfp[sp], O[mv], 0, 0, 0);
            }
        lsum += __shfl_xor(lsum, 32);
        const float inv = 1.0f / lsum;
        const int ln = fresh_lane(), l31 = ln & 31, hh = ln >> 5;
        float* park = (float*)(F.ws + WS_PARK) + ((size_t)F.bid * NWAVES + w) * 4096 + ln * 4;
        if (c == 0) {
#pragma unroll
            for (int mv = 0; mv < 4; ++mv)
#pragma unroll
                for (int g = 0; g < 4; ++g) *(f32x4*)(park + (mv * 4 + g) * 256) = (f32x4){O[mv][4 * g] * inv, O[mv][4 * g + 1] * inv, O[mv][4 * g + 2] * inv, O[mv][4 * g + 3] * inv};
        } else {
            const float lam = ((const float*)(F.ws + WS_SMALL))[SM_LAM / 4 + l];
            const float post = 1.0f - (0.8f - 0.6f * expf(-0.3f * (float)l));
            const float* onorm = A.in[I_DON] + l * 128;
            float ssq = 0.f;
#pragma unroll
            for (int mv = 0; mv < 4; ++mv)
#pragma unroll
                for (int g = 0; g < 4; ++g) { const f32x4 o0 = *(const f32x4*)(park + (mv * 4 + g) * 256);
#pragma unroll
                    for (int j = 0; j < 4; ++j) { const float o = o0[j] - lam * O[mv][4 * g + j] * inv; O[mv][4 * g + j] = o; ssq += o * o; } }
            ssq += __shfl_xor(ssq, 32);
            const float rs = post / sqrtf(ssq * (1.f / 128.f) + NEPS);
            bf16* orow = (bf16*)(F.ws + WS_MIX) + 1536 + h * 128 + (size_t)(qrow0 + 32 * w + l31) * 2048;
#pragma unroll
            for (int mv = 0; mv < 4; ++mv)
#pragma unroll
                for (int g = 0; g < 4; ++g) { const int dv = 32 * mv + 8 * g + 4 * hh; const f32x4 gn = *(const f32x4*)(onorm + dv);
                    uint2 o; o.x = pk2(O[mv][4 * g] * rs * gn.x, O[mv][4 * g + 1] * rs * gn.y); o.y = pk2(O[mv][4 * g + 2] * rs * gn.z, O[mv][4 * g + 3] * rs * gn.w);
                    *(uint2*)(orow + dv) = o; }
        }
    }
}

#ifndef MIX_ONLY
#define MIX_ONLY 0
#endif
__device__ __forceinline__ void ph_mix(const Frame& F0, const ArgView& A, int l) {
    Frame F = F0;
#ifdef SEQ_SCANS
    if (MIX_ONLY == 0 || MIX_ONLY == 1) if (F.bid < 16) { if (F.wave == 0) gdn_seq_chain(F, F.bid & 7, F.bid >> 3); }
    if (MIX_ONLY == 0 || MIX_ONLY == 2) if (F.bid >= 16 && F.bid < 32) { const int b = F.bid - 16; if (F.wave == 0) gla_seq_chain(F, b & 3, (b >> 2) & 1, b >> 3); }
#endif
    if (MIX_ONLY == 0 || MIX_ONLY == 3) {
    { int l_; asm volatile("v_mbcnt_lo_u32_b32 %0, -1, 0\n\tv_mbcnt_hi_u32_b32 %0, -1, %0" : "=v"(l_)); F.lane = l_; F.tid = F.wave * 64 + l_; }
    const int ctxu = (l == 0 && F.bid >= F.G - 4) ? 256 + (F.G - 1 - F.bid) : -1;
    int u = F.bid < 256 ? F.bid : ctxu;
#pragma unroll 1
    while (u >= 0) {
        const bool lat = u < 256; const int h = lat ? (u & 7) >> 1 : u - 256, qb = (u >> 3) * 2 + (u & 1);
        attn_unit(F, A, l, h, lat ? NCTX + 256 * qb : 0, lat ? NTOK / 64 : NCTX / 64);
        if (lat) { u += F.G; if (u >= 256) u = ctxu; } else u = -1; }
    }
}

__device__ __forceinline__ void ph_post(const Frame& F, const ArgView& A, int l, int row_lo) {
    const int gw = F.bid * NWAVES + F.wave, NGW = F.G * NWAVES, lane = F.lane;
    const bf16* P = (const bf16*)(F.ws + WS_P); bf16* mix = (bf16*)(F.ws + WS_MIX);
    const float* OG = (const float*)(F.ws + WS_OGDN); const float* OL = (const float*)(F.ws + WS_OGLA);
    const float* gon = A.in[I_GONORM] + l * 64 + 8 * (lane & 7); const float* lon = A.in[I_LONORM] + l * 128 + 8 * (lane & 15);
    for (int r = row_lo + gw; r < NTOK; r += NGW) {
        { const float* a = OG + (size_t)r * 512 + 8 * lane; const float* b = a + (size_t)NTOK * 512; float o[8], g[8];
          const f32x4 a0 = *(const f32x4*)a, a1 = *(const f32x4*)(a + 4), b0 = *(const f32x4*)b, b1 = *(const f32x4*)(b + 4);
          o[0] = a0.x + b0.x; o[1] = a0.y + b0.y; o[2] = a0.z + b0.z; o[3] = a0.w + b0.w; o[4] = a1.x + b1.x; o[5] = a1.y + b1.y; o[6] = a1.z + b1.z; o[7] = a1.w + b1.w;
          float ss = 0.f;
#pragma unroll
          for (int j = 0; j < 8; ++j) ss += o[j] * o[j];
          ss += __shfl_xor(ss, 1); ss += __shfl_xor(ss, 2); ss += __shfl_xor(ss, 4);
          const float rs = 1.0f / sqrtf(ss * (1.f / 64.f) + NEPS);
          load8(P + (size_t)r * PWP + C_GGATE + 8 * lane, g);
#pragma unroll
          for (int j = 0; j < 8; ++j) o[j] = o[j] * rs * gon[j] * siluf(g[j]);
          *(v4u*)(mix + (size_t)r * 2048 + 8 * lane) = pack8(o); }
        { const float* a = OL + (size_t)r * 512 + 8 * lane; const float* b = a + (size_t)NTOK * 512; float o[8], g[8];
          const f32x4 a0 = *(const f32x4*)a, a1 = *(const f32x4*)(a + 4), b0 = *(const f32x4*)b, b1 = *(const f32x4*)(b + 4);
          o[0] = a0.x + b0.x; o[1] = a0.y + b0.y; o[2] = a0.z + b0.z; o[3] = a0.w + b0.w; o[4] = a1.x + b1.x; o[5] = a1.y + b1.y; o[6] = a1.z + b1.z; o[7] = a1.w + b1.w;
          float ss = 0.f;
#pragma unroll
          for (int j = 0; j < 8; ++j) ss += o[j] * o[j];
          ss += __shfl_xor(ss, 1); ss += __shfl_xor(ss, 2); ss += __shfl_xor(ss, 4); ss += __shfl_xor(ss, 8);
          const float rs = 1.0f / sqrtf(ss * (1.f / 128.f) + NEPS);
          load8(P + (size_t)r * PWP + C_LR + 8 * lane, g);
#pragma unroll
          for (int j = 0; j < 8; ++j) o[j] = o[j] * rs * lon[j] * siluf(g[j]);
          *(v4u*)(mix + (size_t)r * 2048 + 1024 + 8 * lane) = pack8(o); }
#ifdef MIX_KEEP
        { unsigned zu_ = 0u; asm volatile("" : "+v"(zu_));
#pragma unroll
          for (int gq = 0; gq < 4; ++gq) if (gq != MIX_KEEP) *(v4u*)(mix + (size_t)r * 2048 + gq * 512 + 8 * lane) = (v4u){zu_, zu_, zu_, zu_}; }
#endif
    }
}

__device__ __forceinline__ void ph_assign(const Frame& F, int l, int row_lo) {
    const int lane = F.lane, w = F.wave, e = F.bid;
    if (e >= NEXP) return;
    const unsigned* cnt = F.ctl + CW_CNT + 64 * l;
    const int* toke = (const int*)(F.ws + WS_TOKE); int* toks = (int*)(F.ws + WS_TOKS);
    LAS unsigned* wc = (LAS unsigned*)F.lds;
    const int n64 = (NTOK - row_lo) * 2 / 64, per = (n64 + NWAVES - 1) / NWAVES, b0 = w * per, b1 = (b0 + per < n64) ? b0 + per : n64;
    unsigned c = 0;
    for (int b = b0; b < b1; ++b) c += (unsigned)__popcll(__ballot(toke[row_lo * 2 + b * 64 + lane] == e));
    if (lane == 0) wc[w] = c;
    __syncthreads();
    unsigned pos = 0;
    for (int q = 0; q < e; ++q) pos += (__hip_atomic_load(cnt + q, __ATOMIC_RELAXED, __HIP_MEMORY_SCOPE_AGENT) + 255u) & ~255u;
    for (int q = 0; q < w; ++q) pos += wc[q];
    for (int b = b0; b < b1; ++b) { const int idx = row_lo * 2 + b * 64 + lane; const bool m = toke[idx] == e;
        const unsigned long long mask = __ballot(m);
        if (m) toks[idx] = (int)(pos + (unsigned)__popcll(mask & ((1ull << lane) - 1ull)));
        pos += (unsigned)__popcll(mask); }
}
__device__ __forceinline__ void ph_route(const Frame& F, int l, int row_lo) {
    const int gw = F.bid * NWAVES + F.wave, NGW = F.G * NWAVES, lane = F.lane;
    const int* toks = (const int*)(F.ws + WS_TOKS);
    const bf16* hb = (const bf16*)(F.ws + WS_HBUF); bf16* am = (bf16*)(F.ws + WS_AMOE);
    for (int t = row_lo + gw; t < NTOK; t += NGW) {
        const int s0 = toks[t * 2], s1 = toks[t * 2 + 1];
        const v4u* src = (const v4u*)(hb + (size_t)t * 2048); v4u* d0 = (v4u*)(am + (size_t)s0 * 2048); v4u* d1 = (v4u*)(am + (size_t)s1 * 2048);
#pragma unroll
        for (int j = 0; j < 4; ++j) { const v4u v = src[lane + 64 * j]; d0[lane + 64 * j] = v; d1[lane + 64 * j] = v; }
    }
}
__device__ __forceinline__ void build_tile_table(const Frame& F, int l) {
    LAS int* tab = (LAS int*)(F.lds + TILE_TAB_OFF);
    if (F.tid == 0) { const unsigned* cnt = F.ctl + CW_CNT + 64 * l; int nt = 0;
        for (int e = 0; e < NEXP; ++e) { const int k = (int)((__hip_atomic_load(cnt + e, __ATOMIC_RELAXED, __HIP_MEMORY_SCOPE_AGENT) + 255u) >> 8); for (int j = 0; j < k && nt < MAXSLOT / 256; ++j) tab[1 + nt++] = e; }
        tab[0] = nt; }
    __syncthreads();
}
struct GroupedOrder {
    const LAS int* tab; int nN, G, c, nunits; size_t a_tstep, b_estride, b_tstep;
    __device__ void init(const LAS int* tab_, int nN_, int K, int nrows_per_expert, int G_, int c_) { tab = tab_; nN = nN_; G = G_; c = c_; nunits = tab_[0] * nN_;
        a_tstep = (size_t)256 * K * 2; b_tstep = a_tstep; b_estride = (size_t)nrows_per_expert * K * 2; }
    __device__ bool next(int i, pg8::Unit& u) const {
        const int L = i * G + c; if (L >= nunits) return false;
        const int tile = L / nN; u.pm = tile; u.pn = L % nN; const int e = tab[1 + tile];
        u.aoff = (size_t)tile * a_tstep; u.boff = (size_t)e * b_estride + (size_t)u.pn * b_tstep; return true; }
    __device__ __forceinline__ void a_ready(const pg8::Unit&) const {}
    __device__ __forceinline__ void done(const pg8::Unit&) const {}
};
template <class Base> struct OneUnit {
    const Base& B; int i0;
    __device__ bool next(int i, pg8::Unit& u) const { return i == 0 ? B.next(i0, u) : false; }
    __device__ __forceinline__ void a_ready(const pg8::Unit&) const {}
    __device__ __forceinline__ void done(const pg8::Unit&) const {}
};
__device__ __forceinline__ void ph_combine(const Frame& F, int l, int row_lo) {
    const int gw = F.bid * NWAVES + F.wave, NGW = F.G * NWAVES, lane = F.lane;
    const int* toks = (const int*)(F.ws + WS_TOKS); const float* tokw = (const float*)(F.ws + WS_TOKW);
    const bf16* Y = (const bf16*)(F.ws + WS_YMOE);
    for (int t = row_lo + gw; t < NTOK; t += NGW) {
        const bool isctx = t < NCTX;
        float* dst = isctx ? (float*)(F.ws + WS_XCTX) + (size_t)t * 2048 : F.out + (size_t)(t - NCTX) * 2048;
        const float* gate = modv_ptr(F, l, isctx ? 1 : 0) + 5 * 2048;
        const int s0 = toks[t * 2], s1 = toks[t * 2 + 1]; const float w0 = tokw[t * 2], w1 = tokw[t * 2 + 1];
#pragma unroll
        for (int j = 0; j < 4; ++j) { const int c = 8 * (lane + 64 * j); float a[8], b[8];
#ifdef TEST_H
            if (j > 0) continue;
            load8((const bf16*)(F.ws + WS_HMOE) + (size_t)s0 * 512 + c, a); load8((const bf16*)(F.ws + WS_HMOE) + (size_t)s1 * 512 + c, b);
#else
            load8(Y + (size_t)s0 * 2048 + c, a); load8(Y + (size_t)s1 * 2048 + c, b);
#endif
            f32x4 d0 = *(f32x4*)(dst + c), d1 = *(f32x4*)(dst + c + 4); const f32x4 g0 = *(const f32x4*)(gate + c), g1 = *(const f32x4*)(gate + c + 4);
            d0.x += g0.x * (w0 * a[0] + w1 * b[0]); d0.y += g0.y * (w0 * a[1] + w1 * b[1]); d0.z += g0.z * (w0 * a[2] + w1 * b[2]); d0.w += g0.w * (w0 * a[3] + w1 * b[3]);
            d1.x += g1.x * (w0 * a[4] + w1 * b[4]); d1.y += g1.y * (w0 * a[5] + w1 * b[5]); d1.z += g1.z * (w0 * a[6] + w1 * b[6]); d1.w += g1.w * (w0 * a[7] + w1 * b[7]);
            *(f32x4*)(dst + c) = d0; *(f32x4*)(dst + c + 4) = d1; }
    }
}

template <class Sched>
__device__ __forceinline__ void sgemm_bf16out(const Frame& F, const bf16* A, const bf16* Bt, int K, const Sched& S, bf16* O, int ldc) {
    const int lane = F.lane, w = F.wave, tid = F.tid, l31 = lane & 31, hh = lane >> 5, wm = w >> 2, wn = w & 3;
    LAS unsigned char* lds = F.lds;
    const int nt = K / 64;
    int foff[4];
#pragma unroll
    for (int ks = 0; ks < 4; ++ks) foff[ks] = l31 * 128 + (((2 * ks + hh) ^ att_swz(l31)) << 4);
    pg8::Unit u;
#pragma unroll 1
    for (int ui = 0; S.next(ui, u); ++ui) {
        const bf16* Au = (const bf16*)((const char*)A + u.aoff); const bf16* Bu = (const bf16*)((const char*)Bt + u.boff);
        f32x16 acc[4][2];
        float zf_ = 0.f; asm volatile("" : "+v"(zf_));
#pragma unroll
        for (int a = 0; a < 4; ++a)
#pragma unroll
            for (int b = 0; b < 2; ++b)
#pragma unroll
                for (int i = 0; i < 16; ++i) acc[a][b][i] = zf_;
        __syncthreads();
#pragma unroll
        for (int i = 0; i < 4; ++i) { const int id = tid + 512 * i, row = id >> 3, lg = (id & 7) ^ (row & 7); const unsigned so = (unsigned)(row * K + 8 * lg);
            __builtin_amdgcn_global_load_lds((const unsigned*)(Au + so), (LAS unsigned*)(lds + (w * 64 + 512 * i) * 16), 16, 0, 0);
            __builtin_amdgcn_global_load_lds((const unsigned*)(Bu + so), (LAS unsigned*)(lds + 32768 + (w * 64 + 512 * i) * 16), 16, 0, 0); }
        VM_WAIT(); __syncthreads();
#pragma unroll 1
        for (int t = 0; t < nt; ++t) {
            const int cur = (t & 1) * 65536, nxt = 65536 - cur;
            if (t + 1 < nt) { int tl = tid; asm volatile("" : "+v"(tl));
#pragma unroll
                for (int i = 0; i < 4; ++i) { const int id = tl + 512 * i, row = id >> 3, lg = (id & 7) ^ (row & 7); const unsigned so = (unsigned)(row * K + 8 * lg + 64 * (t + 1));
                    __builtin_amdgcn_global_load_lds((const unsigned*)(Au + so), (LAS unsigned*)(lds + nxt + (w * 64 + 512 * i) * 16), 16, 0, 0);
                    __builtin_amdgcn_global_load_lds((const unsigned*)(Bu + so), (LAS unsigned*)(lds + nxt + 32768 + (w * 64 + 512 * i) * 16), 16, 0, 0); } }
#pragma unroll
            for (int ks = 0; ks < 4; ++ks) {
                bf16x8 af[4], bfr[2];
#pragma unroll
                for (int a = 0; a < 4; ++a) af[a] = *(const LAS bf16x8*)(lds + cur + (wm * 128 + a * 32) * 128 + foff[ks]);
#pragma unroll
                for (int b = 0; b < 2; ++b) bfr[b] = *(const LAS bf16x8*)(lds + cur + 32768 + (wn * 64 + b * 32) * 128 + foff[ks]);
#pragma unroll
                for (int a = 0; a < 4; ++a)
#pragma unroll
                    for (int b = 0; b < 2; ++b) acc[a][b] = __builtin_amdgcn_mfma_f32_32x32x16_bf16(bfr[b], af[a], acc[a][b], 0, 0, 0);
            }
            VM_WAIT(); __syncthreads();
        }
#pragma unroll
        for (int a = 0; a < 4; ++a) { bf16* orow = O + (size_t)(u.pm * 256 + wm * 128 + a * 32 + l31) * ldc + u.pn * 256 + wn * 64;
#pragma unroll
            for (int b = 0; b < 2; ++b)
#pragma unroll
                for (int g = 0; g < 4; ++g) { uint2 o; o.x = pg8::cvt_pk_bf16(acc[a][b][4 * g], acc[a][b][4 * g + 1]); o.y = pg8::cvt_pk_bf16(acc[a][b][4 * g + 2], acc[a][b][4 * g + 3]);
                    *(uint2*)(orow + 32 * b + 8 * g + 4 * hh) = o; } }
    }
}

constexpr int CH = 64, NCHUNK = NTOK / CH, NCTXCH = NCTX / CH;
typedef unsigned v2u __attribute__((ext_vector_type(2)));
typedef __bf16 bf2_t __attribute__((ext_vector_type(2))); typedef float f2_t __attribute__((ext_vector_type(2)));
__device__ __forceinline__ unsigned cvt2(float a, float b) { const f2_t v = {a, b}; return __builtin_bit_cast(unsigned, __builtin_convertvector(v, bf2_t)); }
constexpr int LS = 65;
constexpr int LS2 = 129;
template <class FA, class FB> __device__ __forceinline__ f32x16 mm32(FA a, FB b, int K, int l31, int hh) {
    f32x16 acc;
#pragma unroll
    for (int i = 0; i < 16; ++i) acc[i] = 0.f;
#pragma unroll 8
    for (int k = 0; k < K; k += 2) acc = __builtin_amdgcn_mfma_f32_32x32x2f32(a(l31, k + hh), b(k + hh, l31), acc, 0, 0, 0);
    return acc;
}
template <class FA, class FB> __device__ __forceinline__ f32x16 mm32b(FA a, FB b, int K, int l31, int hh) {
    f32x16 acc;
#pragma unroll
    for (int i = 0; i < 16; ++i) acc[i] = 0.f;
#pragma unroll 2
    for (int k = 0; k < K; k += 16) { const int k0 = k + 8 * hh;
        v4u af, bf;
#pragma unroll
        for (int j = 0; j < 4; ++j) { af[j] = pg8::cvt_pk_bf16(a(l31, k0 + 2 * j), a(l31, k0 + 2 * j + 1)); bf[j] = pg8::cvt_pk_bf16(b(k0 + 2 * j, l31), b(k0 + 2 * j + 1, l31)); }
        acc = __builtin_amdgcn_mfma_f32_32x32x16_bf16(__builtin_bit_cast(bf16x8, af), __builtin_bit_cast(bf16x8, bf), acc, 0, 0, 0); }
    return acc;
}
#ifndef MM32
#define MM32 mm32b
#endif
#define GBF(i, j) ((((j) >> 4) * 4 + ((i) >> 4)) * 256 + ((((i) & 15) >> 2) * 16 + ((j) & 15)) * 4 + ((i) & 3))
#define KPERM(j) (16 * (2 * ((j) >> 5) + (((j) >> 3) & 1)) + 8 * (((j) >> 2) & 1) + 4 * (((j) >> 4) & 1) + ((j) & 3))
#define ACC_ROW(r, hh) (((r) & 3) + 8 * ((r) >> 2) + 4 * (hh))

__device__ __forceinline__ size_t gdn_slot(int d, int h, int n) { return ((size_t)(d * 8 + h) * NCHUNK + n) * 4096; }
__device__ __forceinline__ void ph_gdn_a(const Frame& F, int l, bool skip_solve = false) {
    const float* GQ = (const float*)(F.ws + WS_GQ); const float* GK = (const float*)(F.ws + WS_GK); const float* GV = (const float*)(F.ws + WS_GV);
    const float* GBETA = (const float*)(F.ws + WS_GBETA); const float* GDEC = (const float*)(F.ws + WS_GDEC);
    v2u* GB = (v2u*)(F.ws + WS_GB); bf16* GQP = (bf16*)(F.ws + WS_GQP); bf16* GOP = (bf16*)(F.ws + WS_GOP);
    LAS float* Qs = (LAS float*)F.lds; LAS float* Ks = Qs + 64 * LS; LAS float* Vs = Ks + 64 * LS; LAS float* As = Vs + 64 * LS; LAS float* Us = As + 64 * LS; LAS float* Ws = Us + 64 * LS;
    LAS float* Lt = Ws + 64 * LS;
    LAS float* Gv0 = Lt + 64 * 68;
    LAS float* misc = Gv0 + 512;
    LAS float* Dinv = misc + 16;
    const int tid = F.tid, lane = F.lane, w = F.wave, l31 = lane & 31, hh = lane >> 5;
#pragma unroll 1
    for (int unit = F.bid; unit < NCHUNK * 8; unit += F.G) {
        const int n = unit >> 3, h = unit & 7, r0 = n * CH;
        __syncthreads();
        {
            float tq[8], tk[8], tv[8];
#pragma unroll
            for (int q = 0; q < 8; ++q) { const int e = tid + NTHR * q, i = e >> 6, c = e & 63; const size_t g = (size_t)(r0 + i) * 512 + h * 64 + c; tq[q] = GQ[g]; tk[q] = GK[g]; tv[q] = GV[g]; }
#pragma unroll
            for (int q = 0; q < 8; ++q) { const int e = tid + NTHR * q, i = e >> 6, c = e & 63; Qs[i * LS + c] = tq[q] * 0.125f; Ks[i * LS + c] = tk[q]; Vs[i * LS + c] = tv[q]; } }
        if (w < 2) {
            const int d = w; LAS float* Gv = Gv0 + 256 * d;
            const int i = d ? 63 - lane : lane; float g = GDEC[(size_t)(r0 + i) * 16 + d * 8 + h];
#pragma unroll
            for (int o = 1; o < 64; o <<= 1) { const float t = __shfl_up(g, o); if (lane >= o) g += t; }
            const float gl = __shfl(g, 63);
            Gv[i] = g; Gv[64 + i] = __expf(g); Gv[128 + i] = __expf(gl - g); Gv[192 + i] = GBETA[(size_t)(r0 + i) * 16 + d * 8 + h];
            if (lane == 0) misc[d] = __expf(gl);
        }
#pragma unroll 1
        for (int d = 0; d < 2; ++d) {
            LAS float* Gv = Gv0 + 256 * d; LAS float* EGv = Gv + 64; LAS float* Fv = Gv + 128; LAS float* Bv = Gv + 192;
            __syncthreads();
            {
                const int t = w & 3, ti = t >> 1, tj = t & 1; const bool isq = w >= 4; LAS float* X = isq ? Qs : Ks;
                const f32x16 acc = MM32([&](int i, int k) { return X[(32 * ti + i) * LS + k]; }, [&](int k, int j) { return Ks[(32 * tj + j) * LS + k]; }, 64, l31, hh);
                const int j = 32 * tj + l31; const float gj = Gv[j];
#pragma unroll
                for (int r = 0; r < 16; ++r) { const int i = 32 * ti + ACC_ROW(r, hh); const float gi = Gv[i];
                    const bool before = d ? (j > i) : (j < i); const float dec = (before || i == j) ? __expf(gi - gj) : 0.f;
                    if (isq) As[i * LS + j] = acc[r] * dec;
                    else { const int is = d ? 63 - i : i, js = d ? 63 - j : j; Lt[is * 68 + js] = before ? Bv[i] * acc[r] * dec : 0.f; } }
            }
            __syncthreads();
            if (tid < 64 && !skip_solve) {
                const int I = tid >> 4, c = tid & 15; LAS float* Lb = Lt + (16 * I) * 68 + 16 * I; asm volatile("" : "+v"(Lb));
                float y[16];
#pragma unroll
                for (int i = 0; i < 16; ++i) { float v = (i == c) ? 1.0f : 0.0f;
#pragma unroll
                    for (int j4 = 0; j4 < (i + 3) / 4; ++j4) { const f32x4 lv = *(const LAS f32x4*)(Lb + i * 68 + 4 * j4);
                        if (4 * j4 + 0 < i) v -= lv[0] * y[4 * j4 + 0]; if (4 * j4 + 1 < i) v -= lv[1] * y[4 * j4 + 1];
                        if (4 * j4 + 2 < i) v -= lv[2] * y[4 * j4 + 2]; if (4 * j4 + 3 < i) v -= lv[3] * y[4 * j4 + 3]; }
                    y[i] = v; Dinv[(I * 16 + i) * 20 + c] = v; }
            }
            __syncthreads();
            if (!skip_solve) {
                const int li = lane & 15, g = lane >> 4, c = 16 * (w & 3) + li; const bool isw = w >= 4;
                LAS float* R = isw ? Ks : Vs; LAS float* X = isw ? Ws : Us;
                f32x4 Xb[4];
#pragma unroll
                for (int I = 0; I < 4; ++I) {
                    f32x4 z;
#pragma unroll
                    for (int r = 0; r < 4; ++r) { const int is = 16 * I + 4 * g + r, i = d ? 63 - is : is; z[r] = Bv[i] * R[i * LS + c] * (isw ? EGv[i] : 1.0f); }
#pragma unroll
                    for (int J = 0; J < I; ++J) { const f32x4 lf = *(const LAS f32x4*)(Lt + (16 * I + li) * 68 + 16 * J + 4 * g);
#pragma unroll
                        for (int r = 0; r < 4; ++r) z = __builtin_amdgcn_mfma_f32_16x16x4f32(-lf[r], Xb[J][r], z, 0, 0, 0); }
                    const f32x4 df = *(const LAS f32x4*)(Dinv + (I * 16 + li) * 20 + 4 * g);
                    f32x4 xi = (f32x4){0.f, 0.f, 0.f, 0.f};
#pragma unroll
                    for (int r = 0; r < 4; ++r) xi = __builtin_amdgcn_mfma_f32_16x16x4f32(df[r], z[r], xi, 0, 0, 0);
                    Xb[I] = xi;
#pragma unroll
                    for (int r = 0; r < 4; ++r) { const int is = 16 * I + 4 * g + r, i = d ? 63 - is : is; X[i * LS + c] = xi[r]; }
                }
            }
            __syncthreads();
            {
                const int p = w >> 1; const float egl = misc[d];
                if (tid == 0) ((float*)(F.ws + WS_EGL))[gdn_slot(d, h, n) >> 12] = egl;
                 v2u* dstB = GB + (gdn_slot(d, h, n) >> 2); bf16* dstQ = GQP + gdn_slot(d, h, n); bf16* dstO = GOP + gdn_slot(d, h, n);
#pragma unroll 1
                for (int tt = 0; tt < 2; ++tt) { const int t = 2 * (w & 1) + tt, ti = t >> 1, tj = t & 1;
                    LAS float* Xr = (p == 0 || p == 2) ? Ws : Us;
                    f32x16 acc;
                    if (p < 2) acc = MM32([&](int i, int k) { return Ks[k * LS + 32 * ti + i] * Fv[k]; }, [&](int k, int j) { return Xr[k * LS + 32 * tj + j]; }, 64, l31, hh);
                    else       acc = MM32([&](int i, int k) { return As[(32 * ti + i) * LS + k]; }, [&](int k, int j) { return Xr[k * LS + 32 * tj + j]; }, 64, l31, hh);
                    const int j = 32 * tj + l31;
#pragma unroll
                    for (int r = 0; r < 16; ++r) { const int i = 32 * ti + ACC_ROW(r, hh);
                        if (p == 0) Lt[i * 68 + j] = -acc[r];
                        else if (p == 1) { if ((r & 3) == 0) { v2u o_; o_[0] = cvt2(acc[r], acc[r + 1]); o_[1] = cvt2(acc[r + 2], acc[r + 3]); dstB[GBF(i, j) >> 2] = o_; } }
                        else if (p == 2) dstQ[i * 64 + KPERM(j)] = (bf16)f2bf(Qs[i * LS + j] * EGv[i] - acc[r]);
                        else dstO[i * 64 + j] = (bf16)f2bf(acc[r]); } }
            }
            __syncthreads();
            {
                const int f = tid, mo = f >> 7, sx = (f >> 6) & 1, il = f & 15, gx = (f & 63) >> 4; float mv[8];
#pragma unroll
                for (int jj = 0; jj < 8; ++jj) mv[jj] = Lt[(16 * mo + il) * 68 + 32 * sx + 16 * (jj >> 2) + 4 * gx + (jj & 3)];
                *(v4u*)((bf16*)(F.ws + WS_GA) + gdn_slot(d, h, n) + f * 8) = pack8(mv);
            }
        }
    }
}

__device__ __forceinline__ size_t gla_slot(int d, int h, int n) { return (size_t)(d * 4 + h) * NCHUNK + n; }
__device__ __forceinline__ void ph_gla_a(const Frame& F, int l) {
    const bf16* P = (const bf16*)(F.ws + WS_P); const float* LOGA = (const float*)(F.ws + WS_LOGA);
    bf16* OL = (bf16*)(F.ws + WS_OL); float* DS = (float*)(F.ws + WS_DS); float* ACH = (float*)(F.ws + WS_ACH); bf16* GQB = (bf16*)(F.ws + WS_GQB);
    LAS float* Qi = (LAS float*)F.lds; LAS float* Ko = Qi + 64 * LS; LAS float* Vs = Ko + 64 * LS; LAS float* Bs = Vs + 64 * LS2; LAS float* At = Bs + 64 * LS;
    const int tid = F.tid, lane = F.lane, w = F.wave, l31 = lane & 31, hh = lane >> 5;
#pragma unroll 1
    for (int unit = F.G - 1 - F.bid; unit < NCHUNK * 8; unit += F.G) {
        const int n = unit >> 3, h = (unit >> 1) & 3, d = unit & 1, r0 = n * CH;
        __syncthreads();
        float tq[8], tk[8];
        {   float tb[8]; unsigned tv[8];
#pragma unroll
            for (int q = 0; q < 8; ++q) { const int e = tid + NTHR * q, i = e >> 6, c = e & 63; tb[q] = LOGA[(size_t)(r0 + i) * 512 + d * 256 + h * 64 + c];
                tq[q] = bf2f(P[(size_t)(r0 + i) * PWP + C_LQ + h * 64 + c]) * 0.125f; tk[q] = bf2f(P[(size_t)(r0 + i) * PWP + C_LK + h * 64 + c]);
                const int i2 = e >> 6, c2 = (e & 63) * 2; tv[q] = *(const unsigned*)(P + (size_t)(r0 + i2) * PWP + C_LV + h * 128 + c2); }
#pragma unroll
            for (int q = 0; q < 8; ++q) { const int e = tid + NTHR * q, i = e >> 6, c = e & 63; Bs[i * LS + c] = tb[q];
                Vs[i * LS2 + 2 * c] = __builtin_bit_cast(float, tv[q] << 16); Vs[i * LS2 + 2 * c + 1] = __builtin_bit_cast(float, tv[q] & 0xffff0000u); } }
        __syncthreads();
        if (tid < 64) {
            float s = 0.f;
#pragma unroll 8
            for (int is = 0; is < 64; ++is) { const int i = d ? 63 - is : is; s += Bs[i * LS + tid]; Bs[i * LS + tid] = s; }
            ACH[gla_slot(d, h, n) * 64 + tid] = __expf(s);
        }
        __syncthreads();
#pragma unroll
        for (int qq = 0; qq < 8; ++qq) { const int e = tid + NTHR * qq, i = e >> 6, c = e & 63; const int il = d ? 0 : 63;
            const float b = Bs[i * LS + c], bl = Bs[il * LS + c];
            const float q = tq[qq], k = tk[qq];
            Qi[i * LS + c] = q * __expf(b - bl); Ko[i * LS + c] = k * __expf(bl - b);
            GQB[(gla_slot(d, h, n) * 64 + i) * 64 + c] = (bf16)f2bf(q * __expf(b)); }
        __syncthreads();
        if (w < 4) {
            const int ti = w >> 1, tj = w & 1;
            const f32x16 acc = MM32([&](int i, int k) { return Qi[(32 * ti + i) * LS + k]; }, [&](int k, int j) { return Ko[(32 * tj + j) * LS + k]; }, 64, l31, hh);
            const int j = 32 * tj + l31;
#pragma unroll
            for (int r = 0; r < 16; ++r) { const int i = 32 * ti + ACC_ROW(r, hh); const bool ok = d ? (j >= i) : (j <= i); At[i * LS + j] = ok ? acc[r] : 0.f; }
        }
        __syncthreads();
        {
            const int ti = w >> 2, tj = w & 3;
            { const f32x16 acc = MM32([&](int i, int k) { return At[(32 * ti + i) * LS + k]; }, [&](int k, int j) { return Vs[k * LS2 + 32 * tj + j]; }, 64, l31, hh);
              bf16* dst = OL + (size_t)d * NTOK * 512;
#pragma unroll
              for (int r = 0; r < 16; ++r) { const int i = 32 * ti + ACC_ROW(r, hh); dst[(size_t)(r0 + i) * 512 + h * 128 + 32 * tj + l31] = (bf16)f2bf(acc[r]); } }
            { const f32x16 acc = MM32([&](int i, int k) { return Ko[k * LS + 32 * ti + i]; }, [&](int k, int j) { return Vs[k * LS2 + 32 * tj + j]; }, 64, l31, hh);
              float* dst = DS + gla_slot(d, h, n) * 8192;
#pragma unroll
              for (int r = 0; r < 16; ++r) { const int i = 32 * ti + ACC_ROW(r, hh); dst[i * 128 + 32 * tj + l31] = acc[r]; } }
        }
    }
}

__device__ __forceinline__ int chain_chunk(int d, int step) { const int rev = (step < NCTXCH ? NCTXCH - 1 : NCHUNK + NCTXCH - 1) - step; return d ? rev : step; }
__device__ __forceinline__ void gla_scan(const Frame& F, int gtid) {
    const float* DS = (const float*)(F.ws + WS_DS); const float* ACH = (const float*)(F.ws + WS_ACH); v2u* GLS = (v2u*)(F.ws + WS_GLS);
    const int dh = gtid >> 11, e4 = gtid & 2047, kq = e4 >> 7, dv = e4 & 127, d = dh >> 2;
    float s[4] = {0.f, 0.f, 0.f, 0.f};
#pragma unroll 1
    for (int s0 = 0; s0 < NCHUNK; s0 += 10) {
        float x[10][4]; f32x4 a[10];
#pragma unroll
        for (int q = 0; q < 10; ++q) { const size_t slot = (size_t)(dh * NCHUNK + chain_chunk(d, s0 + q));
#pragma unroll
            for (int r = 0; r < 4; ++r) x[q][r] = DS[slot * 8192 + (4 * kq + r) * 128 + dv];
            a[q] = *(const f32x4*)(ACH + slot * 64 + 4 * kq); }
#pragma unroll
        for (int q = 0; q < 10; ++q) { const size_t slot = (size_t)(dh * NCHUNK + chain_chunk(d, s0 + q));
            v2u o; o[0] = pg8::cvt_pk_bf16(s[0], s[1]); o[1] = pg8::cvt_pk_bf16(s[2], s[3]); GLS[slot * 2048 + kq * 128 + dv] = o;
#pragma unroll
            for (int r = 0; r < 4; ++r) s[r] = a[q][r] * s[r] + x[q][r]; }
    }
}
constexpr int SCB = 4;
__device__ __forceinline__ void gdn_scan(const Frame& F) {
    const bf16* GM = (const bf16*)(F.ws + WS_GA); const v2u* GB = (const v2u*)(F.ws + WS_GB); bf16* GST = (bf16*)(F.ws + WS_GST); const float* EGL = (const float*)(F.ws + WS_EGL);
    const int lane = F.lane, w = F.wave, tid = F.tid, ci = w >> 2, slice = w & 3, chain = 2 * F.bid + ci, d = chain >> 3;
    LAS unsigned char* lds = F.lds;
    f32x4 S[4];
#pragma unroll
    for (int m = 0; m < 4; ++m) S[m] = (f32x4){0.f, 0.f, 0.f, 0.f};
    v4u R[8]; v2u Bn[SCB][4], Bc[SCB][4]; float en[SCB], ec[SCB];
#define SC_ISSUE(batch) do { const int b_ = (batch) < NCHUNK / SCB ? (batch) : NCHUNK / SCB - 1; \
        _Pragma("unroll") for (int i_ = 0; i_ < 8; ++i_) { const int q_ = tid + NTHR * i_, cq_ = q_ >> 11, jq_ = (q_ >> 9) & 3, r_ = q_ & 511; \
            const int ch_ = 2 * F.bid + cq_; const size_t slot_ = (size_t)ch_ * NCHUNK + chain_chunk(ch_ >> 3, b_ * SCB + jq_); \
            R[i_] = *(const v4u*)(GM + slot_ * 4096 + r_ * 8); } \
        _Pragma("unroll") for (int j_ = 0; j_ < SCB; ++j_) { const size_t slot_ = (size_t)chain * NCHUNK + chain_chunk(d, b_ * SCB + j_); en[j_] = EGL[slot_]; \
            _Pragma("unroll") for (int m_ = 0; m_ < 4; ++m_) Bn[j_][m_] = GB[slot_ * 1024 + (slice * 4 + m_) * 64 + lane]; } } while (0)
#define SC_COMMIT() do { _Pragma("unroll") for (int i_ = 0; i_ < 8; ++i_) { const int q_ = tid + NTHR * i_; *(LAS v4u*)(lds + q_ * 16) = R[i_]; } \
        _Pragma("unroll") for (int j_ = 0; j_ < SCB; ++j_) { ec[j_] = en[j_]; _Pragma("unroll") for (int m_ = 0; m_ < 4; ++m_) Bc[j_][m_] = Bn[j_][m_]; } } while (0)
    __syncthreads();
    SC_ISSUE(0); SC_COMMIT();
    __syncthreads();
#pragma unroll 1
    for (int b = 0; b < NCHUNK / SCB; ++b) {
        SC_ISSUE(b + 1);
#pragma unroll
        for (int j = 0; j < SCB; ++j) {
            LAS unsigned char* base = lds + (ci * SCB + j) * 8192;
            v4u mf[8]; f32x4 acc[4];
#pragma unroll
            for (int q = 0; q < 8; ++q) mf[q] = *(const LAS v4u*)(base + (q * 64 + lane) * 16);
#pragma unroll
            for (int m = 0; m < 4; ++m) { const v2u bb = Bc[j][m]; f32x4 bf_;
                bf_[0] = __builtin_bit_cast(float, bb[0] << 16); bf_[1] = __builtin_bit_cast(float, bb[0] & 0xffff0000u); bf_[2] = __builtin_bit_cast(float, bb[1] << 16); bf_[3] = __builtin_bit_cast(float, bb[1] & 0xffff0000u);
                acc[m] = S[m] * ec[j] + bf_; }
            v4u sb[2];
#pragma unroll
            for (int s2 = 0; s2 < 2; ++s2) { sb[s2][0] = cvt2(S[2 * s2][0], S[2 * s2][1]); sb[s2][1] = cvt2(S[2 * s2][2], S[2 * s2][3]);
                sb[s2][2] = cvt2(S[2 * s2 + 1][0], S[2 * s2 + 1][1]); sb[s2][3] = cvt2(S[2 * s2 + 1][2], S[2 * s2 + 1][3]); }
            const size_t slot = (size_t)chain * NCHUNK + chain_chunk(d, b * SCB + j);
#pragma unroll
            for (int s2 = 0; s2 < 2; ++s2) *(v4u*)(GST + slot * 4096 + ((slice * 2 + s2) * 64 + lane) * 8) = sb[s2];
#pragma unroll
            for (int s2 = 0; s2 < 2; ++s2)
#pragma unroll
                for (int mo = 0; mo < 4; ++mo) acc[mo] = __builtin_amdgcn_mfma_f32_16x16x32_bf16(__builtin_bit_cast(bf16x8, mf[mo * 2 + s2]), __builtin_bit_cast(bf16x8, sb[s2]), acc[mo], 0, 0, 0);
#pragma unroll
            for (int m = 0; m < 4; ++m) S[m] = acc[m];
        }
        __syncthreads();
        SC_COMMIT();
        __syncthreads();
    }
#undef SC_ISSUE
#undef SC_COMMIT
}
__device__ __forceinline__ void ph_scan(const Frame& F) {
    if (F.bid < 8) gdn_scan(F);
    else if (F.bid < 40) gla_scan(F, (F.bid - 8) * NTHR + F.tid);
}

template <int NT>
__device__ __forceinline__ void final_unit(const Frame& F, const ArgView& A, int l, int n, int h, int ti) {
    const int lane = F.lane, l31 = lane & 31, hh = lane >> 5, r0 = n * CH;
    constexpr bool GDN = (NT == 2); constexpr int NV = 32 * NT;
    f32x16 acc[NT];
#pragma unroll
    for (int t = 0; t < NT; ++t)
#pragma unroll
        for (int i = 0; i < 16; ++i) acc[t][i] = 0.f;
#pragma unroll 1
    for (int d = 0; d < 2; ++d) {
        const bf16* Aq; const v2u* Gl = nullptr; const bf16* Gs = nullptr; const bf16* Ol; int ols;
        if (GDN) { Aq = (const bf16*)(F.ws + WS_GQP) + gdn_slot(d, h, n); Gs = (const bf16*)(F.ws + WS_GST) + gdn_slot(d, h, n); Ol = (const bf16*)(F.ws + WS_GOP) + gdn_slot(d, h, n); ols = 64; }
        else { Aq = (const bf16*)(F.ws + WS_GQB) + gla_slot(d, h, n) * 4096; Gl = (const v2u*)(F.ws + WS_GLS) + gla_slot(d, h, n) * 2048;
               Ol = (const bf16*)(F.ws + WS_OL) + (size_t)d * NTOK * 512 + (size_t)r0 * 512 + h * 128; ols = 512; }
#pragma unroll
        for (int t = 0; t < NT; ++t)
#pragma unroll
            for (int r = 0; r < 16; ++r) acc[t][r] += bf2f(Ol[(size_t)(32 * ti + ACC_ROW(r, hh)) * ols + 32 * t + l31]);
        v4u av[2], bv[2][NT];
#define FIN_LOAD(buf, s) do { av[buf] = *(const v4u*)(Aq + (32 * ti + l31) * 64 + 16 * (s) + 8 * hh); \
        _Pragma("unroll") for (int t_ = 0; t_ < NT; ++t_) { \
            if (GDN) bv[buf][t_] = *(const v4u*)(Gs + ((((2 * t_ + (l31 >> 4)) * 2 + ((s) >> 1)) * 64 + (2 * ((s) & 1) + hh) * 16 + (l31 & 15)) * 8)); \
            else { const v2u b0_ = Gl[(4 * (s) + 2 * hh) * 128 + 32 * t_ + l31], b1_ = Gl[(4 * (s) + 2 * hh + 1) * 128 + 32 * t_ + l31]; \
                   bv[buf][t_][0] = b0_[0]; bv[buf][t_][1] = b0_[1]; bv[buf][t_][2] = b1_[0]; bv[buf][t_][3] = b1_[1]; } } } while (0)
        FIN_LOAD(0, 0);
#pragma unroll
        for (int s = 0; s < 4; ++s) {
            if (s < 3) FIN_LOAD((s + 1) & 1, s + 1);
            const v4u af = av[s & 1];
#pragma unroll
            for (int t = 0; t < NT; ++t) {
                const v4u bf = bv[s & 1][t];
                acc[t] = __builtin_amdgcn_mfma_f32_32x32x16_bf16(__builtin_bit_cast(bf16x8, af), __builtin_bit_cast(bf16x8, bf), acc[t], 0, 0, 0); }
            __builtin_amdgcn_sched_barrier(0);
        }
#undef FIN_LOAD
    }
    const bf16* P = (const bf16*)(F.ws + WS_P); bf16* mix = (bf16*)(F.ws + WS_MIX);
    const float* gain = A.in[GDN ? I_GONORM : I_LONORM] + l * NV; const int gcol = (GDN ? C_GGATE + h * 64 : C_LR + h * 128), mcol = (GDN ? h * 64 : 1024 + h * 128);
    float gn[NT];
#pragma unroll
    for (int t = 0; t < NT; ++t) gn[t] = gain[32 * t + l31];
#pragma unroll
    for (int r = 0; r < 16; ++r) {
        float ss = 0.f;
#pragma unroll
        for (int t = 0; t < NT; ++t) ss += acc[t][r] * acc[t][r];
        ss += __shfl_xor(ss, 1); ss += __shfl_xor(ss, 2); ss += __shfl_xor(ss, 4); ss += __shfl_xor(ss, 8); ss += __shfl_xor(ss, 16);
        const float rs = 1.0f / sqrtf(ss * (1.f / NV) + NEPS);
        const size_t row = (size_t)(r0 + 32 * ti + ACC_ROW(r, hh));
#pragma unroll
        for (int t = 0; t < NT; ++t) { const float g = bf2f(P[row * PWP + gcol + 32 * t + l31]);
            mix[row * 2048 + mcol + 32 * t + l31] = (bf16)f2bf(acc[t][r] * rs * gn[t] * siluf(g)); }
    }
}
__device__ __forceinline__ void ph_final(const Frame& F, const ArgView& A, int l, int chunk_lo) {
    const int gw = F.bid * NWAVES + F.wave, NGW = F.G * NWAVES, nun = (NCHUNK - chunk_lo) * 24;
#pragma unroll 1
    for (int unit = gw; unit < nun; unit += NGW) { const int n = chunk_lo + unit / 24, u = unit % 24;
        if (u < 16) final_unit<2>(F, A, l, n, u >> 1, u & 1);
        else final_unit<4>(F, A, l, n, (u - 16) >> 1, u & 1); }
}

constexpr int PH_PER_LAYER = 15, N_PHASES = 1 + 2 * PH_PER_LAYER;
#ifndef MOEDN_ALIGN
#define MOEDN_ALIGN true
#endif
#ifndef MOEDN_SP2
#define MOEDN_SP2 true
#endif
#ifndef REPEAT_MODE
#define REPEAT_MODE 1
#endif
#ifndef MK_SINGLE
#define MK_SINGLE 0
#endif
template <int KIND> __global__ void __launch_bounds__(NTHR, 2) fwd(Args args) {
    extern __shared__ __attribute__((aligned(16))) unsigned char lds_raw[];
    Frame F; ArgView AV; AV.in.p = (CArgsP)__builtin_amdgcn_kernarg_segment_ptr();
    F.lds = (LAS unsigned char*)lds_raw; F.ws = args.ws; F.ctl = (unsigned*)(args.ws + WS_CTL); F.out = args.out;
    F.tid = threadIdx.x; F.lane = F.tid & 63; F.wave = __builtin_amdgcn_readfirstlane(F.tid >> 6); F.G = gridDim.x; F.bid = blockIdx.x;
    for (int u = F.tid; u < (LDS_BYTES - LDSCTL_OFF) / 4; u += NTHR) ((LAS unsigned*)(F.lds + LDSCTL_OFF))[u] = 0u;
    __syncthreads();
    const int lo = args.ph_lo, hi = args.ph_hi;
#ifdef ACQ_START
    __builtin_amdgcn_fence(__ATOMIC_ACQUIRE, "agent"); asm volatile("s_waitcnt vmcnt(0)" ::: "memory");
#endif
    XcdBarrier bar; bar.bar = F.ctl + CW_BAR; bar.x = 0; bar.st = nullptr;
    if (KIND < 0 || hi - lo > 1) bar = xcd_barrier_post(F.ctl + CW_BAR, (volatile LAS unsigned*)(F.lds + MISC_OFF) + 8);
#define EN(j) (KIND < 0 || (j) == KIND)
#define IN(k) (KIND < 0 || (lo <= (k) && (k) < hi))
#define SEAM(k) do { if (KIND < 0 ? ((k) + 1 < N_PHASES) : (IN(k) && IN((k) + 1))) xcd_barrier(bar); } while (0)
#define FRESH() do { int l_; asm volatile("v_mbcnt_lo_u32_b32 %0, -1, 0\n\tv_mbcnt_hi_u32_b32 %0, -1, %0" : "=v"(l_)); F.lane = l_; F.tid = F.wave * 64 + l_; { CArgsP ka_ = (CArgsP)__builtin_amdgcn_kernarg_segment_ptr(); asm volatile("" : "+s"(ka_)); AV.in.p = ka_; } { unsigned char* w_ = args.ws; asm volatile("" : "+s"(w_)); F.ws = w_; F.ctl = (unsigned*)w_; float* o_ = args.out; asm volatile("" : "+s"(o_)); F.out = o_; } } while (0)

    if (EN(100) && IN(0)) { FRESH(); ph_prologue(F, AV); }
    SEAM(0);
    { constexpr int l = 0;
    {
        const int b = 1 + PH_PER_LAYER * l;
#define XLAT (l == 0 ? AV.in[I_X] : (const float*)F.out)
#define XCTX (l == 0 ? AV.in[I_CTX] : (const float*)(F.ws + WS_XCTX))
        const int out_lo = l == 0 ? 0 : NCTX;
        if (EN(0) && IN(b + 0)) { FRESH(); ph_convert(F, AV, l); }
        SEAM(b + 0);
        if (EN(1) && IN(b + 1)) { FRESH(); ph_norm<0>(F, AV, l, XLAT, XCTX, 0); }
        SEAM(b + 1);
        if (EN(2) && IN(b + 2)) { FRESH();
            pg8::Gemm g{(const bf16*)(F.ws + WS_HBUF), (const bf16*)(F.ws + WS_WIN), NTOK, PWP, DM}; pg8::StaticOrder S; S.init(NTOK, PWP, DM, F.G, F.bid);
            pg8::EpiBf16 E{(bf16*)(F.ws + WS_P), PWP};
            pg8::gemm_phase<pg8::EpiBf16, pg8::StaticOrder, true, true>(F.lds, g, S, E, F.tid);
        }
        SEAM(b + 2);
        if (EN(3) && IN(b + 3)) { FRESH(); ph_prep(F, AV, l); }
        SEAM(b + 3);
        if (EN(4) && IN(b + 4)) { const int rp_ = KIND < 0 ? 0 : args.rep; FRESH(); if (rp_ != 4) ph_gdn_a(F, l, rp_ == 3); FRESH(); if (rp_ < 2 || rp_ == 4) ph_gla_a(F, l); }
        SEAM(b + 4);
        if (EN(5) && IN(b + 5)) { FRESH(); if (KIND < 0 || args.rep == 0) ph_scan(F); FRESH(); ph_mix(F, AV, l); }
        SEAM(b + 5);
        if (EN(6) && IN(b + 6)) { FRESH(); ph_final(F, AV, l, out_lo / CH); }
        SEAM(b + 6);
        if (EN(7) && IN(b + 7)) { FRESH();
            const int M = NTOK - out_lo;
            pg8::Gemm g{(const bf16*)(F.ws + WS_MIX) + (size_t)out_lo * DM, (const bf16*)(F.ws + WS_WOUT), M, DM, DM}; pg8::StaticOrder S; S.init(M, DM, DM, F.G, F.bid);
            pg8::EpiResid E{XLAT, F.out, XCTX, (float*)(F.ws + WS_XCTX), modv_ptr(F, l, 0) + 2 * DM, modv_ptr(F, l, 1) + 2 * DM, NCTX, out_lo};
            pg8::gemm_phase<pg8::EpiResid, pg8::StaticOrder, true, true>(F.lds, g, S, E, F.tid);
        }
        SEAM(b + 7);
        if (EN(8) && IN(b + 8)) { FRESH(); ph_norm<1>(F, AV, l, F.out, (const float*)(F.ws + WS_XCTX), out_lo);
#ifdef ZERO_MOE
            { unsigned zu_ = 0u; asm volatile("" : "+v"(zu_)); v4u* z = (v4u*)(F.ws + WS_AMOE); const size_t n = ((size_t)MAXSLOT * 2048 * 2 + (size_t)MAXSLOT * 512 * 2) / 16;
              for (size_t i = (size_t)F.bid * NTHR + F.tid; i < n; i += (size_t)F.G * NTHR) z[i] = (v4u){zu_, zu_, zu_, zu_}; }
#endif
        }
        SEAM(b + 8);
        if (EN(9) && IN(b + 9)) { FRESH();
            const int M = NTOK - out_lo;
            pg8::Gemm g{(const bf16*)(F.ws + WS_HBUF) + (size_t)out_lo * DM, (const bf16*)(F.ws + WS_WR), M, 256, DM}; pg8::StaticOrder S; S.init(M, 256, DM, F.G, F.bid);
            pg8::EpiRouter E{AV.in[I_RGB] + l * 4, AV.in[I_REB] + l * 32, (int*)(F.ws + WS_TOKE), (float*)(F.ws + WS_TOKW), F.ctl + CW_CNT + 64 * l, out_lo};
            pg8::gemm_phase<pg8::EpiRouter, pg8::StaticOrder, false, true>(F.lds, g, S, E, F.tid);
        }
        SEAM(b + 9);
        if (EN(10) && IN(b + 10)) { FRESH(); ph_assign(F, l, out_lo); }
        SEAM(b + 10);
        if (EN(11) && IN(b + 11)) { FRESH(); ph_route(F, l, out_lo); }
        SEAM(b + 11);
        if (EN(12) && IN(b + 12)) { FRESH();
            build_tile_table(F, l);
            const LAS int* tab = (const LAS int*)(F.lds + TILE_TAB_OFF);
            pg8::Gemm g{(const bf16*)(F.ws + WS_AMOE), (const bf16*)(F.ws + WS_WUP), MAXSLOT, 1024, DM}; GroupedOrder S; S.init(tab, 4, DM, 1024, F.G, F.bid);
            pg8::EpiSwiGLU E{(bf16*)(F.ws + WS_HMOE), 512};
            pg8::gemm_phase<pg8::EpiSwiGLU, GroupedOrder, true, true>(F.lds, g, S, E, F.tid);
        }
        SEAM(b + 12);
        if (EN(13) && IN(b + 13)) { FRESH();
            build_tile_table(F, l);
            const LAS int* tab = (const LAS int*)(F.lds + TILE_TAB_OFF);
#if defined(TEST_W2COPY)
            pg8::Gemm g{(const bf16*)(F.ws + WS_HMOE), (const bf16*)(F.ws + WS_PARK), MAXSLOT, DM, 512}; GroupedOrder S; S.init(tab, 8, 512, 0, F.G, F.bid);
#elif defined(TEST_K512D0)
            pg8::Gemm g{(const bf16*)(F.ws + WS_HMOE), (const bf16*)(F.ws + WS_WDN), MAXSLOT, DM, 512}; GroupedOrder S; S.init(tab, 8, 512, 0, F.G, F.bid);
#elif defined(TEST_K512W)
            pg8::Gemm g{(const bf16*)(F.ws + WS_HMOE), (const bf16*)(F.ws + WS_WOUT), MAXSLOT, DM, 512}; GroupedOrder S; S.init(tab, 8, 512, 0, F.G, F.bid);
#elif defined(TEST_K1024)
            pg8::Gemm g{(const bf16*)(F.ws + WS_AMOE), (const bf16*)(F.ws + WS_WDN), MAXSLOT, DM, 1024}; GroupedOrder S; S.init(tab, 4, 1024, 1024, F.G, F.bid);
#elif defined(TEST_K512A)
            pg8::Gemm g{(const bf16*)(F.ws + WS_AMOE), (const bf16*)(F.ws + WS_WDN), MAXSLOT, DM, 512}; GroupedOrder S; S.init(tab, 8, 512, DM, F.G, F.bid);
#elif defined(TEST_K2048)
            pg8::Gemm g{(const bf16*)(F.ws + WS_AMOE), (const bf16*)(F.ws + WS_WOUT), MAXSLOT, DM, DM}; GroupedOrder S; S.init(tab, 8, DM, 0, F.G, F.bid);
#else
            pg8::Gemm g{(const bf16*)(F.ws + WS_HMOE), (const bf16*)(F.ws + WS_WDN), MAXSLOT, DM, 512}; GroupedOrder S; S.init(tab, 8, 512, DM, F.G, F.bid);
#endif
            pg8::EpiBf16 E{(bf16*)(F.ws + WS_YMOE), DM};
#if defined(MOEDN_SGEMM)
            sgemm_bf16out(F, g.A, g.Bt, g.K, S, (bf16*)(F.ws + WS_YMOE), DM);
#elif defined(MOEDN_ONEUNIT)
#pragma unroll 1
            for (int i = 0; i * F.G + F.bid < S.nunits; ++i) { OneUnit<GroupedOrder> S1{S, i}; pg8::gemm_phase<pg8::EpiBf16, OneUnit<GroupedOrder>, false, true>(F.lds, g, S1, E, F.tid); }
#else
            pg8::gemm_phase<pg8::EpiBf16, GroupedOrder, MOEDN_ALIGN, MOEDN_SP2>(F.lds, g, S, E, F.tid);
#endif
        }
        SEAM(b + 13);
        if (EN(14) && IN(b + 14)) { FRESH(); ph_combine(F, l, out_lo); }
        SEAM(b + 14);
    }
    }
    { constexpr int l = 1;
    {
        const int b = 1 + PH_PER_LAYER * l;
#define XLAT (l == 0 ? AV.in[I_X] : (const float*)F.out)
#define XCTX (l == 0 ? AV.in[I_CTX] : (const float*)(F.ws + WS_XCTX))
        const int out_lo = l == 0 ? 0 : NCTX;
        if (EN(0) && IN(b + 0)) { FRESH(); ph_convert(F, AV, l); }
        SEAM(b + 0);
        if (EN(1) && IN(b + 1)) { FRESH(); ph_norm<0>(F, AV, l, XLAT, XCTX, 0); }
        SEAM(b + 1);
        if (EN(2) && IN(b + 2)) { FRESH();
            pg8::Gemm g{(const bf16*)(F.ws + WS_HBUF), (const bf16*)(F.ws + WS_WIN), NTOK, PWP, DM}; pg8::StaticOrder S; S.init(NTOK, PWP, DM, F.G, F.bid);
            pg8::EpiBf16 E{(bf16*)(F.ws + WS_P), PWP};
            pg8::gemm_phase<pg8::EpiBf16, pg8::StaticOrder, true, true>(F.lds, g, S, E, F.tid);
        }
        SEAM(b + 2);
        if (EN(3) && IN(b + 3)) { FRESH(); ph_prep(F, AV, l); }
        SEAM(b + 3);
        if (EN(4) && IN(b + 4)) { const int rp_ = KIND < 0 ? 0 : args.rep; FRESH(); if (rp_ != 4) ph_gdn_a(F, l, rp_ == 3); FRESH(); if (rp_ < 2 || rp_ == 4) ph_gla_a(F, l); }
        SEAM(b + 4);
        if (EN(5) && IN(b + 5)) { FRESH(); if (KIND < 0 || args.rep == 0) ph_scan(F); FRESH(); ph_mix(F, AV, l); }
        SEAM(b + 5);
        if (EN(6) && IN(b + 6)) { FRESH(); ph_final(F, AV, l, out_lo / CH); }
        SEAM(b + 6);
        if (EN(7) && IN(b + 7)) { FRESH();
            const int M = NTOK - out_lo;
            pg8::Gemm g{(const bf16*)(F.ws + WS_MIX) + (size_t)out_lo * DM, (const bf16*)(F.ws + WS_WOUT), M, DM, DM}; pg8::StaticOrder S; S.init(M, DM, DM, F.G, F.bid);
            pg8::EpiResid E{XLAT, F.out, XCTX, (float*)(F.ws + WS_XCTX), modv_ptr(F, l, 0) + 2 * DM, modv_ptr(F, l, 1) + 2 * DM, NCTX, out_lo};
            pg8::gemm_phase<pg8::EpiResid, pg8::StaticOrder, true, true>(F.lds, g, S, E, F.tid);
        }
        SEAM(b + 7);
        if (EN(8) && IN(b + 8)) { FRESH(); ph_norm<1>(F, AV, l, F.out, (const float*)(F.ws + WS_XCTX), out_lo);
#ifdef ZERO_MOE
            { unsigned zu_ = 0u; asm volatile("" : "+v"(zu_)); v4u* z = (v4u*)(F.ws + WS_AMOE); const size_t n = ((size_t)MAXSLOT * 2048 * 2 + (size_t)MAXSLOT * 512 * 2) / 16;
              for (size_t i = (size_t)F.bid * NTHR + F.tid; i < n; i += (size_t)F.G * NTHR) z[i] = (v4u){zu_, zu_, zu_, zu_}; }
#endif
        }
        SEAM(b + 8);
        if (EN(9) && IN(b + 9)) { FRESH();
            const int M = NTOK - out_lo;
            pg8::Gemm g{(const bf16*)(F.ws + WS_HBUF) + (size_t)out_lo * DM, (const bf16*)(F.ws + WS_WR), M, 256, DM}; pg8::StaticOrder S; S.init(M, 256, DM, F.G, F.bid);
            pg8::EpiRouter E{AV.in[I_RGB] + l * 4, AV.in[I_REB] + l * 32, (int*)(F.ws + WS_TOKE), (float*)(F.ws + WS_TOKW), F.ctl + CW_CNT + 64 * l, out_lo};
            pg8::gemm_phase<pg8::EpiRouter, pg8::StaticOrder, false, true>(F.lds, g, S, E, F.tid);
        }
        SEAM(b + 9);
        if (EN(10) && IN(b + 10)) { FRESH(); ph_assign(F, l, out_lo); }
        SEAM(b + 10);
        if (EN(11) && IN(b + 11)) { FRESH(); ph_route(F, l, out_lo); }
        SEAM(b + 11);
        if (EN(12) && IN(b + 12)) { FRESH();
            build_tile_table(F, l);
            const LAS int* tab = (const LAS int*)(F.lds + TILE_TAB_OFF);
            pg8::Gemm g{(const bf16*)(F.ws + WS_AMOE), (const bf16*)(F.ws + WS_WUP), MAXSLOT, 1024, DM}; GroupedOrder S; S.init(tab, 4, DM, 1024, F.G, F.bid);
            pg8::EpiSwiGLU E{(bf16*)(F.ws + WS_HMOE), 512};
            pg8::gemm_phase<pg8::EpiSwiGLU, GroupedOrder, true, true>(F.lds, g, S, E, F.tid);
        }
        SEAM(b + 12);
        if (EN(13) && IN(b + 13)) { FRESH();
            build_tile_table(F, l);
            const LAS int* tab = (const LAS int*)(F.lds + TILE_TAB_OFF);
#if defined(TEST_W2COPY)
            pg8::Gemm g{(const bf16*)(F.ws + WS_HMOE), (const bf16*)(F.ws + WS_PARK), MAXSLOT, DM, 512}; GroupedOrder S; S.init(tab, 8, 512, 0, F.G, F.bid);
#elif defined(TEST_K512D0)
            pg8::Gemm g{(const bf16*)(F.ws + WS_HMOE), (const bf16*)(F.ws + WS_WDN), MAXSLOT, DM, 512}; GroupedOrder S; S.init(tab, 8, 512, 0, F.G, F.bid);
#elif defined(TEST_K512W)
            pg8::Gemm g{(const bf16*)(F.ws + WS_HMOE), (const bf16*)(F.ws + WS_WOUT), MAXSLOT, DM, 512}; GroupedOrder S; S.init(tab, 8, 512, 0, F.G, F.bid);
#elif defined(TEST_K1024)
            pg8::Gemm g{(const bf16*)(F.ws + WS_AMOE), (const bf16*)(F.ws + WS_WDN), MAXSLOT, DM, 1024}; GroupedOrder S; S.init(tab, 4, 1024, 1024, F.G, F.bid);
#elif defined(TEST_K512A)
            pg8::Gemm g{(const bf16*)(F.ws + WS_AMOE), (const bf16*)(F.ws + WS_WDN), MAXSLOT, DM, 512}; GroupedOrder S; S.init(tab, 8, 512, DM, F.G, F.bid);
#elif defined(TEST_K2048)
            pg8::Gemm g{(const bf16*)(F.ws + WS_AMOE), (const bf16*)(F.ws + WS_WOUT), MAXSLOT, DM, DM}; GroupedOrder S; S.init(tab, 8, DM, 0, F.G, F.bid);
#else
            pg8::Gemm g{(const bf16*)(F.ws + WS_HMOE), (const bf16*)(F.ws + WS_WDN), MAXSLOT, DM, 512}; GroupedOrder S; S.init(tab, 8, 512, DM, F.G, F.bid);
#endif
            pg8::EpiBf16 E{(bf16*)(F.ws + WS_YMOE), DM};
#if defined(MOEDN_SGEMM)
            sgemm_bf16out(F, g.A, g.Bt, g.K, S, (bf16*)(F.ws + WS_YMOE), DM);
#elif defined(MOEDN_ONEUNIT)
#pragma unroll 1
            for (int i = 0; i * F.G + F.bid < S.nunits; ++i) { OneUnit<GroupedOrder> S1{S, i}; pg8::gemm_phase<pg8::EpiBf16, OneUnit<GroupedOrder>, false, true>(F.lds, g, S1, E, F.tid); }
#else
            pg8::gemm_phase<pg8::EpiBf16, GroupedOrder, MOEDN_ALIGN, MOEDN_SP2>(F.lds, g, S, E, F.tid);
#endif
        }
        SEAM(b + 13);
        if (EN(14) && IN(b + 14)) { FRESH(); ph_combine(F, l, out_lo); }
        SEAM(b + 14);
    }
    }

#undef IN
#undef SEAM
}

#ifndef CHK_SCALE
#define CHK_SCALE 1.0f
#endif
#if defined(CHK_REGION) || defined(TOUCH_WDN)
__global__ void chk_kernel(const unsigned short* p, size_t n, float* out) {
    const size_t t = (size_t)blockIdx.x * blockDim.x + threadIdx.x, T = (size_t)gridDim.x * blockDim.x; float s = 0.f;
    for (size_t i = t; i < n; i += T) s += __builtin_bit_cast(float, (unsigned)p[i] << 16);
    out[t] += s * CHK_SCALE;
}
#endif
template <int KIND> static void launch_kind(int grid, const Args& a, hipStream_t stream) {
    static bool attr = false;
    if (!attr) { (void)hipFuncSetAttribute((const void*)fwd<KIND>, hipFuncAttributeMaxDynamicSharedMemorySize, LDS_BYTES); attr = true; }
    hipLaunchKernelGGL(fwd<KIND>, dim3(grid), dim3(NTHR), LDS_BYTES, stream, a);
}
extern "C" void kernel_launch(void* const* d_in, const int* in_sizes, int n_in, void* d_out, int out_size, void* d_ws, size_t ws_size, hipStream_t stream) {
    static int grid = 0;
    if (grid == 0) {
        if (n_in != N_IN || out_size != SEQ * DM || ws_size < WS_END) { fprintf(stderr, "kernel_launch: unexpected shapes: n_in %d out %d ws %zu (need %zu)\n", n_in, out_size, ws_size, (size_t)WS_END); grid = -1; return; }
        int dev = 0, cus = 0;
        if (hipGetDevice(&dev) != hipSuccess || hipDeviceGetAttribute(&cus, hipDeviceAttributeMultiprocessorCount, dev) != hipSuccess) { grid = -1; return; }
        grid = cus;
    }
    if (grid < 0) return;
    (void)hipMemsetAsync((char*)d_ws + WS_CTL, 0, CTL_ZERO_BYTES, stream);
#ifdef MEMSET_WDN
    (void)hipMemsetAsync((char*)d_ws + WS_WDN, 0, 64 * MiB, stream);
#endif
    Args a{};
    for (int i = 0; i < N_IN; ++i) a.in[i] = (const float*)d_in[i];
    a.out = (float*)d_out; a.ws = (unsigned char*)d_ws;
#if MK_SINGLE
    a.ph_lo = 0; a.ph_hi = N_PHASES;
    launch_kind<-1>(grid, a, stream);
#else
#ifndef P_END
#define P_END N_PHASES
#endif
    for (int p = 0; p < P_END; ++p) { a.ph_lo = p; a.ph_hi = p + 1;
        const int k = p == 0 ? 100 : (p - 1) % PH_PER_LAYER;
#ifdef SKIP_MOE_GEMM
        if (k == 12 || k == 13) continue;
#endif
#ifdef TEST_H
        if (k == 13) continue;
#endif
#ifdef TOUCH_WDN
        if (k == 11) hipLaunchKernelGGL(chk_kernel, dim3(256), dim3(512), 0, stream, (const unsigned short*)((char*)d_ws + WS_WDN), (size_t)(64 * MiB) / 2, (float*)((char*)d_ws + WS_PARK));
#endif
#ifdef TEST_W2COPY
        if (k == 11) (void)hipMemcpyAsync((char*)d_ws + WS_PARK, (char*)d_ws + WS_WDN, 2 * MiB, hipMemcpyDeviceToDevice, stream);
#endif
#ifdef TWICE_MOEDN
        if (k == 11) launch_kind<11>(grid, a, stream);
#endif
#ifdef REPEAT_KIND
        if (k == REPEAT_KIND) { a.rep = REPEAT_MODE; for (int q = 0; q < REPEAT_N; ++q) launch_kind<REPEAT_KIND>(grid, a, stream); a.rep = 0; }
#endif
        switch (k) {
            case 100: launch_kind<100>(grid, a, stream); break;
            case 0: launch_kind<0>(grid, a, stream); break; case 1: launch_kind<1>(grid, a, stream); break; case 2: launch_kind<2>(grid, a, stream); break;
            case 3: launch_kind<3>(grid, a, stream); break; case 4: launch_kind<4>(grid, a, stream); break; case 5: launch_kind<5>(grid, a, stream); break;
            case 6: launch_kind<6>(grid, a, stream); break; case 7: launch_kind<7>(grid, a, stream); break; case 8: launch_kind<8>(grid, a, stream); break;
            case 9: launch_kind<9>(grid, a, stream); break; case 10: launch_kind<10>(grid, a, stream); break; case 11: launch_kind<11>(grid, a, stream); break; case 12: launch_kind<12>(grid, a, stream); break; case 13: launch_kind<13>(grid, a, stream); break; case 14: launch_kind<14>(grid, a, stream); break;
        } }
#endif
#ifdef CHK_REGION
    hipLaunchKernelGGL(chk_kernel, dim3(256), dim3(512), 0, stream, (const unsigned short*)((char*)d_ws + CHK_REGION), (size_t)CHK_BYTES / 2, (float*)d_out);
#endif
}
```
